# Optimizing an MI355X kernel written in HIP

```python
import math
import jax, jax.numpy as jnp
from jax import lax
import numpy as np

D_MODEL = 1024
BATCH = 16
SEQ = 4096
DEPTH = 1

EPS = 1e-6
PLE_DIM = 256

GLA_HEADS = 4
GLA_DK = D_MODEL // 16
GLA_DV = D_MODEL // 8
GLA_QK = GLA_HEADS * GLA_DK
GLA_WIDTH = GLA_HEADS * GLA_DV
GLA_GATE_RANK = 16
GLA_TAU = 16.0
GLA_CHUNK = 64

HYENA_WIDTH = D_MODEL - GLA_WIDTH
HYENA_ORDER = 2
HYENA_SHORT = 3
HYENA_BANDS = 8
HYENA_EMB = 1 + 2 * HYENA_BANDS
HYENA_FFN = 64
HYENA_DECAY_TARGET = 1e-2
HYENA_FAST_PCT = 0.3
HYENA_SLOW_PCT = 1.5
HYENA_MIN_DECAY = math.log(HYENA_DECAY_TARGET) / HYENA_SLOW_PCT
HYENA_MAX_DECAY = math.log(HYENA_DECAY_TARGET) / HYENA_FAST_PCT

N_EXPERTS = 16
EC_CAPACITY = 2
D_FF_EXPERT = 2 * D_MODEL

MIX_WIDTH = GLA_WIDTH + HYENA_WIDTH
IN_SIZES = (GLA_QK, GLA_QK, GLA_WIDTH, GLA_WIDTH, GLA_GATE_RANK, GLA_GATE_RANK,
            (HYENA_ORDER + 1) * HYENA_WIDTH)
IN_COLS = GLA_QK * 2 + GLA_WIDTH * 2 + GLA_GATE_RANK * 2 + (HYENA_ORDER + 1) * HYENA_WIDTH

kernel_name = "hybrid_gla_hyena_ec_moe_encoder"


def rmsnorm(x, w):
    xf = x.astype(jnp.float32)
    y = xf * lax.rsqrt(jnp.mean(xf * xf, axis=-1, keepdims=True) + EPS)
    return (y * w.astype(jnp.float32)).astype(x.dtype)


def gla_direction(q, k, v, loga, strict):
    B, L, H, dk = q.shape
    dv = v.shape[-1]
    n = L // GLA_CHUNK

    def chunk(t):
        return t.reshape(B, n, GLA_CHUNK, H, t.shape[-1]).transpose(0, 3, 1, 2, 4)

    q, k, v, loga = chunk(q), chunk(k), chunk(v), chunk(loga)
    b = jnp.cumsum(loga, axis=3)
    b_last = b[:, :, :, -1:, :]
    q_dec = q * jnp.exp(b)
    k_inv = k * jnp.exp(-b)
    scores = jnp.einsum('bhncd,bhnsd->bhncs', q_dec, k_inv)
    mask = jnp.tril(jnp.ones((GLA_CHUNK, GLA_CHUNK), dtype=bool), -1 if strict else 0)
    scores = jnp.where(mask, scores, 0.0)
    o_intra = jnp.einsum('bhncs,bhnsv->bhncv', scores, v)

    chunk_kv = jnp.einsum('bhncd,bhncv->bhndv', k * jnp.exp(b_last - b), v)
    chunk_decay = jnp.exp(b_last[:, :, :, 0, :])

    def step(S, inp):
        dec, kv = inp
        return dec[..., None] * S + kv, S

    S0 = jnp.zeros((B, H, dk, dv), jnp.float32)
    _, S_prev = lax.scan(step, S0, (jnp.moveaxis(chunk_decay, 2, 0), jnp.moveaxis(chunk_kv, 2, 0)))
    S_prev = jnp.moveaxis(S_prev, 0, 2)
    o = o_intra + jnp.einsum('bhncd,bhndv->bhncv', q_dec, S_prev)
    return o.transpose(0, 2, 3, 1, 4).reshape(B, L, H, dv)


def gla_mixer(q_raw, k_raw, v_raw, g_raw, af_code, ab_code, wa_f, ba_f, wa_b, ba_b, norm_w):
    B, L, _ = q_raw.shape
    f32 = jnp.float32
    q = q_raw.astype(f32).reshape(B, L, GLA_HEADS, GLA_DK) * (GLA_DK ** -0.5)
    k = k_raw.astype(f32).reshape(B, L, GLA_HEADS, GLA_DK)
    v = v_raw.astype(f32).reshape(B, L, GLA_HEADS, GLA_DV)
    loga_f = (jax.nn.log_sigmoid((af_code @ wa_f + ba_f).astype(f32)) / GLA_TAU).reshape(B, L, GLA_HEADS, GLA_DK)
    loga_b = (jax.nn.log_sigmoid((ab_code @ wa_b + ba_b).astype(f32)) / GLA_TAU).reshape(B, L, GLA_HEADS, GLA_DK)
    flip = lambda t: jnp.flip(t, axis=1)
    o = gla_direction(q, k, v, loga_f, False) + flip(
        gla_direction(flip(q), flip(k), flip(v), flip(loga_b), True))
    o = o * lax.rsqrt(jnp.mean(o * o, axis=-1, keepdims=True) + EPS) * norm_w.astype(f32)
    o = o * jax.nn.silu(g_raw.astype(f32).reshape(B, L, GLA_HEADS, GLA_DV))
    return o.reshape(B, L, GLA_WIDTH)


def short_conv_centred(u, w, b):
    L = u.shape[1]
    half = HYENA_SHORT // 2
    up = jnp.pad(u, ((0, 0), (half, half), (0, 0)))
    y = b
    for j in range(HYENA_SHORT):
        y = y + up[:, j:j + L] * w[j]
    return y


def hyena_filters(L, w1, b1, fr1, w2, b2, fr2, w3):
    f32 = jnp.float32
    t = jnp.linspace(0.0, 1.0, L, dtype=f32)[:, None]
    w_pos = 2.0 * math.pi * jnp.arange(L, dtype=f32)[:, None] / L
    f = jnp.linspace(1e-4, HYENA_BANDS - 1, HYENA_BANDS, dtype=f32)[None]
    z = jnp.concatenate([t, jnp.cos(f * w_pos), -jnp.sin(f * w_pos)], axis=-1)
    hdn = jnp.sin(fr1.astype(f32) * (z @ w1.astype(f32) + b1.astype(f32)))
    hdn = jnp.sin(fr2.astype(f32) * (hdn @ w2.astype(f32) + b2.astype(f32)))
    h = hdn @ w3.astype(f32)
    deltas = jnp.abs(jnp.linspace(HYENA_MIN_DECAY, HYENA_MAX_DECAY, HYENA_WIDTH, dtype=f32))
    decay = jnp.exp(-t * deltas[None])
    h = h.reshape(L, HYENA_ORDER, 2, HYENA_WIDTH) * decay[:, None, None, :]
    return h.transpose(1, 2, 0, 3)


def bidir_long_conv(u, h_fwd, h_bwd, bias):
    L, W = h_fwd.shape
    n = 2 * L
    kern = jnp.concatenate([h_fwd, jnp.zeros((1, W), h_fwd.dtype), h_bwd[:0:-1]], axis=0)
    y = jnp.fft.irfft(jnp.fft.rfft(u, n=n, axis=1) * jnp.fft.rfft(kern, n=n, axis=0)[None],
                      n=n, axis=1)[:, :L]
    return y + u * bias


def hyena_mixer(u_raw, conv_w, conv_b, filt, bias):
    uc = short_conv_centred(u_raw, conv_w, conv_b).astype(jnp.float32)
    parts = jnp.split(uc, HYENA_ORDER + 1, axis=-1)
    z = parts[0]
    for o in range(HYENA_ORDER):
        z = parts[o + 1] * bidir_long_conv(z, filt[o, 0], filt[o, 1], bias[o].astype(jnp.float32))
    return z


def expert_choice_moe(h, w_router, w_gate, w_up, w_down):
    B, S, D = h.shape
    cap = EC_CAPACITY * S // N_EXPERTS
    probs = jax.nn.softmax((h @ w_router).astype(jnp.float32), axis=-1)
    gate, idx = lax.top_k(jnp.swapaxes(probs, 1, 2), cap)
    xg = jnp.take_along_axis(h, idx.reshape(B, N_EXPERTS * cap)[..., None], axis=1)
    xg = xg.reshape(B, N_EXPERTS, cap, D)
    hid = jax.nn.silu(jnp.einsum('becd,edf->becf', xg, w_gate)) * jnp.einsum('becd,edf->becf', xg, w_up)
    y = jnp.einsum('becf,efd->becd', hid, w_down) * gate[..., None].astype(h.dtype)
    flat_idx = (jnp.arange(B, dtype=jnp.int32)[:, None, None] * S + idx).reshape(-1)
    out = jax.ops.segment_sum(y.reshape(-1, D), flat_idx, num_segments=B * S)
    return out.reshape(B, S, D).astype(h.dtype)


def setup_inputs(seed: int = 0) -> dict:
    key = jax.random.key(seed)
    ks = jax.random.split(key, 32)
    f32 = jnp.float32

    def nrm(k, shape, scale):
        return jax.random.normal(k, shape, f32) * scale

    def gain(k, shape):
        return 1.0 + 0.02 * jax.random.normal(k, shape, f32)

    return {
        "x": nrm(ks[0], (BATCH, SEQ, D_MODEL), 1.0),
        "p": nrm(ks[1], (DEPTH, BATCH, SEQ, PLE_DIM), 1.0),
        "ln_mix_w": gain(ks[2], (DEPTH, D_MODEL)),
        "w_in": nrm(ks[3], (DEPTH, D_MODEL, IN_COLS), D_MODEL ** -0.5),
        "gla_wa_f": nrm(ks[4], (DEPTH, GLA_GATE_RANK, GLA_QK), GLA_GATE_RANK ** -0.5),
        "gla_ba_f": nrm(ks[5], (DEPTH, GLA_QK), 0.1),
        "gla_wa_b": nrm(ks[6], (DEPTH, GLA_GATE_RANK, GLA_QK), GLA_GATE_RANK ** -0.5),
        "gla_ba_b": nrm(ks[7], (DEPTH, GLA_QK), 0.1),
        "gla_norm_w": gain(ks[8], (DEPTH, GLA_DV)),
        "hy_conv_w": nrm(ks[9], (DEPTH, HYENA_SHORT, (HYENA_ORDER + 1) * HYENA_WIDTH), HYENA_SHORT ** -0.5),
        "hy_conv_b": nrm(ks[10], (DEPTH, (HYENA_ORDER + 1) * HYENA_WIDTH), 0.02),
        "hy_f_w1": nrm(ks[11], (DEPTH, HYENA_EMB, HYENA_FFN), HYENA_EMB ** -0.5),
        "hy_f_b1": nrm(ks[12], (DEPTH, HYENA_FFN), 0.02),
        "hy_f_freq1": gain(ks[13], (DEPTH, HYENA_FFN)),
        "hy_f_w2": nrm(ks[14], (DEPTH, HYENA_FFN, HYENA_FFN), HYENA_FFN ** -0.5),
        "hy_f_b2": nrm(ks[15], (DEPTH, HYENA_FFN), 0.02),
        "hy_f_freq2": gain(ks[16], (DEPTH, HYENA_FFN)),
        "hy_f_w3": nrm(ks[17], (DEPTH, HYENA_FFN, HYENA_ORDER * 2 * HYENA_WIDTH), 0.005),
        "hy_bias": nrm(ks[18], (DEPTH, HYENA_ORDER, HYENA_WIDTH), 0.1),
        "w_out": nrm(ks[19], (DEPTH, MIX_WIDTH, D_MODEL), MIX_WIDTH ** -0.5),
        "ln_ffn_w": gain(ks[20], (DEPTH, D_MODEL)),
        "w_router": nrm(ks[21], (DEPTH, D_MODEL, N_EXPERTS), D_MODEL ** -0.5),
        "w_gate_e": nrm(ks[22], (DEPTH, N_EXPERTS, D_MODEL, D_FF_EXPERT), D_MODEL ** -0.5),
        "w_up_e": nrm(ks[23], (DEPTH, N_EXPERTS, D_MODEL, D_FF_EXPERT), D_MODEL ** -0.5),
        "w_down_e": nrm(ks[24], (DEPTH, N_EXPERTS, D_FF_EXPERT, D_MODEL), D_FF_EXPERT ** -0.5),
        "ln_ple_w": gain(ks[25], (DEPTH, D_MODEL)),
        "w_ple_gate": nrm(ks[26], (DEPTH, D_MODEL, D_MODEL), D_MODEL ** -0.5),
        "w_ple_proj": nrm(ks[27], (DEPTH, PLE_DIM, D_MODEL), PLE_DIM ** -0.5),
        "final_norm_w": gain(ks[28], (D_MODEL,)),
    }


def reference(x, p, ln_mix_w, w_in, gla_wa_f, gla_ba_f, gla_wa_b, gla_ba_b, gla_norm_w,
              hy_conv_w, hy_conv_b, hy_f_w1, hy_f_b1, hy_f_freq1, hy_f_w2, hy_f_b2, hy_f_freq2,
              hy_f_w3, hy_bias, w_out, ln_ffn_w, w_router, w_gate_e, w_up_e, w_down_e,
              ln_ple_w, w_ple_gate, w_ple_proj, final_norm_w):
    L = x.shape[1]
    split_idx = []
    acc = 0
    for s in IN_SIZES[:-1]:
        acc += s
        split_idx.append(acc)

    r = x
    for i in range(DEPTH):
        h = rmsnorm(r, ln_mix_w[i])
        proj = h @ w_in[i]
        q_raw, k_raw, v_raw, g_raw, af_code, ab_code, hy_raw = jnp.split(proj, split_idx, axis=-1)
        gla_out = gla_mixer(q_raw, k_raw, v_raw, g_raw, af_code, ab_code,
                            gla_wa_f[i], gla_ba_f[i], gla_wa_b[i], gla_ba_b[i], gla_norm_w[i])
        filt = hyena_filters(L, hy_f_w1[i], hy_f_b1[i], hy_f_freq1[i],
                             hy_f_w2[i], hy_f_b2[i], hy_f_freq2[i], hy_f_w3[i])
        hy_out = hyena_mixer(hy_raw, hy_conv_w[i], hy_conv_b[i], filt, hy_bias[i])
        mixed = jnp.concatenate([gla_out, hy_out], axis=-1).astype(r.dtype)
        r = r + mixed @ w_out[i]
        r = r + expert_choice_moe(rmsnorm(r, ln_ffn_w[i]), w_router[i],
                                  w_gate_e[i], w_up_e[i], w_down_e[i])
        gate = jax.nn.sigmoid(rmsnorm(r, ln_ple_w[i]) @ w_ple_gate[i])
        r = r + gate * (p[i] @ w_ple_proj[i])
    return rmsnorm(r, final_norm_w)
```

```cpp
#include <hip/hip_runtime.h>
#include <hip/hip_cooperative_groups.h>
#include <cstdio>
#include <cstdint>
#include <cstddef>

namespace cg = cooperative_groups;

#define LAS __attribute__((address_space(3)))
typedef _Float16 h16;
typedef _Float16 h16x8 __attribute__((ext_vector_type(8)));
typedef _Float16 h16x4 __attribute__((ext_vector_type(4)));
typedef _Float16 h16x2 __attribute__((ext_vector_type(2)));
typedef float f32x4 __attribute__((ext_vector_type(4)));
typedef float f32x2 __attribute__((ext_vector_type(2)));
typedef unsigned u32x4 __attribute__((ext_vector_type(4)));
typedef unsigned u32x2 __attribute__((ext_vector_type(2)));
typedef int i32x8 __attribute__((ext_vector_type(8)));
typedef int i32x4 __attribute__((ext_vector_type(4)));

constexpr int NB = 16, SEQ = 4096, DM = 1024, NTOK = NB * SEQ;
constexpr int INCOLS = 3104;
constexpr int NEXP = 16, CAP = 512, DFF = 2048;
constexpr int HYW = 512, HYC = 1536;
constexpr float EPS = 1e-6f;

enum { I_X = 0, I_P, I_LNMIX, I_WIN, I_WAF, I_BAF, I_WAB, I_BAB, I_GLANW, I_HCW, I_HCB, I_FW1, I_FB1, I_FFR1, I_FW2, I_FB2, I_FFR2,
       I_FW3, I_HBIAS, I_WOUT, I_LNFFN, I_WROUTER, I_WGATE, I_WUP, I_WDOWN, I_LNPLE, I_WPG, I_WPP, I_FNW, N_IN };

constexpr size_t AL(size_t x) { return (x + 255) & ~(size_t)255; }
constexpr int NA1 = 1792;
constexpr size_t OFF_WINA = 0;
constexpr size_t OFF_WINHY = OFF_WINA + AL((size_t)NA1 * DM * 2);
constexpr size_t OFF_WOUT = OFF_WINHY + AL((size_t)HYC * DM * 2);
constexpr size_t OFF_WGU = OFF_WOUT + AL((size_t)DM * DM * 2);
constexpr size_t OFF_WD = OFF_WGU + AL((size_t)NEXP * 2 * DFF * DM * 2);
constexpr size_t OFF_WG = OFF_WD + AL((size_t)NEXP * DM * DFF * 2);
constexpr size_t OFF_WP = OFF_WG + AL((size_t)DM * DM * 2);
constexpr size_t OFF_P16 = OFF_WP + AL((size_t)DM * 256 * 2);
constexpr size_t OFF_PROBS = OFF_P16 + AL((size_t)NTOK * 256 * 2);
constexpr size_t OFF_SELIDX = OFF_PROBS + AL((size_t)NB * NEXP * SEQ * 4);
constexpr size_t OFF_SELGATE = OFF_SELIDX + AL((size_t)NB * NEXP * CAP * 4);
constexpr size_t OFF_SLOTMAP = OFF_SELGATE + AL((size_t)NB * NEXP * CAP * 4);
constexpr size_t OFF_CTR = OFF_SLOTMAP + AL((size_t)NTOK * NEXP * 4);
constexpr size_t OFF_BIG = OFF_CTR + 256;
constexpr size_t OFF_QKVG = OFF_BIG;
constexpr size_t OFF_HY = OFF_QKVG + AL((size_t)NTOK * 1536 * 2);
constexpr size_t OFF_CODES = OFF_HY + AL((size_t)HYC * NTOK * 2);
constexpr size_t OFF_OF = OFF_CODES + AL((size_t)NTOK * 32 * 4);
constexpr size_t OFF_OB = OFF_OF + AL((size_t)NTOK * 512 * 2);
constexpr size_t OFF_GR = OFF_OB + AL((size_t)NTOK * 512 * 2);
constexpr size_t OFF_H = OFF_GR + AL((size_t)2 * HYW * 8192 * 2);
constexpr size_t OFF_Z2 = OFF_H + AL((size_t)NTOK * DM * 2);
constexpr size_t END_A = OFF_Z2 + AL((size_t)HYW * NTOK * 2);
constexpr size_t OFF_HID = OFF_BIG;
constexpr size_t OFF_Y = OFF_HID + AL((size_t)NB * NEXP * CAP * DFF * 2);
constexpr size_t END_B = OFF_Y + AL((size_t)NB * NEXP * CAP * DM * 2);
static_assert(OFF_H >= OFF_Y, "h2 (read by the up/gate GEMM) must not be overwritten by HID");
constexpr size_t OFF_H3 = OFF_BIG;
constexpr size_t OFF_PP = OFF_H3 + AL((size_t)NTOK * DM * 2);
constexpr size_t OFF_R3H = OFF_PP + AL((size_t)NTOK * DM * 2);
constexpr size_t OFF_RSTD3 = OFF_R3H + AL((size_t)NTOK * DM * 2);
constexpr size_t OFF_ROWSQ = OFF_RSTD3 + AL((size_t)NTOK * 4);
constexpr size_t END_C = OFF_ROWSQ + AL((size_t)NTOK * 4);
constexpr size_t WS_END = END_A > END_B ? (END_A > END_C ? END_A : END_C) : (END_B > END_C ? END_B : END_C);

constexpr int NTHREADS = 512;
constexpr int LDS_BYTES = 156 * 1024;
constexpr float HY_SCALE = 64.0f;
constexpr int FP8_WSHIFT = 5;


struct Args {
    const float* in[N_IN];
    float* out;
    unsigned char* ws;
    int ph_lo, ph_hi;
};

__device__ __forceinline__ float wave_sum(float v) {
#pragma unroll
    for (int o = 32; o >= 1; o >>= 1) v += __shfl_xor(v, o);
    return v;
}
__device__ __forceinline__ float sigmoidf_(float x) { return 1.0f / (1.0f + __expf(-x)); }
__device__ __forceinline__ float siluf_(float x) { return x / (1.0f + __expf(-x)); }
__device__ __forceinline__ unsigned pack_h2(float a, float b) {
    h16x2 v; v.x = (h16)a; v.y = (h16)b; return __builtin_bit_cast(unsigned, v);
}


__device__ __forceinline__ void sincos_f(float x, float& s, float& c) {
    const float kf = rintf(x * 0.6366197723675814f);
    float r = fmaf(kf, -1.5707963705062866f, x); r = fmaf(kf, 4.371139000186241e-8f, r);
    const float r2 = r * r;
    const float sp = r + r * r2 * (-1.6666667e-1f + r2 * (8.3333338e-3f + r2 * (-1.9841270e-4f + r2 * 2.7557319e-6f)));
    const float cp = 1.0f + r2 * (-0.5f + r2 * (4.1666668e-2f + r2 * (-1.3888889e-3f + r2 * (2.4801587e-5f - r2 * 2.7557319e-7f))));
    const int k = (int)kf & 3;
    s = (k == 0) ? sp : (k == 1) ? cp : (k == 2) ? -sp : -cp;
    c = (k == 0) ? cp : (k == 1) ? -sp : (k == 2) ? -cp : sp;
}
__device__ __forceinline__ float sin_f(float x) { float s, c; sincos_f(x, s, c); return s; }

__device__ __forceinline__ unsigned pack_fp8x4(float a, float b, float c, float d) {
    int r = 0; r = __builtin_amdgcn_cvt_pk_fp8_f32(a, b, r, false); r = __builtin_amdgcn_cvt_pk_fp8_f32(c, d, r, true); return (unsigned)r;
}

namespace g8 {
constexpr int BM = 256, BK = 64, HALF = 128, HTB = HALF * BK * 2, STAGE_BYTES = 8 * HTB;
__device__ __forceinline__ int lds_byte(int r, int c) { const int st = (r >> 4) * 2 + (c >> 5), rr = r & 15, cc = c & 31, ob = rr * 64 + cc * 2; return st * 1024 + (ob ^ (((ob >> 9) & 1) << 5)); }
__device__ __forceinline__ void stage_rc(int b, int& R, int& C) { const int st = b / 1024, sb = b % 1024, swz = sb ^ (((sb >> 9) & 1) << 5); R = (st >> 1) * 16 + swz / 64; C = (st & 1) * 32 + (swz % 64) / 2; }
__device__ __forceinline__ int perm32(int rho) { const int n = rho >> 4, i = rho & 15; return 8 * (i >> 2) + 4 * n + (i & 3); }

struct Unit { const char* B; int pm, pn, g; unsigned rowbase; };

template <class Epi, class Sched, bool FP8 = false>
__device__ __forceinline__ void gemm_phase(LAS unsigned char* lds, const char* A, const int K, const Sched& S, const Epi& E) {
    const int tid = threadIdx.x, wid = __builtin_amdgcn_readfirstlane(tid >> 6), lane = tid & 63, wr = wid >> 2, wc = wid & 3, fr = lane & 15, fq = lane >> 4;
    const int nt = K / BK;
    int Rr[2], Cc[2]; unsigned voffB[2];
#pragma unroll
    for (int i = 0; i < 2; ++i) { stage_rc(tid * 16 + i * 8192, Rr[i], Cc[i]); const int Rb = Epi::PERM ? ((Rr[i] & ~31) + perm32(Rr[i] & 31)) : Rr[i];
        voffB[i] = (unsigned)(Rb * K + Cc[i]) * 2u; }
    const size_t kstep = (size_t)(BK * 2);
    const size_t hstep = (size_t)HALF * K * 2;
    const unsigned ldsw = (unsigned)wid * 1024u;
    const int aoff = lds_byte(wr * 64 + fr, fq * 8), boff = lds_byte(wc * 32 + fr, fq * 8);
#define G8_SA(b, h) (((b) * 2 + (h)) * HTB)
#define G8_SB(b, h) ((4 + (b) * 2 + (h)) * HTB)
#define G8_STAGE(bufoff, gbase, v0, v1) do { \
        __builtin_amdgcn_global_load_lds((const unsigned*)((const char*)(gbase) + (v0)), (LAS unsigned*)(lds + (bufoff) + ldsw), 16, 0, 0); \
        __builtin_amdgcn_global_load_lds((const unsigned*)((const char*)(gbase) + (v1)), (LAS unsigned*)(lds + (bufoff) + ldsw + 8192), 16, 0, 0); } while (0)
#define G8_LDA(dst, b, h) do { _Pragma("unroll") for (int m = 0; m < 4; ++m) { \
        const i32x4 lo_ = *(const LAS i32x4*)(lds + G8_SA(b, h) + aoff + m * 2048), hi_ = *(const LAS i32x4*)(lds + G8_SA(b, h) + aoff + m * 2048 + 1024); \
        dst[m] = __builtin_shufflevector(lo_, hi_, 0, 1, 2, 3, 4, 5, 6, 7); } } while (0)
#define G8_LDB(dst, b, h) do { _Pragma("unroll") for (int n = 0; n < 2; ++n) { \
        const i32x4 lo_ = *(const LAS i32x4*)(lds + G8_SB(b, h) + boff + n * 2048), hi_ = *(const LAS i32x4*)(lds + G8_SB(b, h) + boff + n * 2048 + 1024); \
        dst[n] = __builtin_shufflevector(lo_, hi_, 0, 1, 2, 3, 4, 5, 6, 7); } } while (0)
#define G8_MMA(ai, bj, At, Bt) do { __builtin_amdgcn_s_setprio(1); \
        if constexpr (FP8) { _Pragma("unroll") for (int m = 0; m < 4; ++m) _Pragma("unroll") for (int n = 0; n < 2; ++n) \
            asm volatile("v_mfma_scale_f32_16x16x128_f8f6f4 %0, %1, %2, %0, %3, %3 op_sel_hi:[0,0,0]" : "+v"(acc[ai][bj][m][n]) : "v"(Bt[n]), "v"(At[m]), "v"(sc_one)); } \
        else { _Pragma("unroll") for (int m = 0; m < 4; ++m) _Pragma("unroll") for (int n = 0; n < 2; ++n) { \
            const i32x8 a_ = At[m], b_ = Bt[n]; \
            const h16x8 a0_ = __builtin_bit_cast(h16x8, __builtin_shufflevector(a_, a_, 0, 1, 2, 3)), a1_ = __builtin_bit_cast(h16x8, __builtin_shufflevector(a_, a_, 4, 5, 6, 7)); \
            const h16x8 b0_ = __builtin_bit_cast(h16x8, __builtin_shufflevector(b_, b_, 0, 1, 2, 3)), b1_ = __builtin_bit_cast(h16x8, __builtin_shufflevector(b_, b_, 4, 5, 6, 7)); \
            acc[ai][bj][m][n] = __builtin_amdgcn_mfma_f32_16x16x32_f16(b0_, a0_, acc[ai][bj][m][n], 0, 0, 0); \
            acc[ai][bj][m][n] = __builtin_amdgcn_mfma_f32_16x16x32_f16(b1_, a1_, acc[ai][bj][m][n], 0, 0, 0); } } \
        __builtin_amdgcn_s_setprio(0); } while (0)
#define G8_WAIT_V(n) asm volatile("s_waitcnt vmcnt(" #n ")" ::: "memory")
#define G8_WAIT_L(n) asm volatile("s_waitcnt lgkmcnt(" #n ")" ::: "memory")
#define G8_BAR __builtin_amdgcn_s_barrier()
#define G8_SCHED __builtin_amdgcn_sched_barrier(0)
    Unit cur, nxt; int ui = 0;
    if (!S.next(0, cur)) return;
    f32x4 acc[2][2][4][2];
#pragma unroll
    for (int a = 0; a < 2; ++a)
#pragma unroll
        for (int b = 0; b < 2; ++b)
#pragma unroll
            for (int m = 0; m < 4; ++m)
#pragma unroll
                for (int n = 0; n < 2; ++n) acc[a][b][m][n] = (f32x4){0.f, 0.f, 0.f, 0.f};
    i32x8 At[4], B0[2], B1[2];
    const int sc_one = 0x7f7f7f7f; (void)sc_one;
    unsigned va00, va01, va10, va11, vn00, vn01, vn10, vn11;
    va00 = (S.arow(cur, Rr[0]) * (unsigned)K + (unsigned)Cc[0]) * 2u; va01 = (S.arow(cur, Rr[1]) * (unsigned)K + (unsigned)Cc[1]) * 2u;
    va10 = (S.arow(cur, HALF + Rr[0]) * (unsigned)K + (unsigned)Cc[0]) * 2u; va11 = (S.arow(cur, HALF + Rr[1]) * (unsigned)K + (unsigned)Cc[1]) * 2u;
    vn00 = va00; vn01 = va01; vn10 = va10; vn11 = va11;
    const char* cB = cur.B;
    G8_STAGE(G8_SB(0, 0), cB, voffB[0], voffB[1]); G8_STAGE(G8_SA(0, 0), A, va00, va01); G8_STAGE(G8_SB(0, 1), cB + hstep, voffB[0], voffB[1]); G8_STAGE(G8_SA(0, 1), A, va10, va11);
    if (wr == 1) G8_BAR;
    G8_WAIT_V(4); G8_BAR;
    G8_STAGE(G8_SB(1, 0), cB + kstep, voffB[0], voffB[1]); G8_STAGE(G8_SA(1, 0), A + kstep, va00, va01); G8_STAGE(G8_SB(1, 1), cB + hstep + kstep, voffB[0], voffB[1]);
    G8_WAIT_V(6); G8_BAR;
    for (;;) {
        const bool has_next = S.next(ui + 1, nxt);
        const char* nB = has_next ? nxt.B : cB;
        if (has_next) {
            vn00 = (S.arow(nxt, Rr[0]) * (unsigned)K + (unsigned)Cc[0]) * 2u; vn01 = (S.arow(nxt, Rr[1]) * (unsigned)K + (unsigned)Cc[1]) * 2u;
            vn10 = (S.arow(nxt, HALF + Rr[0]) * (unsigned)K + (unsigned)Cc[0]) * 2u; vn11 = (S.arow(nxt, HALF + Rr[1]) * (unsigned)K + (unsigned)Cc[1]) * 2u;
        }
        for (int t = 0; t < nt; t += 2) {
            const bool last = (t == nt - 2);
            const char* a1 = A + (size_t)(t + 1) * kstep;
            const char* a2 = last ? A : A + (size_t)(t + 2) * kstep; const char* b2 = last ? nB : cB + (size_t)(t + 2) * kstep;
            const char* a3 = a2 + kstep; const char* b3 = b2 + kstep;
            const unsigned w00 = last ? vn00 : va00, w01 = last ? vn01 : va01, w10 = last ? vn10 : va10, w11 = last ? vn11 : va11;
            G8_LDB(B0, 0, 0); G8_SCHED; G8_LDA(At, 0, 0); G8_STAGE(G8_SA(1, 1), a1, va10, va11);
            G8_WAIT_L(8); G8_BAR; G8_WAIT_L(0); G8_MMA(0, 0, At, B0); G8_BAR; G8_SCHED;
            G8_LDB(B1, 0, 1); G8_STAGE(G8_SB(0, 0), b2, voffB[0], voffB[1]);
            G8_BAR; G8_WAIT_L(0); G8_MMA(0, 1, At, B1); G8_BAR;
            G8_LDA(At, 0, 1); G8_STAGE(G8_SA(0, 0), a2, w00, w01);
            G8_BAR; G8_WAIT_L(0); G8_MMA(1, 0, At, B0); G8_BAR; G8_SCHED;
            G8_STAGE(G8_SB(0, 1), b2 + hstep, voffB[0], voffB[1]);
            G8_WAIT_V(6); G8_BAR; G8_MMA(1, 1, At, B1); G8_BAR;
            G8_LDB(B0, 1, 0); G8_SCHED; G8_LDA(At, 1, 0); G8_STAGE(G8_SA(0, 1), a2, w10, w11);
            G8_WAIT_L(8); G8_BAR; G8_WAIT_L(0); G8_MMA(0, 0, At, B0); G8_BAR; G8_SCHED;
            G8_LDB(B1, 1, 1); G8_STAGE(G8_SB(1, 0), b3, voffB[0], voffB[1]);
            G8_BAR; G8_WAIT_L(0); G8_MMA(0, 1, At, B1); G8_BAR;
            G8_LDA(At, 1, 1); G8_STAGE(G8_SA(1, 0), a3, w00, w01);
            G8_BAR; G8_WAIT_L(0); G8_MMA(1, 0, At, B0); G8_BAR; G8_SCHED;
            G8_STAGE(G8_SB(1, 1), b3 + hstep, voffB[0], voffB[1]);
            G8_WAIT_V(6); G8_BAR; G8_MMA(1, 1, At, B1); G8_BAR;
        }
        if constexpr (FP8) asm volatile("s_nop 15\n\ts_nop 15" ::: "memory");
        E(acc, cur, wr, wc, fr, fq);
        if (!has_next) break;
#pragma unroll
        for (int a = 0; a < 2; ++a)
#pragma unroll
            for (int b = 0; b < 2; ++b)
#pragma unroll
                for (int m = 0; m < 4; ++m)
#pragma unroll
                    for (int n = 0; n < 2; ++n) acc[a][b][m][n] = (f32x4){0.f, 0.f, 0.f, 0.f};
        cur = nxt; cB = nB; va00 = vn00; va01 = vn01; va10 = vn10; va11 = vn11; ++ui;
    }
    G8_WAIT_V(0);
    if (wr == 0) G8_BAR;
    G8_BAR;
#undef G8_SA
#undef G8_SB
#undef G8_STAGE
#undef G8_LDA
#undef G8_LDB
#undef G8_MMA
#undef G8_WAIT_V
#undef G8_WAIT_L
#undef G8_BAR
#undef G8_SCHED
}

struct DenseSched {
    const char* Bt; int K, nM, nN, nwg, G, c;
    __device__ void init(const void* Bt_, int M, int N, int K_, int G_, int c_) { Bt = (const char*)Bt_; K = K_; nM = M / BM; nN = N / BM; nwg = nM * nN; G = G_; c = c_; }
    __device__ bool next(int i, Unit& u) const {
        const long L = (long)i * G + c; if (L >= nwg) return false;
        int wgid = (int)L; { const int q = nwg / 8, r = nwg % 8, xcd = wgid % 8, off = wgid / 8; wgid = (xcd < r ? xcd * (q + 1) : r * (q + 1) + (xcd - r) * q) + off; }
        const int nig = 8 * nN, gid = wgid / nig, fm = gid * 8, gsz = (nM - fm) < 8 ? (nM - fm) : 8;
        u.pm = fm + ((wgid % nig) % gsz); u.pn = (wgid % nig) / gsz; u.g = 0; u.rowbase = (unsigned)u.pm * BM;
        u.B = Bt + (size_t)u.pn * BM * K * 2; return true;
    }
    __device__ __forceinline__ unsigned arow(const Unit& u, int r) const { return u.rowbase + (unsigned)r; }
};
struct Moe1Sched {
    const char* W; const int* rowmap; int G, c;
    __device__ bool next(int i, Unit& u) const {
        const long L = (long)i * G + c; if (L >= NEXP * 512) return false;
        const int e = (int)(L / 512), w = (int)(L % 512), cc = w % 256, r = w / 256, xcd = cc % 8, j = cc / 8;
        const int mt = xcd * 4 + (j & 3), nt_ = r * 8 + (j >> 2), b = mt >> 1;
        u.pm = mt & 1; u.pn = nt_; u.g = b * NEXP + e; u.rowbase = (unsigned)u.g * CAP + (unsigned)u.pm * BM;
        u.B = W + ((size_t)e * 2 * DFF + (size_t)nt_ * BM) * DM; return true;
    }
    __device__ __forceinline__ unsigned arow(const Unit& u, int r) const { return (unsigned)rowmap[u.rowbase + r]; }
};
struct Moe2Sched {
    const char* W; int G, c;
    __device__ bool next(int i, Unit& u) const {
        const long L = (long)i * G + c; if (L >= NEXP * 128) return false;
        const int e = (int)(L / 128), w = (int)(L % 128), xcd = w % 8, j = w / 8;
        const int mt = xcd * 4 + (j & 3), nt_ = j >> 2, b = mt >> 1;
        u.pm = mt & 1; u.pn = nt_; u.g = b * NEXP + e; u.rowbase = (unsigned)u.g * CAP + (unsigned)u.pm * BM;
        u.B = W + ((size_t)e * DM + (size_t)nt_ * BM) * DFF; return true;
    }
    __device__ __forceinline__ unsigned arow(const Unit& u, int r) const { return u.rowbase + (unsigned)r; }
};

typedef const f32x4 (&AccRef)[2][2][4][2];
struct EpiQKVG {
    static constexpr bool PERM = true;
    h16* qkvg; float* codes;
    __device__ __forceinline__ void operator()(AccRef acc, const Unit& u, int wr, int wc, int fr, int fq) const {
        const int row0 = u.pm * BM + wr * 64 + fr;
        if (u.pn < 6) {
#pragma unroll
            for (int ai = 0; ai < 2; ++ai)
#pragma unroll
                for (int m = 0; m < 4; ++m) { h16* rowp = qkvg + (size_t)(row0 + ai * HALF + m * 16) * 1536 + u.pn * BM + wc * 32 + 8 * fq;
#pragma unroll
                    for (int bj = 0; bj < 2; ++bj) { const f32x4 v0 = acc[ai][bj][m][0], v1 = acc[ai][bj][m][1];
                        u32x4 w; w.x = pack_h2(v0[0], v0[1]); w.y = pack_h2(v0[2], v0[3]); w.z = pack_h2(v1[0], v1[1]); w.w = pack_h2(v1[2], v1[3]);
                        *(u32x4*)(rowp + bj * HALF) = w; } }
        } else if (wc == 0) {
#pragma unroll
            for (int ai = 0; ai < 2; ++ai)
#pragma unroll
                for (int m = 0; m < 4; ++m) { float* rowp = codes + (size_t)(row0 + ai * HALF + m * 16) * 32 + 8 * fq;
                    *(f32x4*)(rowp) = acc[ai][0][m][0]; *(f32x4*)(rowp + 4) = acc[ai][0][m][1]; }
        }
    }
};
struct EpiH16 {
    static constexpr bool PERM = true;
    h16* C; int ldc;
    __device__ __forceinline__ void operator()(AccRef acc, const Unit& u, int wr, int wc, int fr, int fq) const {
        const int row0 = u.pm * BM + wr * 64 + fr;
#pragma unroll
        for (int ai = 0; ai < 2; ++ai)
#pragma unroll
            for (int m = 0; m < 4; ++m) { h16* rowp = C + (size_t)(row0 + ai * HALF + m * 16) * ldc + u.pn * BM + wc * 32 + 8 * fq;
#pragma unroll
                for (int bj = 0; bj < 2; ++bj) { const f32x4 v0 = acc[ai][bj][m][0], v1 = acc[ai][bj][m][1];
                    u32x4 w; w.x = pack_h2(v0[0], v0[1]); w.y = pack_h2(v0[2], v0[3]); w.z = pack_h2(v1[0], v1[1]); w.w = pack_h2(v1[2], v1[3]);
                    *(u32x4*)(rowp + bj * HALF) = w; } }
    }
};
struct EpiResid {
    static constexpr bool PERM = false;
    const float* X; float* R;
    __device__ __forceinline__ void operator()(AccRef acc, const Unit& u, int wr, int wc, int fr, int fq) const {
        const int row0 = u.pm * BM + wr * 64 + fr, col0 = u.pn * BM + wc * 32 + 4 * fq;
#pragma unroll
        for (int ai = 0; ai < 2; ++ai)
#pragma unroll
            for (int m = 0; m < 4; ++m) { const size_t off = (size_t)(row0 + ai * HALF + m * 16) * DM + col0;
#pragma unroll
                for (int bj = 0; bj < 2; ++bj)
#pragma unroll
                    for (int n = 0; n < 2; ++n) { const f32x4 xv = *(const f32x4*)(X + off + bj * HALF + n * 16); *(f32x4*)(R + off + bj * HALF + n * 16) = xv + acc[ai][bj][m][n]; } }
    }
};
struct EpiHid {
    static constexpr bool PERM = true;
    unsigned char* hid;
    __device__ __forceinline__ void operator()(AccRef acc, const Unit& u, int wr, int wc, int fr, int fq) const {
        const unsigned row0 = u.rowbase + wr * 64 + fr;
#pragma unroll
        for (int ai = 0; ai < 2; ++ai)
#pragma unroll
            for (int m = 0; m < 4; ++m) { unsigned char* rowp = hid + (size_t)(row0 + ai * HALF + m * 16) * DFF + u.pn * HALF + wc * 32 + 8 * fq;
                constexpr float ws_ = 1.0f / (float)(1 << FP8_WSHIFT);
                const f32x4 g0 = acc[ai][0][m][0] * ws_, g1 = acc[ai][0][m][1] * ws_, u0 = acc[ai][1][m][0] * ws_, u1 = acc[ai][1][m][1] * ws_;
                u32x2 w; w.x = pack_fp8x4(siluf_(g0[0]) * u0[0], siluf_(g0[1]) * u0[1], siluf_(g0[2]) * u0[2], siluf_(g0[3]) * u0[3]);
                w.y = pack_fp8x4(siluf_(g1[0]) * u1[0], siluf_(g1[1]) * u1[1], siluf_(g1[2]) * u1[2], siluf_(g1[3]) * u1[3]);
                *(u32x2*)rowp = w; }
    }
};
struct EpiDown {
    static constexpr bool PERM = true;
    h16* Y; const float* selgate;
    __device__ __forceinline__ void operator()(AccRef acc, const Unit& u, int wr, int wc, int fr, int fq) const {
        const unsigned row0 = u.rowbase + wr * 64 + fr;
#pragma unroll
        for (int ai = 0; ai < 2; ++ai)
#pragma unroll
            for (int m = 0; m < 4; ++m) { const unsigned sr = row0 + ai * HALF + m * 16; const float gt = selgate[sr] * (1.0f / (float)(1 << FP8_WSHIFT));
                h16* rowp = Y + (size_t)sr * DM + u.pn * BM + wc * 32 + 8 * fq;
#pragma unroll
                for (int bj = 0; bj < 2; ++bj) { const f32x4 v0 = acc[ai][bj][m][0] * gt, v1 = acc[ai][bj][m][1] * gt;
                    u32x4 w; w.x = pack_h2(v0[0], v0[1]); w.y = pack_h2(v0[2], v0[3]); w.z = pack_h2(v1[0], v1[1]); w.w = pack_h2(v1[2], v1[3]);
                    *(u32x4*)(rowp + bj * HALF) = w; } }
    }
};
struct EpiPle {
    static constexpr bool PERM = false;
    const h16* H3; const float* rstd3; const float* lnw; const h16* PP; h16* R3H; float* rowsq;
    __device__ __forceinline__ void operator()(AccRef acc, const Unit& u, int wr, int wc, int fr, int fq) const {
        const int row0 = u.pm * BM + wr * 64 + fr, col0 = u.pn * BM + wc * 32 + 4 * fq;
        f32x4 winv[2][2];
#pragma unroll
        for (int bj = 0; bj < 2; ++bj)
#pragma unroll
            for (int n = 0; n < 2; ++n) { const f32x4 wv = *(const f32x4*)(lnw + col0 + bj * HALF + n * 16);
#pragma unroll
                for (int j = 0; j < 4; ++j) winv[bj][n][j] = 1.0f / wv[j]; }
#pragma unroll
        for (int ai = 0; ai < 2; ++ai)
#pragma unroll
            for (int m = 0; m < 4; ++m) { const int row = row0 + ai * HALF + m * 16; const size_t off = (size_t)row * DM + col0;
                const float inv = 1.0f / rstd3[row]; float sq = 0.f;
#pragma unroll
                for (int bj = 0; bj < 2; ++bj)
#pragma unroll
                    for (int n = 0; n < 2; ++n) { const size_t o2 = off + bj * HALF + n * 16; const h16x4 hv = *(const h16x4*)(H3 + o2), pv = *(const h16x4*)(PP + o2);
                        const f32x4 a = acc[ai][bj][m][n]; float o[4];
#pragma unroll
                        for (int j = 0; j < 4; ++j) { o[j] = (float)hv[j] * inv * winv[bj][n][j] + sigmoidf_(a[j]) * (float)pv[j]; sq += o[j] * o[j]; }
                        u32x2 w; w.x = pack_h2(o[0], o[1]); w.y = pack_h2(o[2], o[3]); *(u32x2*)(R3H + o2) = w; }
                sq += __shfl_xor(sq, 16); sq += __shfl_xor(sq, 32);
                if (fq == 0) unsafeAtomicAdd(rowsq + row, sq); }
    }
};
}

template <class ColPtr>
__device__ void cvt_transpose(LAS unsigned char* lds, h16* dst, int N, int K, int src_ld, ColPtr cp, int blk, int nblk) {
    const int tid = threadIdx.x, w = tid >> 6, l = tid & 63, nq = tid & 31, kp = tid >> 5;
    const int ktiles = K / 256, ntiles = (N / 128) * ktiles;
    for (int t = blk; t < ntiles; t += nblk) {
        const int n0 = (t / ktiles) * 128, k0 = (t % ktiles) * 256;
        const float* sp = cp(n0 + (nq >> 3) * 32);
        f32x4 va[8], vb[8];
#pragma unroll
        for (int ps = 0; ps < 8; ++ps) {
            const int kk = 2 * (kp + 16 * ps);
            if (sp) { va[ps] = *(const f32x4*)(sp + (size_t)(k0 + kk) * src_ld + ((4 * nq) & 31)); vb[ps] = *(const f32x4*)(sp + (size_t)(k0 + kk + 1) * src_ld + ((4 * nq) & 31)); }
            else { va[ps] = (f32x4){0.f, 0.f, 0.f, 0.f}; vb[ps] = va[ps]; }
        }
        __syncthreads();
        const int sv = (nq & 15) << 1;
#pragma unroll
        for (int ps = 0; ps < 8; ++ps) { const int d = kp + 16 * ps;
#pragma unroll
            for (int j = 0; j < 4; ++j) *(LAS unsigned*)(lds + (4 * nq + j) * 512 + ((d ^ sv) << 2)) = pack_h2(va[ps][j], vb[ps][j]); }
        __syncthreads();
#pragma unroll 4
        for (int r = 0; r < 16; ++r) { const int row = w * 16 + r, rv = ((row >> 2) & 15) << 1;
            const u32x2 x = *(const LAS u32x2*)(lds + row * 512 + (((2 * l) ^ rv) << 2));
            *(u32x2*)(dst + (size_t)(n0 + row) * K + k0 + 4 * l) = x; }
    }
}

template <class ColPtr>
__device__ void cvt_transpose_fp8(LAS unsigned char* lds, unsigned char* dst, int N, int K, int src_ld, float scale, ColPtr cp, int blk, int nblk) {
    const int tid = threadIdx.x, w = tid >> 6, l = tid & 63, nq = tid & 31, kq = tid >> 5;
    const int ktiles = K / 256, ntiles = (N / 128) * ktiles;
    for (int t = blk; t < ntiles; t += nblk) {
        const int n0 = (t / ktiles) * 128, k0 = (t % ktiles) * 256;
        const float* sp = cp(n0 + (nq >> 3) * 32);
        f32x4 v[4][4];
#pragma unroll
        for (int ps = 0; ps < 4; ++ps)
#pragma unroll
            for (int q = 0; q < 4; ++q) v[ps][q] = *(const f32x4*)(sp + (size_t)(k0 + 4 * (kq + 16 * ps) + q) * src_ld + ((4 * nq) & 31));
        __syncthreads();
        const int sv = (nq & 15) << 1;
#pragma unroll
        for (int ps = 0; ps < 4; ++ps) { const int d = kq + 16 * ps;
#pragma unroll
            for (int j = 0; j < 4; ++j) *(LAS unsigned*)(lds + (4 * nq + j) * 256 + ((d ^ sv) << 2)) = pack_fp8x4(v[ps][0][j] * scale, v[ps][1][j] * scale, v[ps][2][j] * scale, v[ps][3][j] * scale); }
        __syncthreads();
#pragma unroll 4
        for (int r = 0; r < 16; ++r) { const int row = w * 16 + r, rv = ((row >> 2) & 15) << 1;
            const unsigned x = *(const LAS unsigned*)(lds + row * 256 + ((l ^ rv) << 2));
            *(unsigned*)(dst + (size_t)(n0 + row) * K + k0 + 4 * l) = x; }
    }
}

__device__ void phase_prep(const Args& a, LAS unsigned char* lds, int blk, int nblk) {
    unsigned char* ws = a.ws;
    const int tid = threadIdx.x;
    if (blk == 0 && tid < 64) ((unsigned*)(ws + OFF_CTR))[tid] = 0u;
    { const float* w = a.in[I_WIN]; cvt_transpose(lds, (h16*)(ws + OFF_WINA), NA1, DM, INCOLS, [=](int n0) { return n0 < 1568 ? w + n0 : (const float*)nullptr; }, blk, nblk); }
    { const float* w = a.in[I_WIN]; cvt_transpose(lds, (h16*)(ws + OFF_WINHY), HYC, DM, INCOLS, [=](int n0) { return w + 1568 + n0; }, blk, nblk); }
    { const float* w = a.in[I_WOUT]; cvt_transpose(lds, (h16*)(ws + OFF_WOUT), DM, DM, DM, [=](int n0) { return w + n0; }, blk, nblk); }
    for (int e = 0; e < NEXP; ++e) {
        const float* wg = a.in[I_WGATE] + (size_t)e * DM * DFF; const float* wu = a.in[I_WUP] + (size_t)e * DM * DFF;
        cvt_transpose_fp8(lds, ws + OFF_WGU + (size_t)e * 2 * DFF * DM, 2 * DFF, DM, DFF, (float)(1 << FP8_WSHIFT),
                      [=](int n0) { const int tile = n0 >> 8, within = n0 & 255, f = tile * 128 + (within & 127); return (within >> 7) ? wu + f : wg + f; }, blk, nblk);
    }
    for (int e = 0; e < NEXP; ++e) {
        const float* wd = a.in[I_WDOWN] + (size_t)e * DFF * DM;
        cvt_transpose_fp8(lds, ws + OFF_WD + (size_t)e * DM * DFF, DM, DFF, DM, (float)(1 << FP8_WSHIFT), [=](int n0) { return wd + n0; }, blk, nblk);
    }
    { const float* w = a.in[I_WPG]; cvt_transpose(lds, (h16*)(ws + OFF_WG), DM, DM, DM, [=](int n0) { return w + n0; }, blk, nblk); }
    { const float* w = a.in[I_WPP]; cvt_transpose(lds, (h16*)(ws + OFF_WP), DM, 256, DM, [=](int n0) { return w + n0; }, blk, nblk); }
    { const f32x4* p = (const f32x4*)a.in[I_P]; u32x2* d = (u32x2*)(ws + OFF_P16); const size_t n4 = (size_t)NTOK * 256 / 4;
        for (size_t i = (size_t)blk * NTHREADS + tid; i < n4; i += (size_t)nblk * NTHREADS) { const f32x4 v = p[i]; u32x2 o; o.x = pack_h2(v[0], v[1]); o.y = pack_h2(v[2], v[3]); d[i] = o; } }
}

__device__ void phase_rmsnorm_h16(const float* X, const float* w, h16* H, int blk, int nblk) {
    constexpr int RP = 4;
    const int lane = threadIdx.x & 63, gw = blk * 8 + (threadIdx.x >> 6), nw = nblk * 8;
    f32x4 wv[4];
#pragma unroll
    for (int j = 0; j < 4; ++j) wv[j] = *(const f32x4*)(w + j * 256 + lane * 4);
    for (int row0 = gw * RP; row0 < NTOK; row0 += nw * RP) {
        f32x4 v[RP][4];
#pragma unroll
        for (int r = 0; r < RP; ++r)
#pragma unroll
            for (int j = 0; j < 4; ++j) v[r][j] = *(const f32x4*)(X + (size_t)(row0 + r) * DM + j * 256 + lane * 4);
#pragma unroll
        for (int r = 0; r < RP; ++r) {
            float ss = 0.f;
#pragma unroll
            for (int j = 0; j < 4; ++j) ss += v[r][j][0] * v[r][j][0] + v[r][j][1] * v[r][j][1] + v[r][j][2] * v[r][j][2] + v[r][j][3] * v[r][j][3];
            ss = wave_sum(ss);
            const float rstd = rsqrtf(ss * (1.0f / DM) + EPS);
            h16* hp = H + (size_t)(row0 + r) * DM;
#pragma unroll
            for (int j = 0; j < 4; ++j) { u32x2 o; o.x = pack_h2(v[r][j][0] * rstd * wv[j][0], v[r][j][1] * rstd * wv[j][1]); o.y = pack_h2(v[r][j][2] * rstd * wv[j][2], v[r][j][3] * rstd * wv[j][3]);
                *(u32x2*)(hp + j * 256 + lane * 4) = o; }
        }
    }
}

__device__ void phase_combine_norm(const float* R, const h16* Y, const int* slotmap, const float* w, h16* H, float* rstd3, float* rowsq, int blk, int nblk) {
    constexpr int RP = 2;
    const int lane = threadIdx.x & 63, gw = blk * 8 + (threadIdx.x >> 6), nw = nblk * 8;
    f32x4 wv[4];
#pragma unroll
    for (int j = 0; j < 4; ++j) wv[j] = *(const f32x4*)(w + j * 256 + lane * 4);
    for (int row0 = gw * RP; row0 < NTOK; row0 += nw * RP) {
        f32x4 v[RP][4]; int myslot[RP];
#pragma unroll
        for (int r = 0; r < RP; ++r) {
            myslot[r] = (lane < NEXP) ? slotmap[(size_t)(row0 + r) * NEXP + lane] : -1;
#pragma unroll
            for (int j = 0; j < 4; ++j) v[r][j] = *(const f32x4*)(R + (size_t)(row0 + r) * DM + j * 256 + lane * 4);
        }
#pragma unroll
        for (int r = 0; r < RP; ++r) {
            unsigned long long mask = __ballot(myslot[r] >= 0);
            const int b = (row0 + r) / SEQ;
            while (mask) {
                const int e = __builtin_ctzll(mask); mask &= mask - 1;
                const int sl = __shfl(myslot[r], e);
                const h16* yp = Y + ((size_t)(b * NEXP + e) * CAP + sl) * DM;
                h16x4 y4[4];
#pragma unroll
                for (int j = 0; j < 4; ++j) y4[j] = *(const h16x4*)(yp + j * 256 + lane * 4);
#pragma unroll
                for (int j = 0; j < 4; ++j)
#pragma unroll
                    for (int q = 0; q < 4; ++q) v[r][j][q] += (float)y4[j][q];
            }
        }
#pragma unroll
        for (int r = 0; r < RP; ++r) {
            float ss = 0.f;
#pragma unroll
            for (int j = 0; j < 4; ++j) { ss += v[r][j][0] * v[r][j][0] + v[r][j][1] * v[r][j][1] + v[r][j][2] * v[r][j][2] + v[r][j][3] * v[r][j][3]; }
            ss = wave_sum(ss);
            const float rstd = rsqrtf(ss * (1.0f / DM) + EPS);
            if (lane == 0) { rstd3[row0 + r] = rstd; rowsq[row0 + r] = 0.f; }
            h16* hp = H + (size_t)(row0 + r) * DM;
#pragma unroll
            for (int j = 0; j < 4; ++j) { u32x2 o; o.x = pack_h2(v[r][j][0] * rstd * wv[j][0], v[r][j][1] * rstd * wv[j][1]); o.y = pack_h2(v[r][j][2] * rstd * wv[j][2], v[r][j][3] * rstd * wv[j][3]);
                *(u32x2*)(hp + j * 256 + lane * 4) = o; }
        }
    }
}

__device__ void phase_final_norm(const h16* R3H, const float* rowsq, const float* w, float* out, int blk, int nblk) {
    constexpr int RP = 4;
    const int lane = threadIdx.x & 63, gw = blk * 8 + (threadIdx.x >> 6), nw = nblk * 8;
    f32x4 wv[4];
#pragma unroll
    for (int j = 0; j < 4; ++j) wv[j] = *(const f32x4*)(w + j * 256 + lane * 4);
    for (int row0 = gw * RP; row0 < NTOK; row0 += nw * RP) {
        h16x4 v[RP][4]; float sq[RP];
#pragma unroll
        for (int r = 0; r < RP; ++r) { sq[r] = rowsq[row0 + r];
#pragma unroll
            for (int j = 0; j < 4; ++j) v[r][j] = *(const h16x4*)(R3H + (size_t)(row0 + r) * DM + j * 256 + lane * 4); }
#pragma unroll
        for (int r = 0; r < RP; ++r) {
            const float rstd = rsqrtf(sq[r] * (1.0f / DM) + EPS);
#pragma unroll
            for (int j = 0; j < 4; ++j) { f32x4 o;
#pragma unroll
                for (int q = 0; q < 4; ++q) o[q] = (float)v[r][j][q] * rstd * wv[j][q];
                *(f32x4*)(out + (size_t)(row0 + r) * DM + j * 256 + lane * 4) = o; }
        }
    }
}

__device__ void phase_router(const float* R, const float* w, const float* wrouter, unsigned char* H8, float* probs, LAS unsigned char* lds, int blk, int nblk) {
    constexpr int RP = 2;
    LAS float* wrT = (LAS float*)lds;
    const int tid = threadIdx.x, lane = tid & 63, gw = blk * 8 + (tid >> 6), nw = nblk * 8;
    __syncthreads();
    { float tmp[32];
#pragma unroll
        for (int q = 0; q < 32; ++q) { const int i = tid + NTHREADS * q, e = i >> 10, k = i & 1023; tmp[q] = wrouter[k * NEXP + e]; }
#pragma unroll
        for (int q = 0; q < 32; ++q) wrT[tid + NTHREADS * q] = tmp[q]; }
    __syncthreads();
    f32x4 wv[4];
#pragma unroll
    for (int j = 0; j < 4; ++j) wv[j] = *(const f32x4*)(w + j * 256 + lane * 4);
    const bool b5 = lane & 32, b4 = lane & 16, b3 = lane & 8, b2 = lane & 4;
    const int mye = (b5 ? 8 : 0) + (b4 ? 4 : 0) + (b3 ? 2 : 0) + (b2 ? 1 : 0);
    for (int row0 = gw * RP; row0 < NTOK; row0 += nw * RP) {
        f32x4 v[RP][4];
#pragma unroll
        for (int r = 0; r < RP; ++r)
#pragma unroll
            for (int j = 0; j < 4; ++j) v[r][j] = *(const f32x4*)(R + (size_t)(row0 + r) * DM + j * 256 + lane * 4);
#pragma unroll
        for (int r = 0; r < RP; ++r) {
            float ss = 0.f;
#pragma unroll
            for (int j = 0; j < 4; ++j) ss += v[r][j][0] * v[r][j][0] + v[r][j][1] * v[r][j][1] + v[r][j][2] * v[r][j][2] + v[r][j][3] * v[r][j][3];
            ss = wave_sum(ss);
            const float rstd = rsqrtf(ss * (1.0f / DM) + EPS);
            unsigned char* hp = H8 + (size_t)(row0 + r) * DM;
#pragma unroll
            for (int j = 0; j < 4; ++j) { v[r][j] = v[r][j] * rstd * wv[j]; *(unsigned*)(hp + j * 256 + lane * 4) = pack_fp8x4(v[r][j][0], v[r][j][1], v[r][j][2], v[r][j][3]); }
        }
        float s8a[RP][8];
#pragma unroll
        for (int i = 0; i < 8; ++i) { asm volatile("" ::: "memory");
            f32x4 wa4[4], wb4[4];
#pragma unroll
            for (int j = 0; j < 4; ++j) { wa4[j] = *(const LAS f32x4*)(wrT + i * DM + j * 256 + lane * 4); wb4[j] = *(const LAS f32x4*)(wrT + (i + 8) * DM + j * 256 + lane * 4); }
#pragma unroll
            for (int r = 0; r < RP; ++r) { float sa = 0.f, sb = 0.f;
#pragma unroll
                for (int j = 0; j < 4; ++j) { sa += v[r][j][0] * wa4[j][0] + v[r][j][1] * wa4[j][1] + v[r][j][2] * wa4[j][2] + v[r][j][3] * wa4[j][3];
                                              sb += v[r][j][0] * wb4[j][0] + v[r][j][1] * wb4[j][1] + v[r][j][2] * wb4[j][2] + v[r][j][3] * wb4[j][3]; }
                const float send = b5 ? sa : sb, keep = b5 ? sb : sa; s8a[r][i] = keep + __shfl_xor(send, 32); } }
#pragma unroll
        for (int r = 0; r < RP; ++r) {
            float s8[8], s4[4], s2[2], lg;
#pragma unroll
            for (int i = 0; i < 8; ++i) s8[i] = s8a[r][i];
#pragma unroll
            for (int i = 0; i < 4; ++i) { const float send = b4 ? s8[i] : s8[i + 4], keep = b4 ? s8[i + 4] : s8[i]; s4[i] = keep + __shfl_xor(send, 16); }
#pragma unroll
            for (int i = 0; i < 2; ++i) { const float send = b3 ? s4[i] : s4[i + 2], keep = b3 ? s4[i + 2] : s4[i]; s2[i] = keep + __shfl_xor(send, 8); }
            { const float send = b2 ? s2[0] : s2[1], keep = b2 ? s2[1] : s2[0]; lg = keep + __shfl_xor(send, 4); }
            lg += __shfl_xor(lg, 1); lg += __shfl_xor(lg, 2);
            float mx = lg;
#pragma unroll
            for (int o = 4; o <= 32; o <<= 1) mx = fmaxf(mx, __shfl_xor(mx, o));
            const float ex = expf(lg - mx); float den = ex;
#pragma unroll
            for (int o = 4; o <= 32; o <<= 1) den += __shfl_xor(den, o);
            if ((lane & 3) == 0) { const int row = row0 + r, b = row / SEQ, t = row % SEQ; probs[((size_t)b * NEXP + mye) * SEQ + t] = ex / den; }
        }
    }
}

__device__ void phase_topk(const float* probs, int* selidx, float* selgate, int* slotmap, LAS unsigned char* lds, int blk, int nblk) {
    LAS int* hist = (LAS int*)lds;
    LAS int* red = hist + 256;
    const int tid = threadIdx.x, lane = tid & 63, wid = tid >> 6;
    for (int g = blk; g < NB * NEXP; g += nblk) {
        const float* pp = probs + (size_t)g * SEQ;
        unsigned key[8]; float pv[8];
        { const f32x4 a = *(const f32x4*)(pp + tid * 8), b = *(const f32x4*)(pp + tid * 8 + 4);
#pragma unroll
          for (int j = 0; j < 4; ++j) { pv[j] = a[j]; pv[4 + j] = b[j]; }
#pragma unroll
          for (int j = 0; j < 8; ++j) key[j] = __float_as_uint(pv[j]); }
        unsigned prefix = 0; int krem = CAP;
#pragma unroll 1
        for (int ps = 0; ps < 4; ++ps) {
            const int shift = ps == 0 ? 23 : ps == 1 ? 15 : ps == 2 ? 7 : 0, bits = ps == 3 ? 7 : 8;
            const unsigned mhi = ~((1u << (shift + bits)) - 1u), dmask = (1u << bits) - 1u;
            __syncthreads();
            if (tid < 256) hist[tid] = 0;
            __syncthreads();
#pragma unroll
            for (int j = 0; j < 8; ++j) if ((key[j] & mhi) == (prefix & mhi)) __hip_atomic_fetch_add(hist + ((key[j] >> shift) & dmask), 1, __ATOMIC_RELAXED, __HIP_MEMORY_SCOPE_WORKGROUP);
            __syncthreads();
            if (wid == 0) {
                int c[4], tot = 0;
#pragma unroll
                for (int q = 0; q < 4; ++q) { c[q] = hist[4 * lane + q]; tot += c[q]; }
                int S = tot;
#pragma unroll
                for (int o = 1; o < 64; o <<= 1) { const int t = __shfl_down(S, o); if (lane + o < 64) S += t; }
                const int above = S - tot;
                if (above < krem && krem <= S) {
                    int acc = above, dsel = 4 * lane, kn = krem; bool done = false;
#pragma unroll
                    for (int q = 3; q >= 0; --q) { if (!done && acc + c[q] >= krem) { dsel = 4 * lane + q; kn = krem - acc; done = true; } if (!done) acc += c[q]; }
                    red[0] = dsel; red[1] = kn;
                }
            }
            __syncthreads();
            prefix |= (unsigned)red[0] << shift; krem = red[1];
        }
        int cgt = 0, ceq = 0;
#pragma unroll
        for (int j = 0; j < 8; ++j) { cgt += (key[j] > prefix) ? 1 : 0; ceq += (key[j] == prefix) ? 1 : 0; }
        int sg = cgt, se = ceq;
#pragma unroll
        for (int o = 1; o < 64; o <<= 1) { const int a = __shfl_up(sg, o), b = __shfl_up(se, o); if (lane >= o) { sg += a; se += b; } }
        __syncthreads();
        if (lane == 63) { red[32 + wid] = sg; red[48 + wid] = se; }
        __syncthreads();
        int bg = 0, be = 0;
#pragma unroll
        for (int w = 0; w < 8; ++w) { const int x = red[32 + w], y = red[48 + w]; if (w < wid) { bg += x; be += y; } }
        int pg = bg + sg - cgt, pe = be + se - ceq;
        const int need = krem;
#pragma unroll
        for (int j = 0; j < 8; ++j) {
            const bool gt = key[j] > prefix, eq = key[j] == prefix;
            const bool take = gt || (eq && pe < need);
            const int slot = pg + (pe < need ? pe : need);
            if (take) { selidx[(size_t)g * CAP + slot] = (g / NEXP) * SEQ + tid * 8 + j; selgate[(size_t)g * CAP + slot] = pv[j]; }
            slotmap[((size_t)(g / NEXP) * SEQ + tid * 8 + j) * NEXP + (g % NEXP)] = take ? slot : -1;
            pg += gt ? 1 : 0; pe += eq ? 1 : 0;
        }
    }
}

struct __attribute__((packed, aligned(2))) H8U { h16 v[8]; };
__device__ void phase_filters(const Args& a, h16* GR, LAS unsigned char* lds, int blk, int nblk) {
    constexpr int NP = 16;
    LAS float* z = (LAS float*)lds;
    LAS float* h1 = z + NP * 32;
    LAS float* h2 = h1 + NP * 64;
    const int tid = threadIdx.x;
    const float* w1 = a.in[I_FW1]; const float* b1 = a.in[I_FB1]; const float* fr1 = a.in[I_FFR1];
    const float* w2 = a.in[I_FW2]; const float* b2 = a.in[I_FB2]; const float* fr2 = a.in[I_FFR2];
    const float* w3 = a.in[I_FW3]; const float* hb = a.in[I_HBIAS];
    const float MIND = logf(1e-2f) / 1.5f, MAXD = logf(1e-2f) / 0.3f;
    for (int it = blk; it < SEQ / NP; it += nblk) {
        const int t0 = it * NP;
        __syncthreads();
        if (tid < NP * 17) { const int pos = tid / 17, i = tid % 17, t = t0 + pos; float v;
            if (i == 0) v = (float)t / (float)(SEQ - 1);
            else { const int bi = (i - 1) & 7; const float f = 1e-4f + (float)bi * ((7.0f - 1e-4f) / 7.0f); const float wp = 6.283185307179586f * (float)t / (float)SEQ; const float ang = f * wp;
                float sn, cs; sincos_f(ang, sn, cs); v = (i <= 8) ? cs : -sn; }
            z[pos * 32 + i] = v; }
        __syncthreads();
#pragma unroll
        for (int hf = 0; hf < NP / 8; ++hf) { const int pos = hf * 8 + (tid >> 6), j = tid & 63; float s = b1[j];
#pragma unroll
            for (int i = 0; i < 17; ++i) s += z[pos * 32 + i] * w1[i * 64 + j];
            h1[pos * 64 + j] = sin_f(fr1[j] * s); }
        __syncthreads();
#pragma unroll
        for (int hf = 0; hf < NP / 8; ++hf) { const int pos = hf * 8 + (tid >> 6), j = tid & 63; float s = b2[j];
#pragma unroll 16
            for (int i = 0; i < 64; ++i) s += h1[pos * 64 + i] * w2[i * 64 + j];
            h2[j * NP + pos] = sin_f(fr2[j] * s); }
        __syncthreads();
#pragma unroll 1
        for (int q = 0; q < 4; ++q) {
            const int col = q * 512 + tid; float acc[NP];
#pragma unroll
            for (int p = 0; p < NP; ++p) acc[p] = 0.f;
#pragma unroll 16
            for (int j = 0; j < 64; ++j) { const float wv = w3[j * 2048 + col];
#pragma unroll
                for (int p4 = 0; p4 < NP / 4; ++p4) { const f32x4 hv = *(const LAS f32x4*)(h2 + j * NP + p4 * 4);
#pragma unroll
                    for (int p = 0; p < 4; ++p) acc[p4 * 4 + p] += hv[p] * wv; } }
            const int o = col >> 10, dir = (col >> 9) & 1, c = col & 511;
            const float delta = fabsf(MIND + (float)c * ((MAXD - MIND) / 511.0f));
            h16* gp = GR + ((size_t)o * HYW + c) * 8192;
            float vals[NP];
#pragma unroll
            for (int p = 0; p < NP; ++p) { const int t = t0 + p; const float tl = (float)t / (float)(SEQ - 1); float v = acc[p] * expf(-tl * delta);
                if (dir == 0 && t == 0) v += hb[o * HYW + c];
                vals[p] = v * HY_SCALE; }
            if (dir == 0) {
                h16x8 lo, hi;
#pragma unroll
                for (int q = 0; q < 8; ++q) { lo[q] = (h16)vals[15 - q]; hi[q] = (h16)vals[7 - q]; }
                *(h16x8*)(gp + 4080 - t0) = lo; *(h16x8*)(gp + 4088 - t0) = hi;
            } else {
                H8U lo, hi;
#pragma unroll
                for (int q = 0; q < 8; ++q) { lo.v[q] = (h16)vals[q]; hi.v[q] = (h16)vals[8 + q]; }
                if (t0 == 0) {
#pragma unroll
                    for (int q = 1; q < 8; ++q) gp[4095 + q] = lo.v[q];
                    gp[8191] = (h16)0.f;
                } else *(H8U*)(gp + 4095 + t0) = lo;
                *(H8U*)(gp + 4095 + t0 + 8) = hi;
            }
        }
    }
}

constexpr int HY_ROW = 8192, HY_UIMG = 16 * HY_ROW, HY_RING = 24;
__device__ __forceinline__ int hy_uoff(int b, int s) { return b * HY_ROW + ((((s >> 3) ^ b) << 4) | ((s & 7) << 1)); }
#define HY_MFMA(acc_, a_, b_) asm volatile("v_mfma_f32_16x16x32_f16 %0, %1, %2, %0" : "+v"(acc_) : "v"(a_), "v"(b_))
__device__ void phase_hyena(const h16* __restrict__ hy, h16* __restrict__ z2, const h16* __restrict__ gr, const float* __restrict__ cw, const float* __restrict__ cb, unsigned* __restrict__ queue0, LAS unsigned char* lds, int reps) {
    const int tid = threadIdx.x, w = __builtin_amdgcn_readfirstlane(tid >> 6), l = tid & 63, bcol = l & 15, kg = l >> 4;
    LAS unsigned char* uimg = lds; LAS unsigned char* ring = lds + HY_UIMG;
    LAS int* qslot = (LAS int*)(lds + HY_UIMG + HY_RING * 1024);
    const int lbase = 4095 - (l & 15) + 8 * (l >> 4);
#pragma unroll 1
    for (int rep = 0; rep < reps; ++rep) {
    unsigned* queue = queue0 + rep;
    for (;;) {
        __syncthreads();
        if (tid == 0) *qslot = (int)atomicAdd(queue, 1u);
        __syncthreads();
        const int c = *qslot;
        if (c >= HYW) break;
        { const float w0 = cw[c], w1 = cw[HYC + c], w2 = cw[2 * HYC + c], bb = cb[c]; const int t0 = tid * 8;
#pragma unroll 4
            for (int b = 0; b < NB; ++b) {
                const h16* src = hy + (size_t)c * NTOK + (size_t)b * SEQ;
                const h16x8 rv = *(const h16x8*)(src + t0);
                const float rm = (t0 > 0) ? (float)src[t0 - 1] : 0.f, rp = (t0 + 8 < SEQ) ? (float)src[t0 + 8] : 0.f;
                float r[10]; r[0] = rm; r[9] = rp;
#pragma unroll
                for (int j = 0; j < 8; ++j) r[1 + j] = (float)rv[j];
                h16x8 o;
#pragma unroll
                for (int j = 0; j < 8; ++j) o[j] = (h16)(bb + w0 * r[j] + w1 * r[j + 1] + w2 * r[j + 2]);
                *(LAS h16x8*)(uimg + b * HY_ROW + ((tid ^ b) << 4)) = o;
            } }
#pragma unroll 1
        for (int o = 0; o < 2; ++o) {
            const h16* grp = gr + ((size_t)o * HYW + c) * 8192;
            f32x4 acc[8][4];
#pragma unroll
            for (int i = 0; i < 8; ++i)
#pragma unroll
                for (int m = 0; m < 4; ++m) acc[i][m] = (f32x4){0.f, 0.f, 0.f, 0.f};
            { const int phi = -256 + w; if (phi >= -254) { const H8U v0 = *(const H8U*)(grp + lbase - 16 * phi); *(LAS h16x8*)(ring + ((phi + 264) % HY_RING) * 1024 + l * 16) = __builtin_bit_cast(h16x8, v0); } }
            __syncthreads();
#pragma unroll 1
            for (int st = 0; st < 64; ++st) {
                const int d0 = -64 + 2 * st;
                h16x8 anext = {};
                const int phin = 4 * (d0 + 2) + w;
                if (st < 63) anext = __builtin_bit_cast(h16x8, *(const H8U*)(grp + lbase - 16 * phin));
                const int sbase = (4 * d0 - 2 + 264) % HY_RING;
#pragma unroll
                for (int dd = 0; dd < 2; ++dd) {
                    const int delta = d0 + dd;
                    if (delta >= -63) {
                        h16x8 A6[6];
#pragma unroll
                        for (int q = 0; q < 6; ++q) { int sl = sbase + 4 * dd + q; sl = sl >= HY_RING ? sl - HY_RING : sl; A6[q] = *(const LAS h16x8*)(ring + sl * 1024 + l * 16); }
#pragma unroll
                        for (int i = 0; i < 8; ++i) {
                            const int s1 = w + 8 * i - delta;
                            if ((unsigned)s1 < 64u) {
                                const int ch = 8 * s1 + kg;
                                const h16x8 B0 = *(const LAS h16x8*)(uimg + bcol * HY_ROW + ((ch ^ bcol) << 4)), B1 = *(const LAS h16x8*)(uimg + bcol * HY_ROW + (((ch + 4) ^ bcol) << 4));
                                __builtin_amdgcn_s_setprio(1);
#pragma unroll
                                for (int m = 0; m < 4; ++m) {
                                    HY_MFMA(acc[i][m], A6[m + 2], B0);
                                    HY_MFMA(acc[i][m], A6[m], B1);
                                }
                                __builtin_amdgcn_s_setprio(0);
                            }
                        }
                    }
                }
                if (st < 63) *(LAS h16x8*)(ring + ((phin + 264) % HY_RING) * 1024 + l * 16) = anext;
                __syncthreads();
            }
            asm volatile("s_nop 15\n\ts_nop 15" ::: "memory");
            const int ch = (o + 1) * HYW + c;
            const float w0 = cw[ch], w1 = cw[HYC + ch], w2 = cw[2 * HYC + ch], bb = cb[ch];
            int kg_e = kg, bcol_e = bcol; asm volatile("" : "+v"(kg_e), "+v"(bcol_e));
            const h16* xsrc = hy + (size_t)ch * NTOK + (size_t)bcol_e * SEQ;
#pragma unroll
            for (int i = 0; i < 8; ++i) {
                h16x4 xv[4]; h16 xm[4], xp[4];
#pragma unroll
                for (int m = 0; m < 4; ++m) {
                    const int t = 64 * (w + 8 * i) + 16 * m + 4 * kg_e;
                    xv[m] = *(const h16x4*)(xsrc + t);
                    xm[m] = (t > 0) ? xsrc[t - 1] : (h16)0.f; xp[m] = (t + 4 < SEQ) ? xsrc[t + 4] : (h16)0.f;
                }
#pragma unroll
                for (int m = 0; m < 4; ++m) {
                    const int t = 64 * (w + 8 * i) + 16 * m + 4 * kg_e;
                    float r[6]; r[0] = (float)xm[m]; r[5] = (float)xp[m];
#pragma unroll
                    for (int j = 0; j < 4; ++j) r[1 + j] = (float)xv[m][j];
                    h16x4 zo;
#pragma unroll
                    for (int j = 0; j < 4; ++j) zo[j] = (h16)((bb + w0 * r[j] + w1 * r[j + 1] + w2 * r[j + 2]) * acc[i][m][j] * (1.0f / HY_SCALE));
                    if (o == 0) *(LAS h16x4*)(uimg + hy_uoff(bcol_e, t)) = zo;
                    else *(h16x4*)(z2 + (size_t)c * NTOK + (size_t)bcol_e * SEQ + t) = zo;
                }
                    asm volatile("" ::: "memory");
                }
        }
    }
}
}

__device__ __forceinline__ float wave_incl_scan(float x) {
#define DPP_ADD(ctrl, rmask, bctl) x += __builtin_bit_cast(float, __builtin_amdgcn_update_dpp(0, __builtin_bit_cast(int, x), ctrl, rmask, 0xf, bctl))
    DPP_ADD(0x111, 0xf, true);
    DPP_ADD(0x112, 0xf, true);
    DPP_ADD(0x114, 0xf, true);
    DPP_ADD(0x118, 0xf, true);
    DPP_ADD(0x142, 0xa, false);
    DPP_ADD(0x143, 0xc, false);
#undef DPP_ADD
    return x;
}

constexpr int GL_QD = 0, GL_KI = 8192, GL_KDT = 16384, GL_P = 24576, GL_VT = 32768, GL_EDL = 49152, GL_WA = 49408, GL_BA = 53504, GL_QS = 54272, GL_KS = 62464, GL_VS = 70656, GL_CS = 87040;
__device__ __forceinline__ int gsw(int row, int col) { return row * 128 + ((((col >> 3) ^ (row & 7)) << 4) | ((col & 7) << 1)); }
#define GLA_BAR() do { asm volatile("s_waitcnt lgkmcnt(0)" ::: "memory"); __builtin_amdgcn_s_barrier(); asm volatile("" ::: "memory"); } while (0)
__device__ void phase_gla(const h16* __restrict__ qkvg, const float* __restrict__ codes, const float* __restrict__ waf, const float* __restrict__ baf,
                          const float* __restrict__ wab, const float* __restrict__ bab, h16* __restrict__ of, h16* __restrict__ ob, LAS unsigned char* lds, int first, int stride, int reps) {
    const int tid = threadIdx.x, w = __builtin_amdgcn_readfirstlane(tid >> 6), l = tid & 63, m16 = l & 15, kg = l >> 4;
    LAS float* EDL = (LAS float*)(lds + GL_EDL); LAS float* WA = (LAS float*)(lds + GL_WA); LAS float* BA = (LAS float*)(lds + GL_BA);
    for (int item = first; item < NB * 8 * reps; item += stride) {
        const int b = (item >> 3) % NB, h = (item >> 1) & 3, dir = item & 1;
        const float* wa = dir ? wab : waf; const float* ba = dir ? bab : baf; h16* O = dir ? ob : of;
        __syncthreads();
        for (int i = tid; i < 16 * 64; i += NTHREADS) WA[i] = wa[(i >> 6) * 256 + h * 64 + (i & 63)];
        if (tid < 64) BA[tid] = ba[h * 64 + tid];
        f32x4 S[4];
#pragma unroll
        for (int m = 0; m < 4; ++m) S[m] = (f32x4){0.f, 0.f, 0.f, 0.f};
        h16x8 pq, pk, pv0, pv1; f32x4 pc;
#define GLA_ROW(n_, c_) ((size_t)b * SEQ + (dir ? (SEQ - 1 - (64 * (n_) + (c_))) : (64 * (n_) + (c_))))
#define GLA_FETCH(n_) do { const size_t rq_ = GLA_ROW(n_, tid >> 3); pq = *(const h16x8*)(qkvg + rq_ * 1536 + h * 64 + (tid & 7) * 8); pk = *(const h16x8*)(qkvg + rq_ * 1536 + 256 + h * 64 + (tid & 7) * 8); \
            const size_t rv0_ = GLA_ROW(n_, tid >> 4), rv1_ = GLA_ROW(n_, 32 + (tid >> 4)); pv0 = *(const h16x8*)(qkvg + rv0_ * 1536 + 512 + h * 128 + (tid & 15) * 8); pv1 = *(const h16x8*)(qkvg + rv1_ * 1536 + 512 + h * 128 + (tid & 15) * 8); \
            if (tid < 256) pc = *(const f32x4*)(codes + GLA_ROW(n_, tid >> 2) * 32 + dir * 16 + (tid & 3) * 4); } while (0)
#define GLA_PARK() do { { const int t_ = tid >> 3, p_ = tid & 7; *(LAS h16x8*)(lds + GL_QS + t_ * 128 + ((p_ ^ (t_ & 7)) << 4)) = pq; *(LAS h16x8*)(lds + GL_KS + t_ * 128 + ((p_ ^ (t_ & 7)) << 4)) = pk; } \
            { const int t0_ = tid >> 4, t1_ = 32 + (tid >> 4), p_ = tid & 15; *(LAS h16x8*)(lds + GL_VS + t0_ * 256 + ((p_ ^ ((t0_ & 7) << 1)) << 4)) = pv0; *(LAS h16x8*)(lds + GL_VS + t1_ * 256 + ((p_ ^ ((t1_ & 7) << 1)) << 4)) = pv1; } \
            if (tid < 256) *(LAS f32x4*)(lds + GL_CS + (tid >> 2) * 80 + (tid & 3) * 16) = pc; } while (0)
        GLA_FETCH(0);
        GLA_PARK();
        GLA_FETCH(1);
#pragma unroll 1
        for (int n = 0; n < SEQ / 64; ++n) {
            GLA_BAR();
            {
                const h16x8 cq = *(const LAS h16x8*)(lds + GL_QS + l * 128 + ((w ^ (l & 7)) << 4)), ck = *(const LAS h16x8*)(lds + GL_KS + l * 128 + ((w ^ (l & 7)) << 4));
                const h16x8 cv0 = *(const LAS h16x8*)(lds + GL_VS + l * 256 + (((2 * w) ^ ((l & 7) << 1)) << 4)), cv1 = *(const LAS h16x8*)(lds + GL_VS + l * 256 + (((2 * w + 1) ^ ((l & 7) << 1)) << 4));
                f32x4 cc[4];
#pragma unroll
                for (int r = 0; r < 4; ++r) cc[r] = *(const LAS f32x4*)(lds + GL_CS + l * 80 + r * 16);
                float z[8];
                { const f32x4 b0 = *(const LAS f32x4*)(BA + 8 * w), b1 = *(const LAS f32x4*)(BA + 8 * w + 4);
#pragma unroll
                  for (int j = 0; j < 4; ++j) { z[j] = b0[j]; z[4 + j] = b1[j]; } }
#pragma unroll
                for (int r = 0; r < 16; ++r) { const float cr = cc[r >> 2][r & 3]; const f32x4 w0 = *(const LAS f32x4*)(WA + r * 64 + 8 * w), w1 = *(const LAS f32x4*)(WA + r * 64 + 8 * w + 4);
#pragma unroll
                    for (int j = 0; j < 4; ++j) { z[j] += cr * w0[j]; z[4 + j] += cr * w1[j]; } }
                h16x8 qd, ki, kd; float edl[8];
#pragma unroll
                for (int j = 0; j < 8; ++j) {
                    const float ls = fminf(z[j], 0.f) - __logf(1.0f + __expf(-fabsf(z[j])));
                    float bb = ls * (1.0f / 16.0f);
                    bb = wave_incl_scan(bb);
                    const float bl = __builtin_bit_cast(float, __builtin_amdgcn_readlane(__builtin_bit_cast(int, bb), 63));
                    const float E = __expf(bb), Ei = 1.0f / E, el = __expf(bl);
                    edl[j] = el;
                    qd[j] = (h16)((float)cq[j] * 0.125f * E); const float kiv = (float)ck[j] * Ei; ki[j] = (h16)kiv; kd[j] = (h16)(kiv * el);
                }
                *(LAS h16x8*)(lds + GL_QD + l * 128 + ((w ^ (l & 7)) << 4)) = qd;
                *(LAS h16x8*)(lds + GL_KI + l * 128 + ((w ^ (l & 7)) << 4)) = ki;
#pragma unroll
                for (int j = 0; j < 8; ++j) *(LAS h16*)(lds + GL_KDT + gsw(8 * w + j, l)) = kd[j];
#pragma unroll
                for (int j = 0; j < 8; ++j) { *(LAS h16*)(lds + GL_VT + gsw(16 * w + j, l)) = cv0[j]; *(LAS h16*)(lds + GL_VT + gsw(16 * w + 8 + j, l)) = cv1[j]; }
                if (l == 0) {
#pragma unroll
                    for (int j = 0; j < 8; ++j) EDL[8 * w + j] = edl[j]; }
            }
            GLA_BAR();
            {
                const int mi = w & 3;
                h16x8 Aq[2];
                Aq[0] = *(const LAS h16x8*)(lds + GL_QD + gsw(16 * mi + m16, 8 * kg)); Aq[1] = *(const LAS h16x8*)(lds + GL_QD + gsw(16 * mi + m16, 32 + 8 * kg));
#pragma unroll
                for (int q = 0; q < 2; ++q) {
                    const int nj = 2 * (w >> 2) + q;
                    if (nj <= mi) {
                        const h16x8 B0 = *(const LAS h16x8*)(lds + GL_KI + gsw(16 * nj + m16, 8 * kg)), B1 = *(const LAS h16x8*)(lds + GL_KI + gsw(16 * nj + m16, 32 + 8 * kg));
                        f32x4 p = (f32x4){0.f, 0.f, 0.f, 0.f};
                        p = __builtin_amdgcn_mfma_f32_16x16x32_f16(Aq[0], B0, p, 0, 0, 0);
                        p = __builtin_amdgcn_mfma_f32_16x16x32_f16(Aq[1], B1, p, 0, 0, 0);
#pragma unroll
                        for (int r = 0; r < 4; ++r) { const int c = 16 * mi + 4 * kg + r, cp = 16 * nj + m16; const bool keep = dir ? (cp < c) : (cp <= c);
                            *(LAS h16*)(lds + GL_P + gsw(c, cp)) = (h16)(keep ? p[r] : 0.f); }
                    } else if ((nj >> 1) == (mi >> 1)) {
#pragma unroll
                        for (int r = 0; r < 4; ++r) *(LAS h16*)(lds + GL_P + gsw(16 * mi + 4 * kg + r, 16 * nj + m16)) = (h16)0.f;
                    }
                }
            }
            GLA_BAR();
            {
                h16x8 Bv[2];
                Bv[0] = *(const LAS h16x8*)(lds + GL_VT + gsw(16 * w + m16, 8 * kg)); Bv[1] = *(const LAS h16x8*)(lds + GL_VT + gsw(16 * w + m16, 32 + 8 * kg));
                h16x8 Sf[2];
#pragma unroll
                for (int ks = 0; ks < 2; ++ks)
#pragma unroll
                    for (int j = 0; j < 4; ++j) { Sf[ks][j] = (h16)S[2 * ks][j]; Sf[ks][4 + j] = (h16)S[2 * ks + 1][j]; }
#pragma unroll
                for (int mi = 0; mi < 4; ++mi) {
                    f32x4 o = (f32x4){0.f, 0.f, 0.f, 0.f};
#pragma unroll
                    for (int ks = 0; ks < 2; ++ks) {
                        if (!(ks == 1 && mi < 2)) { const h16x8 Ap = *(const LAS h16x8*)(lds + GL_P + gsw(16 * mi + m16, 32 * ks + 8 * kg)); o = __builtin_amdgcn_mfma_f32_16x16x32_f16(Ap, Bv[ks], o, 0, 0, 0); }
                        const h16x4 a0 = *(const LAS h16x4*)(lds + GL_QD + gsw(16 * mi + m16, 32 * ks + 4 * kg)), a1 = *(const LAS h16x4*)(lds + GL_QD + gsw(16 * mi + m16, 32 * ks + 16 + 4 * kg));
                        h16x8 Aqs;
#pragma unroll
                        for (int j = 0; j < 4; ++j) { Aqs[j] = a0[j]; Aqs[4 + j] = a1[j]; }
                        o = __builtin_amdgcn_mfma_f32_16x16x32_f16(Aqs, Sf[ks], o, 0, 0, 0);
                    }
#pragma unroll
                    for (int r = 0; r < 4; ++r) { const int c = 16 * mi + 4 * kg + r; const int tok = dir ? (SEQ - 1 - (64 * n + c)) : (64 * n + c);
                        O[((size_t)b * SEQ + tok) * 512 + h * 128 + 16 * w + m16] = (h16)o[r]; }
                }
#pragma unroll
                for (int mt = 0; mt < 4; ++mt) {
                    const f32x4 e4 = *(const LAS f32x4*)(EDL + 16 * mt + 4 * kg);
                    S[mt] = S[mt] * e4;
#pragma unroll
                    for (int ks = 0; ks < 2; ++ks) { const h16x8 Ak = *(const LAS h16x8*)(lds + GL_KDT + gsw(16 * mt + m16, 32 * ks + 8 * kg)); S[mt] = __builtin_amdgcn_mfma_f32_16x16x32_f16(Ak, Bv[ks], S[mt], 0, 0, 0); }
                }
            }
            if (n + 1 < SEQ / 64) GLA_PARK();
            if (n + 2 < SEQ / 64) GLA_FETCH(n + 2);
        }
    }
}

__device__ void phase_mixbuild(const h16* __restrict__ of, const h16* __restrict__ ob, const h16* __restrict__ qkvg, const float* __restrict__ nw, const h16* __restrict__ z2,
                               h16* __restrict__ mix, LAS unsigned char* lds, int blk, int nblk) {
    LAS h16* tileT = (LAS h16*)lds;
    const int tid = threadIdx.x;
    float nwv[8];
#pragma unroll
    for (int j = 0; j < 8; ++j) nwv[j] = nw[(tid & 15) * 8 + j];
    for (int sl = blk; sl < NTOK / 64; sl += nblk) {
        const int tok0 = sl * 64;
        h16x8 zv[8];
#pragma unroll
        for (int i = 0; i < 8; ++i) zv[i] = *(const h16x8*)(z2 + (size_t)tid * NTOK + tok0 + 8 * i);
#pragma unroll 2
        for (int i = 0; i < 8; ++i) {
            const int task = tid + NTHREADS * i, token = task >> 6, head = (task >> 4) & 3, part = task & 15;
            const size_t row = (size_t)tok0 + token;
            const h16x8 a = *(const h16x8*)(of + row * 512 + head * 128 + part * 8), b = *(const h16x8*)(ob + row * 512 + head * 128 + part * 8);
            const h16x8 g = *(const h16x8*)(qkvg + row * 1536 + 1024 + head * 128 + part * 8);
            float o[8], ss = 0.f;
#pragma unroll
            for (int j = 0; j < 8; ++j) { o[j] = (float)a[j] + (float)b[j]; ss += o[j] * o[j]; }
            ss += __shfl_xor(ss, 1); ss += __shfl_xor(ss, 2); ss += __shfl_xor(ss, 4); ss += __shfl_xor(ss, 8);
            const float rstd = rsqrtf(ss * (1.0f / 128.0f) + EPS);
            h16x8 r;
#pragma unroll
            for (int j = 0; j < 8; ++j) r[j] = (h16)(o[j] * rstd * nwv[j] * siluf_((float)g[j]));
            *(h16x8*)(mix + row * DM + head * 128 + part * 8) = r;
        }
        __syncthreads();
#pragma unroll
        for (int i = 0; i < 8; ++i)
#pragma unroll
            for (int j = 0; j < 8; ++j) tileT[(8 * i + j) * 520 + tid] = zv[i][j];
        __syncthreads();
#pragma unroll
        for (int i = 0; i < 8; ++i) { const int idx = tid + NTHREADS * i, token = idx >> 6, c8 = (idx & 63) * 8;
            *(h16x8*)(mix + (size_t)(tok0 + token) * DM + 512 + c8) = *(const LAS h16x8*)(tileT + token * 520 + c8); }
    }
}

enum { PH_PREP = 0, PH_NORM1, PH_FILT, PH_G1A, PH_G1B, PH_GLA, PH_HYENA, PH_GLAMIX, PH_G2, PH_ROUTER, PH_TOPK, PH_MOE1, PH_MOE2, PH_NORM3, PH_G5, PH_G6, PH_FINAL, PH_COUNT };

template <bool COOP>
__global__ __launch_bounds__(NTHREADS, 2) void mega(Args a) {
    extern __shared__ __attribute__((aligned(16))) unsigned char shm[];
    LAS unsigned char* lds = (LAS unsigned char*)shm;
    const int blk = blockIdx.x, nblk = gridDim.x;
    unsigned char* ws = a.ws;
#ifndef PROBE_MASK
#define PROBE_MASK 0u
#endif
#define RUN(P, SYNC, ...) if (a.ph_lo <= (P) && (P) < a.ph_hi) { { __syncthreads(); const float pscale = 1.f; (void)pscale; __VA_ARGS__ } \
        if constexpr (((PROBE_MASK >> (P)) & 1u) != 0u && (P) != PH_GLA && (P) != PH_HYENA) { if (COOP) cg::this_grid().sync(); __syncthreads(); const float pscale = 0.f; (void)pscale; __VA_ARGS__ } \
        if (COOP && (SYNC)) { if ((P) + 1 < a.ph_hi) cg::this_grid().sync(); } }
    RUN(PH_PREP, false, phase_prep(a, lds, blk, nblk);)
    RUN(PH_NORM1, false, phase_rmsnorm_h16(a.in[I_X], a.in[I_LNMIX], (h16*)(ws + OFF_H), blk, nblk);)
    RUN(PH_FILT, true, phase_filters(a, (h16*)(ws + OFF_GR), lds, blk, nblk);)
    RUN(PH_G1A, false, { g8::DenseSched S; S.init(ws + OFF_WINA, NTOK, NA1, DM, nblk, blk); g8::EpiQKVG E{(h16*)(ws + OFF_QKVG), (float*)(ws + OFF_CODES)};
        g8::gemm_phase(lds, (const char*)(ws + OFF_H), DM, S, E); })
    RUN(PH_G1B, true, { g8::DenseSched S; S.init(ws + OFF_H, HYC, NTOK, DM, nblk, blk); g8::EpiH16 E{(h16*)(ws + OFF_HY), NTOK};
        g8::gemm_phase(lds, (const char*)(ws + OFF_WINHY), DM, S, E); })
    RUN(PH_GLA, false, { const int ng = nblk >= 2 * NB * 8 ? NB * 8 : nblk;
        if (blk >= nblk - ng) phase_gla((const h16*)(ws + OFF_QKVG), (const float*)(ws + OFF_CODES), a.in[I_WAF], a.in[I_BAF], a.in[I_WAB], a.in[I_BAB], (h16*)(ws + OFF_OF), (h16*)(ws + OFF_OB), lds, blk - (nblk - ng), ng, 1 + (int)((PROBE_MASK >> 5) & 1u)); })
    RUN(PH_HYENA, true, phase_hyena((const h16*)(ws + OFF_HY), (h16*)(ws + OFF_Z2), (const h16*)(ws + OFF_GR), a.in[I_HCW], a.in[I_HCB], (unsigned*)(ws + OFF_CTR), lds, 1 + (int)((PROBE_MASK >> 6) & 1u));)
    RUN(PH_GLAMIX, true, phase_mixbuild((const h16*)(ws + OFF_OF), (const h16*)(ws + OFF_OB), (const h16*)(ws + OFF_QKVG), a.in[I_GLANW], (const h16*)(ws + OFF_Z2), (h16*)(ws + OFF_H), lds, blk, nblk);)
    RUN(PH_G2, true, { g8::DenseSched S; S.init(ws + OFF_WOUT, NTOK, DM, DM, nblk, blk); g8::EpiResid E{a.in[I_X], a.out};
        g8::gemm_phase(lds, (const char*)(ws + OFF_H), DM, S, E); })
    RUN(PH_ROUTER, true, phase_router(a.out, a.in[I_LNFFN], a.in[I_WROUTER], ws + OFF_H, (float*)(ws + OFF_PROBS), lds, blk, nblk);)
    RUN(PH_TOPK, true, phase_topk((const float*)(ws + OFF_PROBS), (int*)(ws + OFF_SELIDX), (float*)(ws + OFF_SELGATE), (int*)(ws + OFF_SLOTMAP), lds, blk, nblk);)
    RUN(PH_MOE1, true, { g8::Moe1Sched S{(const char*)(ws + OFF_WGU), (const int*)(ws + OFF_SELIDX), nblk, blk}; g8::EpiHid E{ws + OFF_HID};
        g8::gemm_phase<g8::EpiHid, g8::Moe1Sched, true>(lds, (const char*)(ws + OFF_H), DM / 2, S, E); })
    RUN(PH_MOE2, true, { g8::Moe2Sched S{(const char*)(ws + OFF_WD), nblk, blk}; g8::EpiDown E{(h16*)(ws + OFF_Y), (const float*)(ws + OFF_SELGATE)};
        g8::gemm_phase<g8::EpiDown, g8::Moe2Sched, true>(lds, (const char*)(ws + OFF_HID), DFF / 2, S, E); })
    RUN(PH_NORM3, false, phase_combine_norm(a.out, (const h16*)(ws + OFF_Y), (const int*)(ws + OFF_SLOTMAP), a.in[I_LNPLE], (h16*)(ws + OFF_H3), (float*)(ws + OFF_RSTD3), (float*)(ws + OFF_ROWSQ), blk, nblk);)
    RUN(PH_G5, true, { g8::DenseSched S; S.init(ws + OFF_WP, NTOK, DM, 256, nblk, blk); g8::EpiH16 E{(h16*)(ws + OFF_PP), DM};
        g8::gemm_phase(lds, (const char*)(ws + OFF_P16), 256, S, E); })
    RUN(PH_G6, true, { g8::DenseSched S; S.init(ws + OFF_WG, NTOK, DM, DM, nblk, blk); g8::EpiPle E{(const h16*)(ws + OFF_H3), (const float*)(ws + OFF_RSTD3), a.in[I_LNPLE], (const h16*)(ws + OFF_PP), (h16*)(ws + OFF_R3H), (float*)(ws + OFF_ROWSQ)};
        g8::gemm_phase(lds, (const char*)(ws + OFF_H3), DM, S, E); })
    RUN(PH_FINAL, false, phase_final_norm((const h16*)(ws + OFF_R3H), (const float*)(ws + OFF_ROWSQ), a.in[I_FNW], a.out, blk, nblk);)
}

extern "C" void kernel_launch(void* const* d_in, const int* in_sizes, int n_in, void* d_out, int out_size, void* d_ws, size_t ws_size, hipStream_t stream) {
    static int grid = 0;
    if (grid == 0) {
        if (n_in != N_IN || out_size != NTOK * DM || ws_size < WS_END) { fprintf(stderr, "kernel_launch: unexpected shapes (n_in %d, out %d, ws %zu, need %zu)\n", n_in, out_size, ws_size, (size_t)WS_END); grid = -1; return; }
        int dev = 0, cus = 0, per_cu = 0;
        (void)hipGetDevice(&dev); (void)hipDeviceGetAttribute(&cus, hipDeviceAttributeMultiprocessorCount, dev);
        (void)hipFuncSetAttribute((const void*)mega<true>, hipFuncAttributeMaxDynamicSharedMemorySize, LDS_BYTES);
        (void)hipOccupancyMaxActiveBlocksPerMultiprocessor(&per_cu, (const void*)mega<true>, NTHREADS, LDS_BYTES);
        if (per_cu < 1) { fprintf(stderr, "kernel_launch: occupancy query says %d blocks per CU\n", per_cu); per_cu = 1; }
        grid = cus * (per_cu > 1 ? 1 : per_cu);
        (void)hipGetLastError();
    }
    if (grid < 0) return;
    Args a{};
    for (int i = 0; i < N_IN; ++i) a.in[i] = (const float*)d_in[i];
    a.out = (float*)d_out; a.ws = (unsigned char*)d_ws;
    a.ph_lo = 0; a.ph_hi = PH_COUNT;
    void* args[] = {&a};
    hipError_t e = hipLaunchCooperativeKernel((const void*)mega<true>, dim3(grid), dim3(NTHREADS), args, LDS_BYTES, stream);
    if (e != hipSuccess) fprintf(stderr, "kernel_launch: cooperative launch failed: %s (grid %d)\n", hipGetErrorString(e), grid);
}
```

```cpp
#include <hip/hip_runtime.h>
#include <hip/hip_cooperative_groups.h>
#include <cstdio>
#include <cstdint>
#include <cstddef>

namespace cg = cooperative_groups;

#define LAS __attribute__((address_space(3)))
typedef _Float16 h16;
typedef _Float16 h16x8 __attribute__((ext_vector_type(8)));
typedef _Float16 h16x4 __attribute__((ext_vector_type(4)));
typedef _Float16 h16x2 __attribute__((ext_vector_type(2)));
typedef float f32x4 __attribute__((ext_vector_type(4)));
typedef float f32x2 __attribute__((ext_vector_type(2)));
typedef unsigned u32x4 __attribute__((ext_vector_type(4)));
typedef unsigned u32x2 __attribute__((ext_vector_type(2)));
typedef int i32x8 __attribute__((ext_vector_type(8)));
typedef int i32x4 __attribute__((ext_vector_type(4)));

constexpr int NB = 16, SEQ = 4096, DM = 1024, NTOK = NB * SEQ;
constexpr int INCOLS = 3104;
constexpr int NEXP = 16, CAP = 512, DFF = 2048;
constexpr int HYW = 512, HYC = 1536;
constexpr float EPS = 1e-6f;

enum { I_X = 0, I_P, I_LNMIX, I_WIN, I_WAF, I_BAF, I_WAB, I_BAB, I_GLANW, I_HCW, I_HCB, I_FW1, I_FB1, I_FFR1, I_FW2, I_FB2, I_FFR2,
       I_FW3, I_HBIAS, I_WOUT, I_LNFFN, I_WROUTER, I_WGATE, I_WUP, I_WDOWN, I_LNPLE, I_WPG, I_WPP, I_FNW, N_IN };

constexpr size_t AL(size_t x) { return (x + 255) & ~(size_t)255; }
constexpr int NA1 = 1792;
constexpr size_t OFF_WINA = 0;
constexpr size_t OFF_WINHY = OFF_WINA + AL((size_t)NA1 * DM * 2);
constexpr size_t OFF_WOUT = OFF_WINHY + AL((size_t)HYC * DM * 2);
constexpr size_t OFF_WGU = OFF_WOUT + AL((size_t)DM * DM * 2);
constexpr size_t OFF_WD = OFF_WGU + AL((size_t)NEXP * 2 * DFF * DM * 2);
constexpr size_t OFF_WG = OFF_WD + AL((size_t)NEXP * DM * DFF * 2);
constexpr size_t OFF_WP = OFF_WG + AL((size_t)DM * DM * 2);
constexpr size_t OFF_P16 = OFF_WP + AL((size_t)DM * 256 * 2);
constexpr size_t OFF_PROBS = OFF_P16 + AL((size_t)NTOK * 256 * 2);
constexpr size_t OFF_SELIDX = OFF_PROBS + AL((size_t)NB * NEXP * SEQ * 4);
constexpr size_t OFF_SELGATE = OFF_SELIDX + AL((size_t)NB * NEXP * CAP * 4);
constexpr size_t OFF_SLOTMAP = OFF_SELGATE + AL((size_t)NB * NEXP * CAP * 4);
constexpr size_t OFF_CTR = OFF_SLOTMAP + AL((size_t)NTOK * NEXP * 4);
constexpr size_t OFF_BIG = OFF_CTR + 256;
constexpr size_t OFF_QKVG = OFF_BIG;
constexpr size_t OFF_HY = OFF_QKVG + AL((size_t)NTOK * 1536 * 2);
constexpr size_t OFF_CODES = OFF_HY + AL((size_t)HYC * NTOK * 2);
constexpr size_t OFF_OF = OFF_CODES + AL((size_t)NTOK * 32 * 4);
constexpr size_t OFF_OB = OFF_OF + AL((size_t)NTOK * 512 * 2);
constexpr size_t OFF_GR = OFF_OB + AL((size_t)NTOK * 512 * 2);
constexpr size_t OFF_H = OFF_GR + AL((size_t)2 * HYW * 8192 * 2);
constexpr size_t OFF_Z2 = OFF_H + AL((size_t)NTOK * DM * 2);
constexpr size_t END_A = OFF_Z2 + AL((size_t)HYW * NTOK * 2);
constexpr size_t OFF_HID = OFF_BIG;
constexpr size_t OFF_Y = OFF_HID + AL((size_t)NB * NEXP * CAP * DFF * 2);
constexpr size_t END_B = OFF_Y + AL((size_t)NB * NEXP * CAP * DM * 2);
static_assert(OFF_H >= OFF_Y, "h2 (read by the up/gate GEMM) must not be overwritten by HID");
constexpr size_t OFF_H3 = OFF_BIG;
constexpr size_t OFF_PP = OFF_H3 + AL((size_t)NTOK * DM * 2);
constexpr size_t OFF_R3H = OFF_PP + AL((size_t)NTOK * DM * 2);
constexpr size_t OFF_RSTD3 = OFF_R3H + AL((size_t)NTOK * DM * 2);
constexpr size_t OFF_ROWSQ = OFF_RSTD3 + AL((size_t)NTOK * 4);
constexpr size_t END_C = OFF_ROWSQ + AL((size_t)NTOK * 4);
constexpr size_t WS_END = END_A > END_B ? (END_A > END_C ? END_A : END_C) : (END_B > END_C ? END_B : END_C);

constexpr int NTHREADS = 512;
constexpr int LDS_BYTES = 156 * 1024;
constexpr float HY_SCALE = 64.0f;
constexpr int FP8_WSHIFT = 5;


struct Args {
    const float* in[N_IN];
    float* out;
    unsigned char* ws;
    int ph_lo, ph_hi;
};

__device__ __forceinline__ float wave_sum(float v) {
#pragma unroll
    for (int o = 32; o >= 1; o >>= 1) v += __shfl_xor(v, o);
    return v;
}
__device__ __forceinline__ float sigmoidf_(float x) { return 1.0f / (1.0f + __expf(-x)); }
__device__ __forceinline__ float siluf_(float x) { return x / (1.0f + __expf(-x)); }
__device__ __forceinline__ unsigned pack_h2(float a, float b) {
    h16x2 v; v.x = (h16)a; v.y = (h16)b; return __builtin_bit_cast(unsigned, v);
}


__device__ __forceinline__ void sincos_f(float x, float& s, float& c) {
    const float kf = rintf(x * 0.6366197723675814f);
    float r = fmaf(kf, -1.5707963705062866f, x); r = fmaf(kf, 4.371139000186241e-8f, r);
    const float r2 = r * r;
    const float sp = r + r * r2 * (-1.6666667e-1f + r2 * (8.3333338e-3f + r2 * (-1.9841270e-4f + r2 * 2.7557319e-6f)));
    const float cp = 1.0f + r2 * (-0.5f + r2 * (4.1666668e-2f + r2 * (-1.3888889e-3f + r2 * (2.4801587e-5f - r2 * 2.7557319e-7f))));
    const int k = (int)kf & 3;
    s = (k == 0) ? sp : (k == 1) ? cp : (k == 2) ? -sp : -cp;
    c = (k == 0) ? cp : (k == 1) ? -sp : (k == 2) ? -cp : sp;
}
__device__ __forceinline__ float sin_f(float x) { float s, c; sincos_f(x, s, c); return s; }

__device__ __forceinline__ unsigned pack_fp8x4(float a, float b, float c, float d) {
    int r = 0; r = __builtin_amdgcn_cvt_pk_fp8_f32(a, b, r, false); r = __builtin_amdgcn_cvt_pk_fp8_f32(c, d, r, true); return (unsigned)r;
}

namespace g8 {
constexpr int BM = 256, BK = 64, HALF = 128, HTB = HALF * BK * 2, STAGE_BYTES = 8 * HTB;
__device__ __forceinline__ int lds_byte(int r, int c) { const int st = (r >> 4) * 2 + (c >> 5), rr = r & 15, cc = c & 31, ob = rr * 64 + cc * 2; return st * 1024 + (ob ^ (((ob >> 9) & 1) << 5)); }
__device__ __forceinline__ void stage_rc(int b, int& R, int& C) { const int st = b / 1024, sb = b % 1024, swz = sb ^ (((sb >> 9) & 1) << 5); R = (st >> 1) * 16 + swz / 64; C = (st & 1) * 32 + (swz % 64) / 2; }
__device__ __forceinline__ int perm32(int rho) { const int n = rho >> 4, i = rho & 15; return 8 * (i >> 2) + 4 * n + (i & 3); }

struct Unit { const char* B; int pm, pn, g; unsigned rowbase; };

template <class Epi, class Sched, bool FP8 = false>
__device__ __forceinline__ void gemm_phase(LAS unsigned char* lds, const char* A, const int K, const Sched& S, const Epi& E) {
    const int tid = threadIdx.x, wid = __builtin_amdgcn_readfirstlane(tid >> 6), lane = tid & 63, wr = wid >> 2, wc = wid & 3, fr = lane & 15, fq = lane >> 4;
    const int nt = K / BK;
    int Rr[2], Cc[2]; unsigned voffB[2];
#pragma unroll
    for (int i = 0; i < 2; ++i) { stage_rc(tid * 16 + i * 8192, Rr[i], Cc[i]); const int Rb = Epi::PERM ? ((Rr[i] & ~31) + perm32(Rr[i] & 31)) : Rr[i];
        voffB[i] = (unsigned)(Rb * K + Cc[i]) * 2u; }
    const size_t kstep = (size_t)(BK * 2);
    const size_t hstep = (size_t)HALF * K * 2;
    const unsigned ldsw = (unsigned)wid * 1024u;
    const int aoff = lds_byte(wr * 64 + fr, fq * 8), boff = lds_byte(wc * 32 + fr, fq * 8);
#define G8_SA(b, h) (((b) * 2 + (h)) * HTB)
#define G8_SB(b, h) ((4 + (b) * 2 + (h)) * HTB)
#define G8_STAGE(bufoff, gbase, v0, v1) do { \
        __builtin_amdgcn_global_load_lds((const unsigned*)((const char*)(gbase) + (v0)), (LAS unsigned*)(lds + (bufoff) + ldsw), 16, 0, 0); \
        __builtin_amdgcn_global_load_lds((const unsigned*)((const char*)(gbase) + (v1)), (LAS unsigned*)(lds + (bufoff) + ldsw + 8192), 16, 0, 0); } while (0)
#define G8_LDA(dst, b, h) do { _Pragma("unroll") for (int m = 0; m < 4; ++m) { \
        const i32x4 lo_ = *(const LAS i32x4*)(lds + G8_SA(b, h) + aoff + m * 2048), hi_ = *(const LAS i32x4*)(lds + G8_SA(b, h) + aoff + m * 2048 + 1024); \
        dst[m] = __builtin_shufflevector(lo_, hi_, 0, 1, 2, 3, 4, 5, 6, 7); } } while (0)
#define G8_LDB(dst, b, h) do { _Pragma("unroll") for (int n = 0; n < 2; ++n) { \
        const i32x4 lo_ = *(const LAS i32x4*)(lds + G8_SB(b, h) + boff + n * 2048), hi_ = *(const LAS i32x4*)(lds + G8_SB(b, h) + boff + n * 2048 + 1024); \
        dst[n] = __builtin_shufflevector(lo_, hi_, 0, 1, 2, 3, 4, 5, 6, 7); } } while (0)
#define G8_MMA(ai, bj, At, Bt) do { __builtin_amdgcn_s_setprio(1); \
        if constexpr (FP8) { _Pragma("unroll") for (int m = 0; m < 4; ++m) _Pragma("unroll") for (int n = 0; n < 2; ++n) \
            asm volatile("v_mfma_scale_f32_16x16x128_f8f6f4 %0, %1, %2, %0, %3, %3 op_sel_hi:[0,0,0]" : "+v"(acc[ai][bj][m][n]) : "v"(Bt[n]), "v"(At[m]), "v"(sc_one)); } \
        else { _Pragma("unroll") for (int m = 0; m < 4; ++m) _Pragma("unroll") for (int n = 0; n < 2; ++n) { \
            const i32x8 a_ = At[m], b_ = Bt[n]; \
            const h16x8 a0_ = __builtin_bit_cast(h16x8, __builtin_shufflevector(a_, a_, 0, 1, 2, 3)), a1_ = __builtin_bit_cast(h16x8, __builtin_shufflevector(a_, a_, 4, 5, 6, 7)); \
            const h16x8 b0_ = __builtin_bit_cast(h16x8, __builtin_shufflevector(b_, b_, 0, 1, 2, 3)), b1_ = __builtin_bit_cast(h16x8, __builtin_shufflevector(b_, b_, 4, 5, 6, 7)); \
            acc[ai][bj][m][n] = __builtin_amdgcn_mfma_f32_16x16x32_f16(b0_, a0_, acc[ai][bj][m][n], 0, 0, 0); \
            acc[ai][bj][m][n] = __builtin_amdgcn_mfma_f32_16x16x32_f16(b1_, a1_, acc[ai][bj][m][n], 0, 0, 0); } } \
        __builtin_amdgcn_s_setprio(0); } while (0)
#define G8_WAIT_V(n) asm volatile("s_waitcnt vmcnt(" #n ")" ::: "memory")
#define G8_WAIT_L(n) asm volatile("s_waitcnt lgkmcnt(" #n ")" ::: "memory")
#define G8_BAR __builtin_amdgcn_s_barrier()
#define G8_SCHED __builtin_amdgcn_sched_barrier(0)
    Unit cur, nxt; int ui = 0;
    if (!S.next(0, cur)) return;
    f32x4 acc[2][2][4][2];
#pragma unroll
    for (int a = 0; a < 2; ++a)
#pragma unroll
        for (int b = 0; b < 2; ++b)
#pragma unroll
            for (int m = 0; m < 4; ++m)
#pragma unroll
                for (int n = 0; n < 2; ++n) acc[a][b][m][n] = (f32x4){0.f, 0.f, 0.f, 0.f};
    i32x8 At[4], B0[2], B1[2];
    const int sc_one = 0x7f7f7f7f; (void)sc_one;
    unsigned va00, va01, va10, va11, vn00, vn01, vn10, vn11;
    va00 = (S.arow(cur, Rr[0]) * (unsigned)K + (unsigned)Cc[0]) * 2u; va01 = (S.arow(cur, Rr[1]) * (unsigned)K + (unsigned)Cc[1]) * 2u;
    va10 = (S.arow(cur, HALF + Rr[0]) * (unsigned)K + (unsigned)Cc[0]) * 2u; va11 = (S.arow(cur, HALF + Rr[1]) * (unsigned)K + (unsigned)Cc[1]) * 2u;
    vn00 = va00; vn01 = va01; vn10 = va10; vn11 = va11;
    const char* cB = cur.B;
    G8_STAGE(G8_SB(0, 0), cB, voffB[0], voffB[1]); G8_STAGE(G8_SA(0, 0), A, va00, va01); G8_STAGE(G8_SB(0, 1), cB + hstep, voffB[0], voffB[1]); G8_STAGE(G8_SA(0, 1), A, va10, va11);
    if (wr == 1) G8_BAR;
    G8_WAIT_V(4); G8_BAR;
    G8_STAGE(G8_SB(1, 0), cB + kstep, voffB[0], voffB[1]); G8_STAGE(G8_SA(1, 0), A + kstep, va00, va01); G8_STAGE(G8_SB(1, 1), cB + hstep + kstep, voffB[0], voffB[1]);
    G8_WAIT_V(6); G8_BAR;
    for (;;) {
        const bool has_next = S.next(ui + 1, nxt);
        const char* nB = has_next ? nxt.B : cB;
        if (has_next) {
            vn00 = (S.arow(nxt, Rr[0]) * (unsigned)K + (unsigned)Cc[0]) * 2u; vn01 = (S.arow(nxt, Rr[1]) * (unsigned)K + (unsigned)Cc[1]) * 2u;
            vn10 = (S.arow(nxt, HALF + Rr[0]) * (unsigned)K + (unsigned)Cc[0]) * 2u; vn11 = (S.arow(nxt, HALF + Rr[1]) * (unsigned)K + (unsigned)Cc[1]) * 2u;
        }
        for (int t = 0; t < nt; t += 2) {
            const bool last = (t == nt - 2);
            const char* a1 = A + (size_t)(t + 1) * kstep;
            const char* a2 = last ? A : A + (size_t)(t + 2) * kstep; const char* b2 = last ? nB : cB + (size_t)(t + 2) * kstep;
            const char* a3 = a2 + kstep; const char* b3 = b2 + kstep;
            const unsigned w00 = last ? vn00 : va00, w01 = last ? vn01 : va01, w10 = last ? vn10 : va10, w11 = last ? vn11 : va11;
            G8_LDB(B0, 0, 0); G8_SCHED; G8_LDA(At, 0, 0); G8_STAGE(G8_SA(1, 1), a1, va10, va11);
            G8_WAIT_L(8); G8_BAR; G8_WAIT_L(0); G8_MMA(0, 0, At, B0); G8_BAR; G8_SCHED;
            G8_LDB(B1, 0, 1); G8_STAGE(G8_SB(0, 0), b2, voffB[0], voffB[1]);
            G8_BAR; G8_WAIT_L(0); G8_MMA(0, 1, At, B1); G8_BAR;
            G8_LDA(At, 0, 1); G8_STAGE(G8_SA(0, 0), a2, w00, w01);
            G8_BAR; G8_WAIT_L(0); G8_MMA(1, 0, At, B0); G8_BAR; G8_SCHED;
            G8_STAGE(G8_SB(0, 1), b2 + hstep, voffB[0], voffB[1]);
            G8_WAIT_V(6); G8_BAR; G8_MMA(1, 1, At, B1); G8_BAR;
            G8_LDB(B0, 1, 0); G8_SCHED; G8_LDA(At, 1, 0); G8_STAGE(G8_SA(0, 1), a2, w10, w11);
            G8_WAIT_L(8); G8_BAR; G8_WAIT_L(0); G8_MMA(0, 0, At, B0); G8_BAR; G8_SCHED;
            G8_LDB(B1, 1, 1); G8_STAGE(G8_SB(1, 0), b3, voffB[0], voffB[1]);
            G8_BAR; G8_WAIT_L(0); G8_MMA(0, 1, At, B1); G8_BAR;
            G8_LDA(At, 1, 1); G8_STAGE(G8_SA(1, 0), a3, w00, w01);
            G8_BAR; G8_WAIT_L(0); G8_MMA(1, 0, At, B0); G8_BAR; G8_SCHED;
            G8_STAGE(G8_SB(1, 1), b3 + hstep, voffB[0], voffB[1]);
            G8_WAIT_V(6); G8_BAR; G8_MMA(1, 1, At, B1); G8_BAR;
        }
        if constexpr (FP8) asm volatile("s_nop 15\n\ts_nop 15" ::: "memory");
        E(acc, cur, wr, wc, fr, fq);
        if (!has_next) break;
#pragma unroll
        for (int a = 0; a < 2; ++a)
#pragma unroll
            for (int b = 0; b < 2; ++b)
#pragma unroll
                for (int m = 0; m < 4; ++m)
#pragma unroll
                    for (int n = 0; n < 2; ++n) acc[a][b][m][n] = (f32x4){0.f, 0.f, 0.f, 0.f};
        cur = nxt; cB = nB; va00 = vn00; va01 = vn01; va10 = vn10; va11 = vn11; ++ui;
    }
    G8_WAIT_V(0);
    if (wr == 0) G8_BAR;
    G8_BAR;
#undef G8_SA
#undef G8_SB
#undef G8_STAGE
#undef G8_LDA
#undef G8_LDB
#undef G8_MMA
#undef G8_WAIT_V
#undef G8_WAIT_L
#undef G8_BAR
#undef G8_SCHED
}

struct DenseSched {
    const char* Bt; int K, nM, nN, nwg, G, c;
    __device__ void init(const void* Bt_, int M, int N, int K_, int G_, int c_) { Bt = (const char*)Bt_; K = K_; nM = M / BM; nN = N / BM; nwg = nM * nN; G = G_; c = c_; }
    __device__ bool next(int i, Unit& u) const {
        const long L = (long)i * G + c; if (L >= nwg) return false;
        int wgid = (int)L; { const int q = nwg / 8, r = nwg % 8, xcd = wgid % 8, off = wgid / 8; wgid = (xcd < r ? xcd * (q + 1) : r * (q + 1) + (xcd - r) * q) + off; }
        const int nig = 8 * nN, gid = wgid / nig, fm = gid * 8, gsz = (nM - fm) < 8 ? (nM - fm) : 8;
        u.pm = fm + ((wgid % nig) % gsz); u.pn = (wgid % nig) / gsz; u.g = 0; u.rowbase = (unsigned)u.pm * BM;
        u.B = Bt + (size_t)u.pn * BM * K * 2; return true;
    }
    __device__ __forceinline__ unsigned arow(const Unit& u, int r) const { return u.rowbase + (unsigned)r; }
};
struct Moe1Sched {
    const char* W; const int* rowmap; int G, c;
    __device__ bool next(int i, Unit& u) const {
        const long L = (long)i * G + c; if (L >= NEXP * 512) return false;
        const int e = (int)(L / 512), w = (int)(L % 512), cc = w % 256, r = w / 256, xcd = cc % 8, j = cc / 8;
        const int mt = xcd * 4 + (j & 3), nt_ = r * 8 + (j >> 2), b = mt >> 1;
        u.pm = mt & 1; u.pn = nt_; u.g = b * NEXP + e; u.rowbase = (unsigned)u.g * CAP + (unsigned)u.pm * BM;
        u.B = W + ((size_t)e * 2 * DFF + (size_t)nt_ * BM) * DM; return true;
    }
    __device__ __forceinline__ unsigned arow(const Unit& u, int r) const { return (unsigned)rowmap[u.rowbase + r]; }
};
struct Moe2Sched {
    const char* W; int G, c;
    __device__ bool next(int i, Unit& u) const {
        const long L = (long)i * G + c; if (L >= NEXP * 128) return false;
        const int e = (int)(L / 128), w = (int)(L % 128), xcd = w % 8, j = w / 8;
        const int mt = xcd * 4 + (j & 3), nt_ = j >> 2, b = mt >> 1;
        u.pm = mt & 1; u.pn = nt_; u.g = b * NEXP + e; u.rowbase = (unsigned)u.g * CAP + (unsigned)u.pm * BM;
        u.B = W + ((size_t)e * DM + (size_t)nt_ * BM) * DFF; return true;
    }
    __device__ __forceinline__ unsigned arow(const Unit& u, int r) const { return u.rowbase + (unsigned)r; }
};

typedef const f32x4 (&AccRef)[2][2][4][2];
struct EpiQKVG {
    static constexpr bool PERM = true;
    h16* qkvg; float* codes;
    __device__ __forceinline__ void operator()(AccRef acc, const Unit& u, int wr, int wc, int fr, int fq) const {
        const int row0 = u.pm * BM + wr * 64 + fr;
        if (u.pn < 6) {
#pragma unroll
            for (int ai = 0; ai < 2; ++ai)
#pragma unroll
                for (int m = 0; m < 4; ++m) { h16* rowp = qkvg + (size_t)(row0 + ai * HALF + m * 16) * 1536 + u.pn * BM + wc * 32 + 8 * fq;
#pragma unroll
                    for (int bj = 0; bj < 2; ++bj) { const f32x4 v0 = acc[ai][bj][m][0], v1 = acc[ai][bj][m][1];
                        u32x4 w; w.x = pack_h2(v0[0], v0[1]); w.y = pack_h2(v0[2], v0[3]); w.z = pack_h2(v1[0], v1[1]); w.w = pack_h2(v1[2], v1[3]);
                        *(u32x4*)(rowp + bj * HALF) = w; } }
        } else if (wc == 0) {
#pragma unroll
            for (int ai = 0; ai < 2; ++ai)
#pragma unroll
                for (int m = 0; m < 4; ++m) { float* rowp = codes + (size_t)(row0 + ai * HALF + m * 16) * 32 + 8 * fq;
                    *(f32x4*)(rowp) = acc[ai][0][m][0]; *(f32x4*)(rowp + 4) = acc[ai][0][m][1]; }
        }
    }
};
struct EpiH16 {
    static constexpr bool PERM = true;
    h16* C; int ldc;
    __device__ __forceinline__ void operator()(AccRef acc, const Unit& u, int wr, int wc, int fr, int fq) const {
        const int row0 = u.pm * BM + wr * 64 + fr;
#pragma unroll
        for (int ai = 0; ai < 2; ++ai)
#pragma unroll
            for (int m = 0; m < 4; ++m) { h16* rowp = C + (size_t)(row0 + ai * HALF + m * 16) * ldc + u.pn * BM + wc * 32 + 8 * fq;
#pragma unroll
                for (int bj = 0; bj < 2; ++bj) { const f32x4 v0 = acc[ai][bj][m][0], v1 = acc[ai][bj][m][1];
                    u32x4 w; w.x = pack_h2(v0[0], v0[1]); w.y = pack_h2(v0[2], v0[3]); w.z = pack_h2(v1[0], v1[1]); w.w = pack_h2(v1[2], v1[3]);
                    *(u32x4*)(rowp + bj * HALF) = w; } }
    }
};
struct EpiResid {
    static constexpr bool PERM = true;
    const float* X; h16* R;
    __device__ __forceinline__ void operator()(AccRef acc, const Unit& u, int wr, int wc, int fr, int fq) const {
        const int row0 = u.pm * BM + wr * 64 + fr, col0 = u.pn * BM + wc * 32 + 8 * fq;
#pragma unroll
        for (int ai = 0; ai < 2; ++ai)
#pragma unroll
            for (int m = 0; m < 4; ++m) { const size_t off = (size_t)(row0 + ai * HALF + m * 16) * DM + col0;
#pragma unroll
                for (int bj = 0; bj < 2; ++bj) { const f32x4 x0 = *(const f32x4*)(X + off + bj * HALF), x1 = *(const f32x4*)(X + off + bj * HALF + 4);
                    const f32x4 v0 = x0 + acc[ai][bj][m][0], v1 = x1 + acc[ai][bj][m][1];
                    u32x4 w; w.x = pack_h2(v0[0], v0[1]); w.y = pack_h2(v0[2], v0[3]); w.z = pack_h2(v1[0], v1[1]); w.w = pack_h2(v1[2], v1[3]);
                    *(u32x4*)(R + off + bj * HALF) = w; } }
    }
};
struct EpiHid {
    static constexpr bool PERM = true;
    unsigned char* hid;
    __device__ __forceinline__ void operator()(AccRef acc, const Unit& u, int wr, int wc, int fr, int fq) const {
        const unsigned row0 = u.rowbase + wr * 64 + fr;
#pragma unroll
        for (int ai = 0; ai < 2; ++ai)
#pragma unroll
            for (int m = 0; m < 4; ++m) { unsigned char* rowp = hid + (size_t)(row0 + ai * HALF + m * 16) * DFF + u.pn * HALF + wc * 32 + 8 * fq;
                constexpr float ws_ = 1.0f / (float)(1 << FP8_WSHIFT);
                const f32x4 g0 = acc[ai][0][m][0] * ws_, g1 = acc[ai][0][m][1] * ws_, u0 = acc[ai][1][m][0] * ws_, u1 = acc[ai][1][m][1] * ws_;
                u32x2 w; w.x = pack_fp8x4(siluf_(g0[0]) * u0[0], siluf_(g0[1]) * u0[1], siluf_(g0[2]) * u0[2], siluf_(g0[3]) * u0[3]);
                w.y = pack_fp8x4(siluf_(g1[0]) * u1[0], siluf_(g1[1]) * u1[1], siluf_(g1[2]) * u1[2], siluf_(g1[3]) * u1[3]);
                *(u32x2*)rowp = w; }
    }
};
struct EpiDown {
    static constexpr bool PERM = true;
    h16* Y; const float* selgate;
    __device__ __forceinline__ void operator()(AccRef acc, const Unit& u, int wr, int wc, int fr, int fq) const {
        const unsigned row0 = u.rowbase + wr * 64 + fr;
#pragma unroll
        for (int ai = 0; ai < 2; ++ai)
#pragma unroll
            for (int m = 0; m < 4; ++m) { const unsigned sr = row0 + ai * HALF + m * 16; const float gt = selgate[sr] * (1.0f / (float)(1 << FP8_WSHIFT));
                h16* rowp = Y + (size_t)sr * DM + u.pn * BM + wc * 32 + 8 * fq;
#pragma unroll
                for (int bj = 0; bj < 2; ++bj) { const f32x4 v0 = acc[ai][bj][m][0] * gt, v1 = acc[ai][bj][m][1] * gt;
                    u32x4 w; w.x = pack_h2(v0[0], v0[1]); w.y = pack_h2(v0[2], v0[3]); w.z = pack_h2(v1[0], v1[1]); w.w = pack_h2(v1[2], v1[3]);
                    *(u32x4*)(rowp + bj * HALF) = w; } }
    }
};
struct EpiPle {
    static constexpr bool PERM = false;
    const h16* H3; const float* rstd3; const float* lnw; const h16* PP; h16* R3H; float* rowsq;
    __device__ __forceinline__ void operator()(AccRef acc, const Unit& u, int wr, int wc, int fr, int fq) const {
        const int row0 = u.pm * BM + wr * 64 + fr, col0 = u.pn * BM + wc * 32 + 4 * fq;
        f32x4 winv[2][2];
#pragma unroll
        for (int bj = 0; bj < 2; ++bj)
#pragma unroll
            for (int n = 0; n < 2; ++n) { const f32x4 wv = *(const f32x4*)(lnw + col0 + bj * HALF + n * 16);
#pragma unroll
                for (int j = 0; j < 4; ++j) winv[bj][n][j] = 1.0f / wv[j]; }
#pragma unroll
        for (int ai = 0; ai < 2; ++ai)
#pragma unroll
            for (int m = 0; m < 4; ++m) { const int row = row0 + ai * HALF + m * 16; const size_t off = (size_t)row * DM + col0;
                const float inv = 1.0f / rstd3[row]; float sq = 0.f;
#pragma unroll
                for (int bj = 0; bj < 2; ++bj)
#pragma unroll
                    for (int n = 0; n < 2; ++n) { const size_t o2 = off + bj * HALF + n * 16; const h16x4 hv = *(const h16x4*)(H3 + o2), pv = *(const h16x4*)(PP + o2);
                        const f32x4 a = acc[ai][bj][m][n]; float o[4];
#pragma unroll
                        for (int j = 0; j < 4; ++j) { o[j] = (float)hv[j] * inv * winv[bj][n][j] + sigmoidf_(a[j]) * (float)pv[j]; sq += o[j] * o[j]; }
                        u32x2 w; w.x = pack_h2(o[0], o[1]); w.y = pack_h2(o[2], o[3]); *(u32x2*)(R3H + o2) = w; }
                sq += __shfl_xor(sq, 16); sq += __shfl_xor(sq, 32);
                if (fq == 0) unsafeAtomicAdd(rowsq + row, sq); }
    }
};
}

template <class ColPtr>
__device__ void cvt_transpose(LAS unsigned char* lds, h16* dst, int N, int K, int src_ld, ColPtr cp, int blk, int nblk) {
    const int tid = threadIdx.x, w = tid >> 6, l = tid & 63, nq = tid & 31, kp = tid >> 5;
    const int ktiles = K / 256, ntiles = (N / 128) * ktiles;
    f32x4 va[8], vb[8];
    auto fetch = [&](int t) {
        const int n0 = (t / ktiles) * 128, k0 = (t % ktiles) * 256;
        const float* sp = cp(n0 + (nq >> 3) * 32);
#pragma unroll
        for (int ps = 0; ps < 8; ++ps) {
            const int kk = 2 * (kp + 16 * ps);
            if (sp) { va[ps] = *(const f32x4*)(sp + (size_t)(k0 + kk) * src_ld + ((4 * nq) & 31)); vb[ps] = *(const f32x4*)(sp + (size_t)(k0 + kk + 1) * src_ld + ((4 * nq) & 31)); }
            else { va[ps] = (f32x4){0.f, 0.f, 0.f, 0.f}; vb[ps] = va[ps]; }
        }
    };
    if (blk < ntiles) fetch(blk);
    for (int t = blk; t < ntiles; t += nblk) {
        const int n0 = (t / ktiles) * 128, k0 = (t % ktiles) * 256;
        __syncthreads();
        const int sv = (nq & 15) << 1;
#pragma unroll
        for (int ps = 0; ps < 8; ++ps) { const int d = kp + 16 * ps;
#pragma unroll
            for (int j = 0; j < 4; ++j) *(LAS unsigned*)(lds + (4 * nq + j) * 512 + ((d ^ sv) << 2)) = pack_h2(va[ps][j], vb[ps][j]); }
        if (t + nblk < ntiles) fetch(t + nblk);
        __syncthreads();
#pragma unroll 4
        for (int r = 0; r < 16; ++r) { const int row = w * 16 + r, rv = ((row >> 2) & 15) << 1;
            const u32x2 x = *(const LAS u32x2*)(lds + row * 512 + (((2 * l) ^ rv) << 2));
            *(u32x2*)(dst + (size_t)(n0 + row) * K + k0 + 4 * l) = x; }
    }
}

template <class ColPtr>
__device__ void cvt_transpose_fp8(LAS unsigned char* lds, unsigned char* dst, int N, int K, int src_ld, float scale, ColPtr cp, int blk, int nblk) {
    const int tid = threadIdx.x, w = tid >> 6, l = tid & 63, nq = tid & 31, kq = tid >> 5;
    const int ktiles = K / 256, ntiles = (N / 128) * ktiles;
    f32x4 v[4][4];
    auto fetch = [&](int t) {
        const int n0 = (t / ktiles) * 128, k0 = (t % ktiles) * 256;
        const float* sp = cp(n0 + (nq >> 3) * 32);
#pragma unroll
        for (int ps = 0; ps < 4; ++ps)
#pragma unroll
            for (int q = 0; q < 4; ++q) v[ps][q] = *(const f32x4*)(sp + (size_t)(k0 + 4 * (kq + 16 * ps) + q) * src_ld + ((4 * nq) & 31));
    };
    if (blk < ntiles) fetch(blk);
    for (int t = blk; t < ntiles; t += nblk) {
        const int n0 = (t / ktiles) * 128, k0 = (t % ktiles) * 256;
        __syncthreads();
        const int sv = (nq & 15) << 1;
#pragma unroll
        for (int ps = 0; ps < 4; ++ps) { const int d = kq + 16 * ps;
#pragma unroll
            for (int j = 0; j < 4; ++j) *(LAS unsigned*)(lds + (4 * nq + j) * 256 + ((d ^ sv) << 2)) = pack_fp8x4(v[ps][0][j] * scale, v[ps][1][j] * scale, v[ps][2][j] * scale, v[ps][3][j] * scale); }
        if (t + nblk < ntiles) fetch(t + nblk);
        __syncthreads();
#pragma unroll 4
        for (int r = 0; r < 16; ++r) { const int row = w * 16 + r, rv = ((row >> 2) & 15) << 1;
            const unsigned x = *(const LAS unsigned*)(lds + row * 256 + ((l ^ rv) << 2));
            *(unsigned*)(dst + (size_t)(n0 + row) * K + k0 + 4 * l) = x; }
    }
}

__device__ void prep_fp8_weights(const Args& a, LAS unsigned char* lds, int blk, int nblk) {
    unsigned char* ws = a.ws;
    const int tid = threadIdx.x, w = tid >> 6, l = tid & 63, nq = tid & 31, kq = tid >> 5;
    constexpr int NT = 2048 + 1024;
    const float scale = (float)(1 << FP8_WSHIFT);
    struct Tile { const float* sp; int src_ld; unsigned char* dst; int K; };
    auto decode = [&](int gt) -> Tile {
        Tile t;
        if (gt < 2048) { const int e = gt >> 7, r = gt & 127, n0 = (r >> 2) * 128, k0 = (r & 3) * 256, nb = n0 + (nq >> 3) * 32;
            const int tile = nb >> 8, within = nb & 255, f = tile * 128 + (within & 127);
            t.sp = ((within >> 7) ? a.in[I_WUP] : a.in[I_WGATE]) + (size_t)e * DM * DFF + f + (size_t)k0 * DFF; t.src_ld = DFF; t.K = DM;
            t.dst = ws + OFF_WGU + (size_t)e * 2 * DFF * DM + (size_t)n0 * DM + k0; }
        else { const int g2 = gt - 2048, e = g2 >> 6, r = g2 & 63, n0 = (r >> 3) * 128, k0 = (r & 7) * 256, nb = n0 + (nq >> 3) * 32;
            t.sp = a.in[I_WDOWN] + (size_t)e * DFF * DM + nb + (size_t)k0 * DM; t.src_ld = DM; t.K = DFF;
            t.dst = ws + OFF_WD + (size_t)e * DM * DFF + (size_t)n0 * DFF + k0; }
        return t;
    };
    f32x4 v[4][4];
    auto fetch = [&](const Tile& t) {
#pragma unroll
        for (int ps = 0; ps < 4; ++ps)
#pragma unroll
            for (int q = 0; q < 4; ++q) v[ps][q] = *(const f32x4*)(t.sp + (size_t)(4 * (kq + 16 * ps) + q) * t.src_ld + ((4 * nq) & 31));
    };
    Tile cur;
    if (blk < NT) { cur = decode(blk); fetch(cur); }
    for (int gt = blk; gt < NT; gt += nblk) {
        __syncthreads();
        const int sv = (nq & 15) << 1;
#pragma unroll
        for (int ps = 0; ps < 4; ++ps) { const int d = kq + 16 * ps;
#pragma unroll
            for (int j = 0; j < 4; ++j) *(LAS unsigned*)(lds + (4 * nq + j) * 256 + ((d ^ sv) << 2)) = pack_fp8x4(v[ps][0][j] * scale, v[ps][1][j] * scale, v[ps][2][j] * scale, v[ps][3][j] * scale); }
        unsigned char* dst = cur.dst; const int K = cur.K;
        if (gt + nblk < NT) { cur = decode(gt + nblk); fetch(cur); }
        __syncthreads();
#pragma unroll 4
        for (int r = 0; r < 16; ++r) { const int row = w * 16 + r, rv = ((row >> 2) & 15) << 1;
            const unsigned x = *(const LAS unsigned*)(lds + row * 256 + ((l ^ rv) << 2));
            *(unsigned*)(dst + (size_t)row * K + 4 * l) = x; }
    }
}

__device__ void phase_prep(const Args& a, LAS unsigned char* lds, int blk, int nblk) {
    unsigned char* ws = a.ws;
    const int tid = threadIdx.x;
    if (blk == 0 && tid < 64) ((unsigned*)(ws + OFF_CTR))[tid] = 0u;
    auto rot = [&](int off) { return (blk - off + 4 * nblk) % nblk; };
    { const float* w = a.in[I_WIN]; cvt_transpose(lds, (h16*)(ws + OFF_WINA), NA1, DM, INCOLS, [=](int n0) { return n0 < 1568 ? w + n0 : (const float*)nullptr; }, rot(0), nblk); }
    { const float* w = a.in[I_WIN]; cvt_transpose(lds, (h16*)(ws + OFF_WINHY), HYC, DM, INCOLS, [=](int n0) { return w + 1568 + n0; }, rot(56), nblk); }
    { const float* w = a.in[I_WOUT]; cvt_transpose(lds, (h16*)(ws + OFF_WOUT), DM, DM, DM, [=](int n0) { return w + n0; }, rot(104), nblk); }
    { const float* w = a.in[I_WPG]; cvt_transpose(lds, (h16*)(ws + OFF_WG), DM, DM, DM, [=](int n0) { return w + n0; }, rot(136), nblk); }
    { const float* w = a.in[I_WPP]; cvt_transpose(lds, (h16*)(ws + OFF_WP), DM, 256, DM, [=](int n0) { return w + n0; }, rot(168), nblk); }
    prep_fp8_weights(a, lds, blk, nblk);
    { const f32x4* p = (const f32x4*)a.in[I_P]; u32x2* d = (u32x2*)(ws + OFF_P16); const size_t n4 = (size_t)NTOK * 256 / 4;
        for (size_t i = (size_t)blk * NTHREADS + tid; i < n4; i += (size_t)nblk * NTHREADS) { const f32x4 v = p[i]; u32x2 o; o.x = pack_h2(v[0], v[1]); o.y = pack_h2(v[2], v[3]); d[i] = o; } }
}

__device__ void phase_rmsnorm_h16(const float* X, const float* w, h16* H, int blk, int nblk) {
    constexpr int RP = 4;
    const int lane = threadIdx.x & 63, gw = blk * 8 + (threadIdx.x >> 6), nw = nblk * 8;
    f32x4 wv[4];
#pragma unroll
    for (int j = 0; j < 4; ++j) wv[j] = *(const f32x4*)(w + j * 256 + lane * 4);
    for (int row0 = gw * RP; row0 < NTOK; row0 += nw * RP) {
        f32x4 v[RP][4];
#pragma unroll
        for (int r = 0; r < RP; ++r)
#pragma unroll
            for (int j = 0; j < 4; ++j) v[r][j] = *(const f32x4*)(X + (size_t)(row0 + r) * DM + j * 256 + lane * 4);
#pragma unroll
        for (int r = 0; r < RP; ++r) {
            float ss = 0.f;
#pragma unroll
            for (int j = 0; j < 4; ++j) ss += v[r][j][0] * v[r][j][0] + v[r][j][1] * v[r][j][1] + v[r][j][2] * v[r][j][2] + v[r][j][3] * v[r][j][3];
            ss = wave_sum(ss);
            const float rstd = rsqrtf(ss * (1.0f / DM) + EPS);
            h16* hp = H + (size_t)(row0 + r) * DM;
#pragma unroll
            for (int j = 0; j < 4; ++j) { u32x2 o; o.x = pack_h2(v[r][j][0] * rstd * wv[j][0], v[r][j][1] * rstd * wv[j][1]); o.y = pack_h2(v[r][j][2] * rstd * wv[j][2], v[r][j][3] * rstd * wv[j][3]);
                *(u32x2*)(hp + j * 256 + lane * 4) = o; }
        }
    }
}

__device__ void phase_combine_norm(const h16* R, const h16* Y, const int* slotmap, const float* w, h16* H, float* rstd3, float* rowsq, int blk, int nblk) {
    constexpr int RP = 2;
    const int lane = threadIdx.x & 63, gw = blk * 8 + (threadIdx.x >> 6), nw = nblk * 8;
    f32x4 wv[4];
#pragma unroll
    for (int j = 0; j < 4; ++j) wv[j] = *(const f32x4*)(w + j * 256 + lane * 4);
    for (int row0 = gw * RP; row0 < NTOK; row0 += nw * RP) {
        f32x4 v[RP][4]; int myslot[RP];
#pragma unroll
        for (int r = 0; r < RP; ++r) {
            myslot[r] = (lane < NEXP) ? slotmap[(size_t)(row0 + r) * NEXP + lane] : -1;
#pragma unroll
            for (int j = 0; j < 4; ++j) { const h16x4 hv = *(const h16x4*)(R + (size_t)(row0 + r) * DM + j * 256 + lane * 4); v[r][j] = (f32x4){(float)hv[0], (float)hv[1], (float)hv[2], (float)hv[3]}; }
        }
#pragma unroll
        for (int r = 0; r < RP; ++r) {
            unsigned long long mask = __ballot(myslot[r] >= 0);
            const int b = (row0 + r) / SEQ;
            while (mask) {
                const int e = __builtin_ctzll(mask); mask &= mask - 1;
                const int sl = __shfl(myslot[r], e);
                const h16* yp = Y + ((size_t)(b * NEXP + e) * CAP + sl) * DM;
                h16x4 y4[4];
#pragma unroll
                for (int j = 0; j < 4; ++j) y4[j] = *(const h16x4*)(yp + j * 256 + lane * 4);
#pragma unroll
                for (int j = 0; j < 4; ++j)
#pragma unroll
                    for (int q = 0; q < 4; ++q) v[r][j][q] += (float)y4[j][q];
            }
        }
#pragma unroll
        for (int r = 0; r < RP; ++r) {
            float ss = 0.f;
#pragma unroll
            for (int j = 0; j < 4; ++j) { ss += v[r][j][0] * v[r][j][0] + v[r][j][1] * v[r][j][1] + v[r][j][2] * v[r][j][2] + v[r][j][3] * v[r][j][3]; }
            ss = wave_sum(ss);
            const float rstd = rsqrtf(ss * (1.0f / DM) + EPS);
            if (lane == 0) { rstd3[row0 + r] = rstd; rowsq[row0 + r] = 0.f; }
            h16* hp = H + (size_t)(row0 + r) * DM;
#pragma unroll
            for (int j = 0; j < 4; ++j) { u32x2 o; o.x = pack_h2(v[r][j][0] * rstd * wv[j][0], v[r][j][1] * rstd * wv[j][1]); o.y = pack_h2(v[r][j][2] * rstd * wv[j][2], v[r][j][3] * rstd * wv[j][3]);
                *(u32x2*)(hp + j * 256 + lane * 4) = o; }
        }
    }
}

__device__ void phase_final_norm(const h16* R3H, const float* rowsq, const float* w, float* out, int blk, int nblk) {
    constexpr int RP = 4;
    const int lane = threadIdx.x & 63, gw = blk * 8 + (threadIdx.x >> 6), nw = nblk * 8;
    f32x4 wv[4];
#pragma unroll
    for (int j = 0; j < 4; ++j) wv[j] = *(const f32x4*)(w + j * 256 + lane * 4);
    for (int row0 = gw * RP; row0 < NTOK; row0 += nw * RP) {
        h16x4 v[RP][4]; float sq[RP];
#pragma unroll
        for (int r = 0; r < RP; ++r) { sq[r] = rowsq[row0 + r];
#pragma unroll
            for (int j = 0; j < 4; ++j) v[r][j] = *(const h16x4*)(R3H + (size_t)(row0 + r) * DM + j * 256 + lane * 4); }
#pragma unroll
        for (int r = 0; r < RP; ++r) {
            const float rstd = rsqrtf(sq[r] * (1.0f / DM) + EPS);
#pragma unroll
            for (int j = 0; j < 4; ++j) { f32x4 o;
#pragma unroll
                for (int q = 0; q < 4; ++q) o[q] = (float)v[r][j][q] * rstd * wv[j][q];
                *(f32x4*)(out + (size_t)(row0 + r) * DM + j * 256 + lane * 4) = o; }
        }
    }
}

__device__ void phase_router(const h16* R, const float* w, const float* wrouter, unsigned char* H8, float* probs, LAS unsigned char* lds, int blk, int nblk) {
    constexpr int RP = 2;
    LAS float* wrT = (LAS float*)lds;
    const int tid = threadIdx.x, lane = tid & 63, gw = blk * 8 + (tid >> 6), nw = nblk * 8;
    __syncthreads();
    { float tmp[32];
#pragma unroll
        for (int q = 0; q < 32; ++q) { const int i = tid + NTHREADS * q, e = i >> 10, k = i & 1023; tmp[q] = wrouter[k * NEXP + e]; }
#pragma unroll
        for (int q = 0; q < 32; ++q) wrT[tid + NTHREADS * q] = tmp[q]; }
    __syncthreads();
    f32x4 wv[4];
#pragma unroll
    for (int j = 0; j < 4; ++j) wv[j] = *(const f32x4*)(w + j * 256 + lane * 4);
    const bool b5 = lane & 32, b4 = lane & 16, b3 = lane & 8, b2 = lane & 4;
    const int mye = (b5 ? 8 : 0) + (b4 ? 4 : 0) + (b3 ? 2 : 0) + (b2 ? 1 : 0);
    for (int row0 = gw * RP; row0 < NTOK; row0 += nw * RP) {
        f32x4 v[RP][4];
#pragma unroll
        for (int r = 0; r < RP; ++r)
#pragma unroll
            for (int j = 0; j < 4; ++j) { const h16x4 hv = *(const h16x4*)(R + (size_t)(row0 + r) * DM + j * 256 + lane * 4); v[r][j] = (f32x4){(float)hv[0], (float)hv[1], (float)hv[2], (float)hv[3]}; }
#pragma unroll
        for (int r = 0; r < RP; ++r) {
            float ss = 0.f;
#pragma unroll
            for (int j = 0; j < 4; ++j) ss += v[r][j][0] * v[r][j][0] + v[r][j][1] * v[r][j][1] + v[r][j][2] * v[r][j][2] + v[r][j][3] * v[r][j][3];
            ss = wave_sum(ss);
            const float rstd = rsqrtf(ss * (1.0f / DM) + EPS);
            unsigned char* hp = H8 + (size_t)(row0 + r) * DM;
#pragma unroll
            for (int j = 0; j < 4; ++j) { v[r][j] = v[r][j] * rstd * wv[j]; *(unsigned*)(hp + j * 256 + lane * 4) = pack_fp8x4(v[r][j][0], v[r][j][1], v[r][j][2], v[r][j][3]); }
        }
        float s8a[RP][8];
#pragma unroll
        for (int i = 0; i < 8; ++i) { asm volatile("" ::: "memory");
            f32x4 wa4[4], wb4[4];
#pragma unroll
            for (int j = 0; j < 4; ++j) { wa4[j] = *(const LAS f32x4*)(wrT + i * DM + j * 256 + lane * 4); wb4[j] = *(const LAS f32x4*)(wrT + (i + 8) * DM + j * 256 + lane * 4); }
#pragma unroll
            for (int r = 0; r < RP; ++r) { float sa = 0.f, sb = 0.f;
#pragma unroll
                for (int j = 0; j < 4; ++j) { sa += v[r][j][0] * wa4[j][0] + v[r][j][1] * wa4[j][1] + v[r][j][2] * wa4[j][2] + v[r][j][3] * wa4[j][3];
                                              sb += v[r][j][0] * wb4[j][0] + v[r][j][1] * wb4[j][1] + v[r][j][2] * wb4[j][2] + v[r][j][3] * wb4[j][3]; }
                const float send = b5 ? sa : sb, keep = b5 ? sb : sa; s8a[r][i] = keep + __shfl_xor(send, 32); } }
#pragma unroll
        for (int r = 0; r < RP; ++r) {
            float s8[8], s4[4], s2[2], lg;
#pragma unroll
            for (int i = 0; i < 8; ++i) s8[i] = s8a[r][i];
#pragma unroll
            for (int i = 0; i < 4; ++i) { const float send = b4 ? s8[i] : s8[i + 4], keep = b4 ? s8[i + 4] : s8[i]; s4[i] = keep + __shfl_xor(send, 16); }
#pragma unroll
            for (int i = 0; i < 2; ++i) { const float send = b3 ? s4[i] : s4[i + 2], keep = b3 ? s4[i + 2] : s4[i]; s2[i] = keep + __shfl_xor(send, 8); }
            { const float send = b2 ? s2[0] : s2[1], keep = b2 ? s2[1] : s2[0]; lg = keep + __shfl_xor(send, 4); }
            lg += __shfl_xor(lg, 1); lg += __shfl_xor(lg, 2);
            float mx = lg;
#pragma unroll
            for (int o = 4; o <= 32; o <<= 1) mx = fmaxf(mx, __shfl_xor(mx, o));
            const float ex = expf(lg - mx); float den = ex;
#pragma unroll
            for (int o = 4; o <= 32; o <<= 1) den += __shfl_xor(den, o);
            if ((lane & 3) == 0) { const int row = row0 + r, b = row / SEQ, t = row % SEQ; probs[((size_t)b * NEXP + mye) * SEQ + t] = ex / den; }
        }
    }
}

__device__ void phase_topk(const float* probs, int* selidx, float* selgate, int* slotmap, LAS unsigned char* lds, int blk, int nblk) {
    LAS int* hist = (LAS int*)lds;
    LAS int* red = hist + 256;
    const int tid = threadIdx.x, lane = tid & 63, wid = tid >> 6;
    for (int g = blk; g < NB * NEXP; g += nblk) {
        const float* pp = probs + (size_t)g * SEQ;
        unsigned key[8]; float pv[8];
        { const f32x4 a = *(const f32x4*)(pp + tid * 8), b = *(const f32x4*)(pp + tid * 8 + 4);
#pragma unroll
          for (int j = 0; j < 4; ++j) { pv[j] = a[j]; pv[4 + j] = b[j]; }
#pragma unroll
          for (int j = 0; j < 8; ++j) key[j] = __float_as_uint(pv[j]); }
        unsigned prefix = 0; int krem = CAP;
#pragma unroll 1
        for (int ps = 0; ps < 4; ++ps) {
            const int shift = ps == 0 ? 23 : ps == 1 ? 15 : ps == 2 ? 7 : 0, bits = ps == 3 ? 7 : 8;
            const unsigned mhi = ~((1u << (shift + bits)) - 1u), dmask = (1u << bits) - 1u;
            __syncthreads();
            if (tid < 256) hist[tid] = 0;
            __syncthreads();
#pragma unroll
            for (int j = 0; j < 8; ++j) if ((key[j] & mhi) == (prefix & mhi)) __hip_atomic_fetch_add(hist + ((key[j] >> shift) & dmask), 1, __ATOMIC_RELAXED, __HIP_MEMORY_SCOPE_WORKGROUP);
            __syncthreads();
            if (wid == 0) {
                int c[4], tot = 0;
#pragma unroll
                for (int q = 0; q < 4; ++q) { c[q] = hist[4 * lane + q]; tot += c[q]; }
                int S = tot;
#pragma unroll
                for (int o = 1; o < 64; o <<= 1) { const int t = __shfl_down(S, o); if (lane + o < 64) S += t; }
                const int above = S - tot;
                if (above < krem && krem <= S) {
                    int acc = above, dsel = 4 * lane, kn = krem; bool done = false;
#pragma unroll
                    for (int q = 3; q >= 0; --q) { if (!done && acc + c[q] >= krem) { dsel = 4 * lane + q; kn = krem - acc; done = true; } if (!done) acc += c[q]; }
                    red[0] = dsel; red[1] = kn;
                }
            }
            __syncthreads();
            prefix |= (unsigned)red[0] << shift; krem = red[1];
        }
        int cgt = 0, ceq = 0;
#pragma unroll
        for (int j = 0; j < 8; ++j) { cgt += (key[j] > prefix) ? 1 : 0; ceq += (key[j] == prefix) ? 1 : 0; }
        int sg = cgt, se = ceq;
#pragma unroll
        for (int o = 1; o < 64; o <<= 1) { const int a = __shfl_up(sg, o), b = __shfl_up(se, o); if (lane >= o) { sg += a; se += b; } }
        __syncthreads();
        if (lane == 63) { red[32 + wid] = sg; red[48 + wid] = se; }
        __syncthreads();
        int bg = 0, be = 0;
#pragma unroll
        for (int w = 0; w < 8; ++w) { const int x = red[32 + w], y = red[48 + w]; if (w < wid) { bg += x; be += y; } }
        int pg = bg + sg - cgt, pe = be + se - ceq;
        const int need = krem;
#pragma unroll
        for (int j = 0; j < 8; ++j) {
            const bool gt = key[j] > prefix, eq = key[j] == prefix;
            const bool take = gt || (eq && pe < need);
            const int slot = pg + (pe < need ? pe : need);
            if (take) { selidx[(size_t)g * CAP + slot] = (g / NEXP) * SEQ + tid * 8 + j; selgate[(size_t)g * CAP + slot] = pv[j]; }
            slotmap[((size_t)(g / NEXP) * SEQ + tid * 8 + j) * NEXP + (g % NEXP)] = take ? slot : -1;
            pg += gt ? 1 : 0; pe += eq ? 1 : 0;
        }
    }
}

struct __attribute__((packed, aligned(2))) H8U { h16 v[8]; };
__device__ void phase_filters(const Args& a, h16* GR, LAS unsigned char* lds, int blk, int nblk) {
    constexpr int NP = 16;
    LAS float* z = (LAS float*)lds;
    LAS float* h1 = z + NP * 32;
    LAS float* h2 = h1 + NP * 64;
    const int tid = threadIdx.x;
    const float* w1 = a.in[I_FW1]; const float* b1 = a.in[I_FB1]; const float* fr1 = a.in[I_FFR1];
    const float* w2 = a.in[I_FW2]; const float* b2 = a.in[I_FB2]; const float* fr2 = a.in[I_FFR2];
    const float* w3 = a.in[I_FW3]; const float* hb = a.in[I_HBIAS];
    const float MIND = logf(1e-2f) / 1.5f, MAXD = logf(1e-2f) / 0.3f;
    for (int it = blk; it < SEQ / NP; it += nblk) {
        const int t0 = it * NP;
        __syncthreads();
        if (tid < NP * 17) { const int pos = tid / 17, i = tid % 17, t = t0 + pos; float v;
            if (i == 0) v = (float)t / (float)(SEQ - 1);
            else { const int bi = (i - 1) & 7; const float f = 1e-4f + (float)bi * ((7.0f - 1e-4f) / 7.0f); const float wp = 6.283185307179586f * (float)t / (float)SEQ; const float ang = f * wp;
                float sn, cs; sincos_f(ang, sn, cs); v = (i <= 8) ? cs : -sn; }
            z[pos * 32 + i] = v; }
        __syncthreads();
#pragma unroll
        for (int hf = 0; hf < NP / 8; ++hf) { const int pos = hf * 8 + (tid >> 6), j = tid & 63; float s = b1[j];
#pragma unroll
            for (int i = 0; i < 17; ++i) s += z[pos * 32 + i] * w1[i * 64 + j];
            h1[pos * 64 + j] = sin_f(fr1[j] * s); }
        __syncthreads();
#pragma unroll
        for (int hf = 0; hf < NP / 8; ++hf) { const int pos = hf * 8 + (tid >> 6), j = tid & 63; float s = b2[j];
#pragma unroll 16
            for (int i = 0; i < 64; ++i) s += h1[pos * 64 + i] * w2[i * 64 + j];
            h2[j * NP + pos] = sin_f(fr2[j] * s); }
        __syncthreads();
#pragma unroll 1
        for (int q = 0; q < 4; ++q) {
            const int col = q * 512 + tid; float acc[NP];
#pragma unroll
            for (int p = 0; p < NP; ++p) acc[p] = 0.f;
#pragma unroll 16
            for (int j = 0; j < 64; ++j) { const float wv = w3[j * 2048 + col];
#pragma unroll
                for (int p4 = 0; p4 < NP / 4; ++p4) { const f32x4 hv = *(const LAS f32x4*)(h2 + j * NP + p4 * 4);
#pragma unroll
                    for (int p = 0; p < 4; ++p) acc[p4 * 4 + p] += hv[p] * wv; } }
            const int o = col >> 10, dir = (col >> 9) & 1, c = col & 511;
            const float delta = fabsf(MIND + (float)c * ((MAXD - MIND) / 511.0f));
            h16* gp = GR + ((size_t)o * HYW + c) * 8192;
            float vals[NP];
#pragma unroll
            for (int p = 0; p < NP; ++p) { const int t = t0 + p; const float tl = (float)t / (float)(SEQ - 1); float v = acc[p] * expf(-tl * delta);
                if (dir == 0 && t == 0) v += hb[o * HYW + c];
                vals[p] = v * HY_SCALE; }
            if (dir == 0) {
                h16x8 lo, hi;
#pragma unroll
                for (int q = 0; q < 8; ++q) { lo[q] = (h16)vals[15 - q]; hi[q] = (h16)vals[7 - q]; }
                *(h16x8*)(gp + 4080 - t0) = lo; *(h16x8*)(gp + 4088 - t0) = hi;
            } else {
                H8U lo, hi;
#pragma unroll
                for (int q = 0; q < 8; ++q) { lo.v[q] = (h16)vals[q]; hi.v[q] = (h16)vals[8 + q]; }
                if (t0 == 0) {
#pragma unroll
                    for (int q = 1; q < 8; ++q) gp[4095 + q] = lo.v[q];
                    gp[8191] = (h16)0.f;
                } else *(H8U*)(gp + 4095 + t0) = lo;
                *(H8U*)(gp + 4095 + t0 + 8) = hi;
            }
        }
    }
}

constexpr int HY_ROW = 8192, HY_UIMG = 16 * HY_ROW, HY_RING = 24;
__device__ __forceinline__ int hy_uoff(int b, int s) { return b * HY_ROW + ((((s >> 3) ^ b) << 4) | ((s & 7) << 1)); }
#define HY_MFMA(acc_, a_, b_) asm volatile("v_mfma_f32_16x16x32_f16 %0, %1, %2, %0" : "+v"(acc_) : "v"(a_), "v"(b_))
__device__ void phase_hyena(const h16* __restrict__ hy, h16* __restrict__ z2, const h16* __restrict__ gr, const float* __restrict__ cw, const float* __restrict__ cb, unsigned* __restrict__ queue0, LAS unsigned char* lds, int reps) {
    const int tid = threadIdx.x, w = __builtin_amdgcn_readfirstlane(tid >> 6), l = tid & 63, bcol = l & 15, kg = l >> 4;
    LAS unsigned char* uimg = lds; LAS unsigned char* ring = lds + HY_UIMG;
    LAS int* qslot = (LAS int*)(lds + HY_UIMG + HY_RING * 1024);
    const int lbase = 4095 - (l & 15) + 8 * (l >> 4);
#pragma unroll 1
    for (int rep = 0; rep < reps; ++rep) {
    unsigned* queue = queue0 + rep;
    for (;;) {
        __syncthreads();
        if (tid == 0) *qslot = (int)atomicAdd(queue, 1u);
        __syncthreads();
        const int c = *qslot;
        if (c >= HYW) break;
        { const float w0 = cw[c], w1 = cw[HYC + c], w2 = cw[2 * HYC + c], bb = cb[c]; const int t0 = tid * 8;
#pragma unroll 8
            for (int b = 0; b < NB; ++b) {
                const h16* src = hy + (size_t)c * NTOK + (size_t)b * SEQ;
                const h16x8 rv = *(const h16x8*)(src + t0);
                const float rm = (t0 > 0) ? (float)src[t0 - 1] : 0.f, rp = (t0 + 8 < SEQ) ? (float)src[t0 + 8] : 0.f;
                float r[10]; r[0] = rm; r[9] = rp;
#pragma unroll
                for (int j = 0; j < 8; ++j) r[1 + j] = (float)rv[j];
                h16x8 o;
#pragma unroll
                for (int j = 0; j < 8; ++j) o[j] = (h16)(bb + w0 * r[j] + w1 * r[j + 1] + w2 * r[j + 2]);
                *(LAS h16x8*)(uimg + b * HY_ROW + ((tid ^ b) << 4)) = o;
            } }
#pragma unroll 1
        for (int o = 0; o < 2; ++o) {
            const h16* grp = gr + ((size_t)o * HYW + c) * 8192;
            f32x4 acc[8][4];
#pragma unroll
            for (int i = 0; i < 8; ++i)
#pragma unroll
                for (int m = 0; m < 4; ++m) acc[i][m] = (f32x4){0.f, 0.f, 0.f, 0.f};
            { const int phi = -256 + w; if (phi >= -254) { const H8U v0 = *(const H8U*)(grp + lbase - 16 * phi); *(LAS h16x8*)(ring + ((phi + 264) % HY_RING) * 1024 + l * 16) = __builtin_bit_cast(h16x8, v0); } }
            h16x8 fragA = __builtin_bit_cast(h16x8, *(const H8U*)(grp + lbase - 16 * (-248 + w))), fragB = {};
            __syncthreads();
#define HY_STEP(st_, fcur_, fnext_) do { \
                const int d0 = -64 + 2 * (st_); \
                if ((st_) < 62) fnext_ = __builtin_bit_cast(h16x8, *(const H8U*)(grp + lbase - 16 * (4 * (d0 + 4) + w))); \
                const int sbase = (4 * d0 - 2 + 264) % HY_RING; \
                _Pragma("unroll") for (int dd = 0; dd < 2; ++dd) { \
                    const int delta = d0 + dd; \
                    if (delta >= -63) { \
                        h16x8 A6[6]; \
                        _Pragma("unroll") for (int q = 0; q < 6; ++q) { int sl = sbase + 4 * dd + q; sl = sl >= HY_RING ? sl - HY_RING : sl; A6[q] = *(const LAS h16x8*)(ring + sl * 1024 + l * 16); } \
                        _Pragma("unroll") for (int i = 0; i < 8; ++i) { \
                            const int s1 = w + 8 * i - delta; \
                            if ((unsigned)s1 < 64u) { \
                                const int ch = 8 * s1 + kg; \
                                const h16x8 B0 = *(const LAS h16x8*)(uimg + bcol * HY_ROW + ((ch ^ bcol) << 4)), B1 = *(const LAS h16x8*)(uimg + bcol * HY_ROW + (((ch + 4) ^ bcol) << 4)); \
                                __builtin_amdgcn_s_setprio(1); \
                                _Pragma("unroll") for (int m = 0; m < 4; ++m) { HY_MFMA(acc[i][m], A6[m + 2], B0); HY_MFMA(acc[i][m], A6[m], B1); } \
                                __builtin_amdgcn_s_setprio(0); \
                            } } } } \
                if ((st_) < 63) *(LAS h16x8*)(ring + ((4 * (d0 + 2) + w + 264) % HY_RING) * 1024 + l * 16) = fcur_; \
                asm volatile("s_waitcnt lgkmcnt(0)" ::: "memory"); __builtin_amdgcn_s_barrier(); asm volatile("" ::: "memory"); \
            } while (0)
#pragma unroll 1
            for (int st = 0; st < 64; st += 2) { HY_STEP(st, fragA, fragB); HY_STEP(st + 1, fragB, fragA); }
#undef HY_STEP
            asm volatile("s_nop 15\n\ts_nop 15" ::: "memory");
            const int ch = (o + 1) * HYW + c;
            const float w0 = cw[ch], w1 = cw[HYC + ch], w2 = cw[2 * HYC + ch], bb = cb[ch];
            int kg_e = kg, bcol_e = bcol; asm volatile("" : "+v"(kg_e), "+v"(bcol_e));
            const h16* xsrc = hy + (size_t)ch * NTOK + (size_t)bcol_e * SEQ;
#pragma unroll
            for (int ih = 0; ih < 4; ++ih) {
                h16x4 xv[2][4]; h16 xm[2][4], xp[2][4];
#pragma unroll
                for (int ii = 0; ii < 2; ++ii)
#pragma unroll
                    for (int m = 0; m < 4; ++m) {
                        const int t = 64 * (w + 8 * (2 * ih + ii)) + 16 * m + 4 * kg_e;
                        xv[ii][m] = *(const h16x4*)(xsrc + t);
                        xm[ii][m] = (t > 0) ? xsrc[t - 1] : (h16)0.f; xp[ii][m] = (t + 4 < SEQ) ? xsrc[t + 4] : (h16)0.f;
                    }
#pragma unroll
                for (int ii = 0; ii < 2; ++ii)
#pragma unroll
                    for (int m = 0; m < 4; ++m) {
                        const int i = 2 * ih + ii;
                        const int t = 64 * (w + 8 * i) + 16 * m + 4 * kg_e;
                        float r[6]; r[0] = (float)xm[ii][m]; r[5] = (float)xp[ii][m];
#pragma unroll
                        for (int jj = 0; jj < 4; ++jj) r[1 + jj] = (float)xv[ii][m][jj];
                        h16x4 zo;
#pragma unroll
                        for (int jj = 0; jj < 4; ++jj) zo[jj] = (h16)((bb + w0 * r[jj] + w1 * r[jj + 1] + w2 * r[jj + 2]) * acc[i][m][jj] * (1.0f / HY_SCALE));
                        if (o == 0) *(LAS h16x4*)(uimg + hy_uoff(bcol_e, t)) = zo;
                        else *(h16x4*)(z2 + (size_t)c * NTOK + (size_t)bcol_e * SEQ + t) = zo;
                    }
                asm volatile("" ::: "memory");
            }
        }
    }
}
}

__device__ __forceinline__ float wave_incl_scan(float x) {
#define DPP_ADD(ctrl, rmask, bctl) x += __builtin_bit_cast(float, __builtin_amdgcn_update_dpp(0, __builtin_bit_cast(int, x), ctrl, rmask, 0xf, bctl))
    DPP_ADD(0x111, 0xf, true);
    DPP_ADD(0x112, 0xf, true);
    DPP_ADD(0x114, 0xf, true);
    DPP_ADD(0x118, 0xf, true);
    DPP_ADD(0x142, 0xa, false);
    DPP_ADD(0x143, 0xc, false);
#undef DPP_ADD
    return x;
}

constexpr int GL_QD = 0, GL_KI = 8192, GL_KDT = 16384, GL_P = 24576, GL_VT = 32768, GL_EDL = 49152, GL_WA = 49408, GL_BA = 53504, GL_QS = 54272, GL_KS = 62464, GL_VS = 70656, GL_CS = 87040;
__device__ __forceinline__ int gsw(int row, int col) { return row * 128 + ((((col >> 3) ^ (row & 7)) << 4) | ((col & 7) << 1)); }
#define GLA_BAR() do { asm volatile("s_waitcnt lgkmcnt(0)" ::: "memory"); __builtin_amdgcn_s_barrier(); asm volatile("" ::: "memory"); } while (0)
__device__ void phase_gla(const h16* __restrict__ qkvg, const float* __restrict__ codes, const float* __restrict__ waf, const float* __restrict__ baf,
                          const float* __restrict__ wab, const float* __restrict__ bab, h16* __restrict__ of, h16* __restrict__ ob, LAS unsigned char* lds, int first, int stride, int reps) {
    const int tid = threadIdx.x, w = __builtin_amdgcn_readfirstlane(tid >> 6), l = tid & 63, m16 = l & 15, kg = l >> 4;
    LAS float* EDL = (LAS float*)(lds + GL_EDL); LAS float* WA = (LAS float*)(lds + GL_WA); LAS float* BA = (LAS float*)(lds + GL_BA);
    for (int item = first; item < NB * 8 * reps; item += stride) {
        const int b = (item >> 3) % NB, h = (item >> 1) & 3, dir = item & 1;
        const float* wa = dir ? wab : waf; const float* ba = dir ? bab : baf; h16* O = dir ? ob : of;
        __syncthreads();
        for (int i = tid; i < 16 * 64; i += NTHREADS) WA[i] = wa[(i >> 6) * 256 + h * 64 + (i & 63)];
        if (tid < 64) BA[tid] = ba[h * 64 + tid];
        f32x4 S[4];
#pragma unroll
        for (int m = 0; m < 4; ++m) S[m] = (f32x4){0.f, 0.f, 0.f, 0.f};
        h16x8 pq, pk, pv0, pv1; f32x4 pc;
#define GLA_ROW(n_, c_) ((size_t)b * SEQ + (dir ? (SEQ - 1 - (64 * (n_) + (c_))) : (64 * (n_) + (c_))))
#define GLA_FETCH(n_) do { const size_t rq_ = GLA_ROW(n_, tid >> 3); pq = *(const h16x8*)(qkvg + rq_ * 1536 + h * 64 + (tid & 7) * 8); pk = *(const h16x8*)(qkvg + rq_ * 1536 + 256 + h * 64 + (tid & 7) * 8); \
            const size_t rv0_ = GLA_ROW(n_, tid >> 4), rv1_ = GLA_ROW(n_, 32 + (tid >> 4)); pv0 = *(const h16x8*)(qkvg + rv0_ * 1536 + 512 + h * 128 + (tid & 15) * 8); pv1 = *(const h16x8*)(qkvg + rv1_ * 1536 + 512 + h * 128 + (tid & 15) * 8); \
            if (tid < 256) pc = *(const f32x4*)(codes + GLA_ROW(n_, tid >> 2) * 32 + dir * 16 + (tid & 3) * 4); } while (0)
#define GLA_PARK() do { { const int t_ = tid >> 3, p_ = tid & 7; *(LAS h16x8*)(lds + GL_QS + t_ * 128 + ((p_ ^ (t_ & 7)) << 4)) = pq; *(LAS h16x8*)(lds + GL_KS + t_ * 128 + ((p_ ^ (t_ & 7)) << 4)) = pk; } \
            { const int t0_ = tid >> 4, t1_ = 32 + (tid >> 4), p_ = tid & 15; *(LAS h16x8*)(lds + GL_VS + t0_ * 256 + ((p_ ^ ((t0_ & 7) << 1)) << 4)) = pv0; *(LAS h16x8*)(lds + GL_VS + t1_ * 256 + ((p_ ^ ((t1_ & 7) << 1)) << 4)) = pv1; } \
            if (tid < 256) *(LAS f32x4*)(lds + GL_CS + (tid >> 2) * 80 + (tid & 3) * 16) = pc; } while (0)
        GLA_FETCH(0);
        GLA_PARK();
        GLA_FETCH(1);
#pragma unroll 1
        for (int n = 0; n < SEQ / 64; ++n) {
            GLA_BAR();
            {
                const h16x8 cq = *(const LAS h16x8*)(lds + GL_QS + l * 128 + ((w ^ (l & 7)) << 4)), ck = *(const LAS h16x8*)(lds + GL_KS + l * 128 + ((w ^ (l & 7)) << 4));
                const h16x8 cv0 = *(const LAS h16x8*)(lds + GL_VS + l * 256 + (((2 * w) ^ ((l & 7) << 1)) << 4)), cv1 = *(const LAS h16x8*)(lds + GL_VS + l * 256 + (((2 * w + 1) ^ ((l & 7) << 1)) << 4));
                f32x4 cc[4];
#pragma unroll
                for (int r = 0; r < 4; ++r) cc[r] = *(const LAS f32x4*)(lds + GL_CS + l * 80 + r * 16);
                float z[8];
                { const f32x4 b0 = *(const LAS f32x4*)(BA + 8 * w), b1 = *(const LAS f32x4*)(BA + 8 * w + 4);
#pragma unroll
                  for (int j = 0; j < 4; ++j) { z[j] = b0[j]; z[4 + j] = b1[j]; } }
#pragma unroll
                for (int r = 0; r < 16; ++r) { const float cr = cc[r >> 2][r & 3]; const f32x4 w0 = *(const LAS f32x4*)(WA + r * 64 + 8 * w), w1 = *(const LAS f32x4*)(WA + r * 64 + 8 * w + 4);
#pragma unroll
                    for (int j = 0; j < 4; ++j) { z[j] += cr * w0[j]; z[4 + j] += cr * w1[j]; } }
                h16x8 qd, ki, kd; float edl[8];
#pragma unroll
                for (int j = 0; j < 8; ++j) {
                    const float ls = fminf(z[j], 0.f) - __logf(1.0f + __expf(-fabsf(z[j])));
                    float bb = ls * (1.0f / 16.0f);
                    bb = wave_incl_scan(bb);
                    const float bl = __builtin_bit_cast(float, __builtin_amdgcn_readlane(__builtin_bit_cast(int, bb), 63));
                    const float E = __expf(bb), Ei = 1.0f / E, el = __expf(bl);
                    edl[j] = el;
                    qd[j] = (h16)((float)cq[j] * 0.125f * E); const float kiv = (float)ck[j] * Ei; ki[j] = (h16)kiv; kd[j] = (h16)(kiv * el);
                }
                *(LAS h16x8*)(lds + GL_QD + l * 128 + ((w ^ (l & 7)) << 4)) = qd;
                *(LAS h16x8*)(lds + GL_KI + l * 128 + ((w ^ (l & 7)) << 4)) = ki;
#pragma unroll
                for (int j = 0; j < 8; ++j) *(LAS h16*)(lds + GL_KDT + gsw(8 * w + j, l)) = kd[j];
#pragma unroll
                for (int j = 0; j < 8; ++j) { *(LAS h16*)(lds + GL_VT + gsw(16 * w + j, l)) = cv0[j]; *(LAS h16*)(lds + GL_VT + gsw(16 * w + 8 + j, l)) = cv1[j]; }
                if (l == 0) {
#pragma unroll
                    for (int j = 0; j < 8; ++j) EDL[8 * w + j] = edl[j]; }
            }
            GLA_BAR();
            {
                const int mi = w & 3;
                h16x8 Aq[2];
                Aq[0] = *(const LAS h16x8*)(lds + GL_QD + gsw(16 * mi + m16, 8 * kg)); Aq[1] = *(const LAS h16x8*)(lds + GL_QD + gsw(16 * mi + m16, 32 + 8 * kg));
#pragma unroll
                for (int q = 0; q < 2; ++q) {
                    const int nj = 2 * (w >> 2) + q;
                    if (nj <= mi) {
                        const h16x8 B0 = *(const LAS h16x8*)(lds + GL_KI + gsw(16 * nj + m16, 8 * kg)), B1 = *(const LAS h16x8*)(lds + GL_KI + gsw(16 * nj + m16, 32 + 8 * kg));
                        f32x4 p = (f32x4){0.f, 0.f, 0.f, 0.f};
                        p = __builtin_amdgcn_mfma_f32_16x16x32_f16(Aq[0], B0, p, 0, 0, 0);
                        p = __builtin_amdgcn_mfma_f32_16x16x32_f16(Aq[1], B1, p, 0, 0, 0);
#pragma unroll
                        for (int r = 0; r < 4; ++r) { const int c = 16 * mi + 4 * kg + r, cp = 16 * nj + m16; const bool keep = dir ? (cp < c) : (cp <= c);
                            *(LAS h16*)(lds + GL_P + gsw(c, cp)) = (h16)(keep ? p[r] : 0.f); }
                    } else if ((nj >> 1) == (mi >> 1)) {
#pragma unroll
                        for (int r = 0; r < 4; ++r) *(LAS h16*)(lds + GL_P + gsw(16 * mi + 4 * kg + r, 16 * nj + m16)) = (h16)0.f;
                    }
                }
            }
            GLA_BAR();
            {
                h16x8 Bv[2];
                Bv[0] = *(const LAS h16x8*)(lds + GL_VT + gsw(16 * w + m16, 8 * kg)); Bv[1] = *(const LAS h16x8*)(lds + GL_VT + gsw(16 * w + m16, 32 + 8 * kg));
                h16x8 Sf[2];
#pragma unroll
                for (int ks = 0; ks < 2; ++ks)
#pragma unroll
                    for (int j = 0; j < 4; ++j) { Sf[ks][j] = (h16)S[2 * ks][j]; Sf[ks][4 + j] = (h16)S[2 * ks + 1][j]; }
#pragma unroll
                for (int mi = 0; mi < 4; ++mi) {
                    f32x4 o = (f32x4){0.f, 0.f, 0.f, 0.f};
#pragma unroll
                    for (int ks = 0; ks < 2; ++ks) {
                        if (!(ks == 1 && mi < 2)) { const h16x8 Ap = *(const LAS h16x8*)(lds + GL_P + gsw(16 * mi + m16, 32 * ks + 8 * kg)); o = __builtin_amdgcn_mfma_f32_16x16x32_f16(Ap, Bv[ks], o, 0, 0, 0); }
                        const h16x4 a0 = *(const LAS h16x4*)(lds + GL_QD + gsw(16 * mi + m16, 32 * ks + 4 * kg)), a1 = *(const LAS h16x4*)(lds + GL_QD + gsw(16 * mi + m16, 32 * ks + 16 + 4 * kg));
                        h16x8 Aqs;
#pragma unroll
                        for (int j = 0; j < 4; ++j) { Aqs[j] = a0[j]; Aqs[4 + j] = a1[j]; }
                        o = __builtin_amdgcn_mfma_f32_16x16x32_f16(Aqs, Sf[ks], o, 0, 0, 0);
                    }
#pragma unroll
                    for (int r = 0; r < 4; ++r) { const int c = 16 * mi + 4 * kg + r; const int tok = dir ? (SEQ - 1 - (64 * n + c)) : (64 * n + c);
                        O[((size_t)b * SEQ + tok) * 512 + h * 128 + 16 * w + m16] = (h16)o[r]; }
                }
#pragma unroll
                for (int mt = 0; mt < 4; ++mt) {
                    const f32x4 e4 = *(const LAS f32x4*)(EDL + 16 * mt + 4 * kg);
                    S[mt] = S[mt] * e4;
#pragma unroll
                    for (int ks = 0; ks < 2; ++ks) { const h16x8 Ak = *(const LAS h16x8*)(lds + GL_KDT + gsw(16 * mt + m16, 32 * ks + 8 * kg)); S[mt] = __builtin_amdgcn_mfma_f32_16x16x32_f16(Ak, Bv[ks], S[mt], 0, 0, 0); }
                }
            }
            if (n + 1 < SEQ / 64) GLA_PARK();
            if (n + 2 < SEQ / 64) GLA_FETCH(n + 2);
        }
    }
}

__device__ void phase_mixbuild(const h16* __restrict__ of, const h16* __restrict__ ob, const h16* __restrict__ qkvg, const float* __restrict__ nw, const h16* __restrict__ z2,
                               h16* __restrict__ mix, LAS unsigned char* lds, int blk, int nblk) {
    LAS h16* tileT = (LAS h16*)lds;
    const int tid = threadIdx.x;
    float nwv[8];
#pragma unroll
    for (int j = 0; j < 8; ++j) nwv[j] = nw[(tid & 15) * 8 + j];
    for (int sl = blk; sl < NTOK / 64; sl += nblk) {
        const int tok0 = sl * 64;
        h16x8 zv[8];
#pragma unroll
        for (int i = 0; i < 8; ++i) zv[i] = *(const h16x8*)(z2 + (size_t)tid * NTOK + tok0 + 8 * i);
#pragma unroll 2
        for (int i = 0; i < 8; ++i) {
            const int task = tid + NTHREADS * i, token = task >> 6, head = (task >> 4) & 3, part = task & 15;
            const size_t row = (size_t)tok0 + token;
            const h16x8 a = *(const h16x8*)(of + row * 512 + head * 128 + part * 8), b = *(const h16x8*)(ob + row * 512 + head * 128 + part * 8);
            const h16x8 g = *(const h16x8*)(qkvg + row * 1536 + 1024 + head * 128 + part * 8);
            float o[8], ss = 0.f;
#pragma unroll
            for (int j = 0; j < 8; ++j) { o[j] = (float)a[j] + (float)b[j]; ss += o[j] * o[j]; }
            ss += __shfl_xor(ss, 1); ss += __shfl_xor(ss, 2); ss += __shfl_xor(ss, 4); ss += __shfl_xor(ss, 8);
            const float rstd = rsqrtf(ss * (1.0f / 128.0f) + EPS);
            h16x8 r;
#pragma unroll
            for (int j = 0; j < 8; ++j) r[j] = (h16)(o[j] * rstd * nwv[j] * siluf_((float)g[j]));
            *(h16x8*)(mix + row * DM + head * 128 + part * 8) = r;
        }
        __syncthreads();
#pragma unroll
        for (int i = 0; i < 8; ++i)
#pragma unroll
            for (int j = 0; j < 8; ++j) tileT[(8 * i + j) * 520 + tid] = zv[i][j];
        __syncthreads();
#pragma unroll
        for (int i = 0; i < 8; ++i) { const int idx = tid + NTHREADS * i, token = idx >> 6, c8 = (idx & 63) * 8;
            *(h16x8*)(mix + (size_t)(tok0 + token) * DM + 512 + c8) = *(const LAS h16x8*)(tileT + token * 520 + c8); }
    }
}

enum { PH_PREP = 0, PH_NORM1, PH_FILT, PH_G1A, PH_G1B, PH_GLA, PH_HYENA, PH_GLAMIX, PH_G2, PH_ROUTER, PH_TOPK, PH_MOE1, PH_MOE2, PH_NORM3, PH_G5, PH_G6, PH_FINAL, PH_COUNT };

template <bool COOP>
__global__ __launch_bounds__(NTHREADS, 2) void mega(Args a) {
    extern __shared__ __attribute__((aligned(16))) unsigned char shm[];
    LAS unsigned char* lds = (LAS unsigned char*)shm;
    const int blk = blockIdx.x, nblk = gridDim.x;
    unsigned char* ws = a.ws;
#ifndef PROBE_MASK
#define PROBE_MASK 0u
#endif
#define RUN(P, SYNC, ...) if (a.ph_lo <= (P) && (P) < a.ph_hi) { { __syncthreads(); const float pscale = 1.f; (void)pscale; __VA_ARGS__ } \
        if constexpr (((PROBE_MASK >> (P)) & 1u) != 0u && (P) != PH_GLA && (P) != PH_HYENA) { if (COOP) cg::this_grid().sync(); __syncthreads(); const float pscale = 0.f; (void)pscale; __VA_ARGS__ } \
        if (COOP && (SYNC)) { if ((P) + 1 < a.ph_hi) cg::this_grid().sync(); } }
    RUN(PH_PREP, false, phase_prep(a, lds, blk, nblk);)
    RUN(PH_NORM1, false, phase_rmsnorm_h16(a.in[I_X], a.in[I_LNMIX], (h16*)(ws + OFF_H), blk, nblk);)
    RUN(PH_FILT, true, phase_filters(a, (h16*)(ws + OFF_GR), lds, blk, nblk);)
    RUN(PH_G1A, false, { g8::DenseSched S; S.init(ws + OFF_WINA, NTOK, NA1, DM, nblk, blk); g8::EpiQKVG E{(h16*)(ws + OFF_QKVG), (float*)(ws + OFF_CODES)};
        g8::gemm_phase(lds, (const char*)(ws + OFF_H), DM, S, E); })
    RUN(PH_G1B, true, { g8::DenseSched S; S.init(ws + OFF_H, HYC, NTOK, DM, nblk, blk); g8::EpiH16 E{(h16*)(ws + OFF_HY), NTOK};
        g8::gemm_phase(lds, (const char*)(ws + OFF_WINHY), DM, S, E); })
    RUN(PH_GLA, false, { const int ng = nblk >= 2 * NB * 8 ? NB * 8 : nblk;
        if (blk >= nblk - ng) phase_gla((const h16*)(ws + OFF_QKVG), (const float*)(ws + OFF_CODES), a.in[I_WAF], a.in[I_BAF], a.in[I_WAB], a.in[I_BAB], (h16*)(ws + OFF_OF), (h16*)(ws + OFF_OB), lds, blk - (nblk - ng), ng, 1 + (int)((PROBE_MASK >> 5) & 1u)); })
    RUN(PH_HYENA, true, phase_hyena((const h16*)(ws + OFF_HY), (h16*)(ws + OFF_Z2), (const h16*)(ws + OFF_GR), a.in[I_HCW], a.in[I_HCB], (unsigned*)(ws + OFF_CTR), lds, 1 + (int)((PROBE_MASK >> 6) & 1u));)
    RUN(PH_GLAMIX, true, phase_mixbuild((const h16*)(ws + OFF_OF), (const h16*)(ws + OFF_OB), (const h16*)(ws + OFF_QKVG), a.in[I_GLANW], (const h16*)(ws + OFF_Z2), (h16*)(ws + OFF_H), lds, blk, nblk);)
    RUN(PH_G2, true, { g8::DenseSched S; S.init(ws + OFF_WOUT, NTOK, DM, DM, nblk, blk); g8::EpiResid E{a.in[I_X], (h16*)a.out};
        g8::gemm_phase(lds, (const char*)(ws + OFF_H), DM, S, E); })
    RUN(PH_ROUTER, true, phase_router((const h16*)a.out, a.in[I_LNFFN], a.in[I_WROUTER], ws + OFF_H, (float*)(ws + OFF_PROBS), lds, blk, nblk);)
    RUN(PH_TOPK, true, phase_topk((const float*)(ws + OFF_PROBS), (int*)(ws + OFF_SELIDX), (float*)(ws + OFF_SELGATE), (int*)(ws + OFF_SLOTMAP), lds, blk, nblk);)
    RUN(PH_MOE1, true, { g8::Moe1Sched S{(const char*)(ws + OFF_WGU), (const int*)(ws + OFF_SELIDX), nblk, blk}; g8::EpiHid E{ws + OFF_HID};
        g8::gemm_phase<g8::EpiHid, g8::Moe1Sched, true>(lds, (const char*)(ws + OFF_H), DM / 2, S, E); })
    RUN(PH_MOE2, true, { g8::Moe2Sched S{(const char*)(ws + OFF_WD), nblk, blk}; g8::EpiDown E{(h16*)(ws + OFF_Y), (const float*)(ws + OFF_SELGATE)};
        g8::gemm_phase<g8::EpiDown, g8::Moe2Sched, true>(lds, (const char*)(ws + OFF_HID), DFF / 2, S, E); })
    RUN(PH_NORM3, false, phase_combine_norm((const h16*)a.out, (const h16*)(ws + OFF_Y), (const int*)(ws + OFF_SLOTMAP), a.in[I_LNPLE], (h16*)(ws + OFF_H3), (float*)(ws + OFF_RSTD3), (float*)(ws + OFF_ROWSQ), blk, nblk);)
    RUN(PH_G5, true, { g8::DenseSched S; S.init(ws + OFF_WP, NTOK, DM, 256, nblk, blk); g8::EpiH16 E{(h16*)(ws + OFF_PP), DM};
        g8::gemm_phase(lds, (const char*)(ws + OFF_P16), 256, S, E); })
    RUN(PH_G6, true, { g8::DenseSched S; S.init(ws + OFF_WG, NTOK, DM, DM, nblk, blk); g8::EpiPle E{(const h16*)(ws + OFF_H3), (const float*)(ws + OFF_RSTD3), a.in[I_LNPLE], (const h16*)(ws + OFF_PP), (h16*)(ws + OFF_R3H), (float*)(ws + OFF_ROWSQ)};
        g8::gemm_phase(lds, (const char*)(ws + OFF_H3), DM, S, E); })
    RUN(PH_FINAL, false, phase_final_norm((const h16*)(ws + OFF_R3H), (const float*)(ws + OFF_ROWSQ), a.in[I_FNW], a.out, blk, nblk);)
}

extern "C" void kernel_launch(void* const* d_in, const int* in_sizes, int n_in, void* d_out, int out_size, void* d_ws, size_t ws_size, hipStream_t stream) {
    static int grid = 0;
    if (grid == 0) {
        if (n_in != N_IN || out_size != NTOK * DM || ws_size < WS_END) { fprintf(stderr, "kernel_launch: unexpected shapes (n_in %d, out %d, ws %zu, need %zu)\n", n_in, out_size, ws_size, (size_t)WS_END); grid = -1; return; }
        int dev = 0, cus = 0, per_cu = 0;
        (void)hipGetDevice(&dev); (void)hipDeviceGetAttribute(&cus, hipDeviceAttributeMultiprocessorCount, dev);
        (void)hipFuncSetAttribute((const void*)mega<true>, hipFuncAttributeMaxDynamicSharedMemorySize, LDS_BYTES);
        (void)hipOccupancyMaxActiveBlocksPerMultiprocessor(&per_cu, (const void*)mega<true>, NTHREADS, LDS_BYTES);
        if (per_cu < 1) { fprintf(stderr, "kernel_launch: occupancy query says %d blocks per CU\n", per_cu); per_cu = 1; }
        grid = cus * (per_cu > 1 ? 1 : per_cu);
        (void)hipGetLastError();
    }
    if (grid < 0) return;
    Args a{};
    for (int i = 0; i < N_IN; ++i) a.in[i] = (const float*)d_in[i];
    a.out = (float*)d_out; a.ws = (unsigned char*)d_ws;
    a.ph_lo = 0; a.ph_hi = PH_COUNT;
    void* args[] = {&a};
    hipError_t e = hipLaunchCooperativeKernel((const void*)mega<true>, dim3(grid), dim3(NTHREADS), args, LDS_BYTES, stream);
    if (e != hipSuccess) fprintf(stderr, "kernel_launch: cooperative launch failed: %s (grid %d)\n", hipGetErrorString(e), grid);
}
```

```cpp
#include <hip/hip_runtime.h>
#include <hip/hip_cooperative_groups.h>
#include <cstdio>
#include <cstdint>
#include <cstddef>

namespace cg = cooperative_groups;

#define LAS __attribute__((address_space(3)))
typedef _Float16 h16;
typedef _Float16 h16x8 __attribute__((ext_vector_type(8)));
typedef _Float16 h16x4 __attribute__((ext_vector_type(4)));
typedef _Float16 h16x2 __attribute__((ext_vector_type(2)));
typedef float f32x4 __attribute__((ext_vector_type(4)));
typedef float f32x2 __attribute__((ext_vector_type(2)));
typedef unsigned u32x4 __attribute__((ext_vector_type(4)));
typedef unsigned u32x2 __attribute__((ext_vector_type(2)));
typedef int i32x8 __attribute__((ext_vector_type(8)));
typedef int i32x4 __attribute__((ext_vector_type(4)));

constexpr int NB = 16, SEQ = 4096, DM = 1024, NTOK = NB * SEQ;
constexpr int INCOLS = 3104;
constexpr int NEXP = 16, CAP = 512, DFF = 2048;
constexpr int HYW = 512, HYC = 1536;
constexpr float EPS = 1e-6f;

enum { I_X = 0, I_P, I_LNMIX, I_WIN, I_WAF, I_BAF, I_WAB, I_BAB, I_GLANW, I_HCW, I_HCB, I_FW1, I_FB1, I_FFR1, I_FW2, I_FB2, I_FFR2,
       I_FW3, I_HBIAS, I_WOUT, I_LNFFN, I_WROUTER, I_WGATE, I_WUP, I_WDOWN, I_LNPLE, I_WPG, I_WPP, I_FNW, N_IN };

constexpr size_t AL(size_t x) { return (x + 255) & ~(size_t)255; }
constexpr int NA1 = 1792;
constexpr size_t OFF_WINA = 0;
constexpr size_t OFF_WINHY = OFF_WINA + AL((size_t)NA1 * DM * 2);
constexpr size_t OFF_WOUT = OFF_WINHY + AL((size_t)HYC * DM * 2);
constexpr size_t OFF_WGU = OFF_WOUT + AL((size_t)DM * DM * 2);
constexpr size_t OFF_WD = OFF_WGU + AL((size_t)NEXP * 2 * DFF * DM * 2);
constexpr size_t OFF_WG = OFF_WD + AL((size_t)NEXP * DM * DFF * 2);
constexpr size_t OFF_WP = OFF_WG + AL((size_t)DM * DM * 2);
constexpr size_t OFF_P16 = OFF_WP + AL((size_t)DM * 256 * 2);
constexpr size_t OFF_PROBS = OFF_P16 + AL((size_t)NTOK * 256 * 2);
constexpr size_t OFF_SELIDX = OFF_PROBS + AL((size_t)NB * NEXP * SEQ * 4);
constexpr size_t OFF_SELGATE = OFF_SELIDX + AL((size_t)NB * NEXP * CAP * 4);
constexpr size_t OFF_SLOTMAP = OFF_SELGATE + AL((size_t)NB * NEXP * CAP * 4);
constexpr size_t OFF_CTR = OFF_SLOTMAP + AL((size_t)NTOK * NEXP * 4);
constexpr size_t OFF_BIG = OFF_CTR + 256;
constexpr size_t OFF_QKVG = OFF_BIG;
constexpr size_t OFF_HY = OFF_QKVG + AL((size_t)NTOK * 1536 * 2);
constexpr size_t OFF_CODES = OFF_HY + AL((size_t)HYC * NTOK * 2);
constexpr size_t OFF_OF = OFF_CODES + AL((size_t)NTOK * 32 * 4);
constexpr size_t OFF_OB = OFF_OF + AL((size_t)NTOK * 512 * 2);
constexpr size_t OFF_GR = OFF_OB + AL((size_t)NTOK * 512 * 2);
constexpr size_t OFF_H = OFF_GR + AL((size_t)2 * HYW * 8192 * 2);
constexpr size_t OFF_Z2 = OFF_H + AL((size_t)NTOK * DM * 2);
constexpr size_t END_A = OFF_Z2 + AL((size_t)HYW * NTOK * 2);
constexpr size_t OFF_HID = OFF_BIG;
constexpr size_t OFF_Y = OFF_HID + AL((size_t)NB * NEXP * CAP * DFF * 2);
constexpr size_t END_B = OFF_Y + AL((size_t)NB * NEXP * CAP * DM * 2);
static_assert(OFF_H >= OFF_Y, "h2 (read by the up/gate GEMM) must not be overwritten by HID");
constexpr size_t OFF_H3 = OFF_BIG;
constexpr size_t OFF_PP = OFF_H3 + AL((size_t)NTOK * DM * 2);
constexpr size_t OFF_R3H = OFF_PP + AL((size_t)NTOK * DM * 2);
constexpr size_t OFF_RSTD3 = OFF_R3H + AL((size_t)NTOK * DM * 2);
constexpr size_t OFF_ROWSQ = OFF_RSTD3 + AL((size_t)NTOK * 4);
constexpr size_t END_C = OFF_ROWSQ + AL((size_t)NTOK * 4);
constexpr size_t WS_END = END_A > END_B ? (END_A > END_C ? END_A : END_C) : (END_B > END_C ? END_B : END_C);

constexpr int NTHREADS = 512;
constexpr int LDS_BYTES = 156 * 1024;
constexpr float HY_SCALE = 64.0f;
constexpr int FP8_WSHIFT = 5;


struct Args {
    const float* in[N_IN];
    float* out;
    unsigned char* ws;
    int ph_lo, ph_hi;
};

__device__ __forceinline__ float wave_sum(float v) {
#pragma unroll
    for (int o = 32; o >= 1; o >>= 1) v += __shfl_xor(v, o);
    return v;
}
__device__ __forceinline__ float sigmoidf_(float x) { return 1.0f / (1.0f + __expf(-x)); }
__device__ __forceinline__ float siluf_(float x) { return x / (1.0f + __expf(-x)); }
__device__ __forceinline__ unsigned pack_h2(float a, float b) {
    h16x2 v; v.x = (h16)a; v.y = (h16)b; return __builtin_bit_cast(unsigned, v);
}


__device__ __forceinline__ void sincos_f(float x, float& s, float& c) {
    const float kf = rintf(x * 0.6366197723675814f);
    float r = fmaf(kf, -1.5707963705062866f, x); r = fmaf(kf, 4.371139000186241e-8f, r);
    const float r2 = r * r;
    const float sp = r + r * r2 * (-1.6666667e-1f + r2 * (8.3333338e-3f + r2 * (-1.9841270e-4f + r2 * 2.7557319e-6f)));
    const float cp = 1.0f + r2 * (-0.5f + r2 * (4.1666668e-2f + r2 * (-1.3888889e-3f + r2 * (2.4801587e-5f - r2 * 2.7557319e-7f))));
    const int k = (int)kf & 3;
    s = (k == 0) ? sp : (k == 1) ? cp : (k == 2) ? -sp : -cp;
    c = (k == 0) ? cp : (k == 1) ? -sp : (k == 2) ? -cp : sp;
}
__device__ __forceinline__ float sin_f(float x) { float s, c; sincos_f(x, s, c); return s; }

__device__ __forceinline__ unsigned pack_fp8x4(float a, float b, float c, float d) {
    int r = 0; r = __builtin_amdgcn_cvt_pk_fp8_f32(a, b, r, false); r = __builtin_amdgcn_cvt_pk_fp8_f32(c, d, r, true); return (unsigned)r;
}

namespace g8 {
constexpr int BM = 256, BK = 64, HALF = 128, HTB = HALF * BK * 2, STAGE_BYTES = 8 * HTB;
__device__ __forceinline__ int lds_byte(int r, int c) { const int st = (r >> 4) * 2 + (c >> 5), rr = r & 15, cc = c & 31, ob = rr * 64 + cc * 2; return st * 1024 + (ob ^ (((ob >> 9) & 1) << 5)); }
__device__ __forceinline__ void stage_rc(int b, int& R, int& C) { const int st = b / 1024, sb = b % 1024, swz = sb ^ (((sb >> 9) & 1) << 5); R = (st >> 1) * 16 + swz / 64; C = (st & 1) * 32 + (swz % 64) / 2; }
__device__ __forceinline__ int perm32(int rho) { const int n = rho >> 4, i = rho & 15; return 8 * (i >> 2) + 4 * n + (i & 3); }

struct Unit { const char* B; int pm, pn, g; unsigned rowbase; };

template <class Epi, class Sched, bool FP8 = false>
__device__ __forceinline__ void gemm_phase(LAS unsigned char* lds, const char* A, const int K, const Sched& S, const Epi& E) {
    const int tid = threadIdx.x, wid = __builtin_amdgcn_readfirstlane(tid >> 6), lane = tid & 63, wr = wid >> 2, wc = wid & 3, fr = lane & 15, fq = lane >> 4;
    const int nt = K / BK;
    int Rr[2], Cc[2]; unsigned voffB[2];
#pragma unroll
    for (int i = 0; i < 2; ++i) { stage_rc(tid * 16 + i * 8192, Rr[i], Cc[i]); const int Rb = Epi::PERM ? ((Rr[i] & ~31) + perm32(Rr[i] & 31)) : Rr[i];
        voffB[i] = (unsigned)(Rb * K + Cc[i]) * 2u; }
    const size_t kstep = (size_t)(BK * 2);
    const size_t hstep = (size_t)HALF * K * 2;
    const unsigned ldsw = (unsigned)wid * 1024u;
    const int aoff = lds_byte(wr * 64 + fr, fq * 8), boff = lds_byte(wc * 32 + fr, fq * 8);
#define G8_SA(b, h) (((b) * 2 + (h)) * HTB)
#define G8_SB(b, h) ((4 + (b) * 2 + (h)) * HTB)
#define G8_STAGE(bufoff, gbase, v0, v1) do { \
        __builtin_amdgcn_global_load_lds((const unsigned*)((const char*)(gbase) + (v0)), (LAS unsigned*)(lds + (bufoff) + ldsw), 16, 0, 0); \
        __builtin_amdgcn_global_load_lds((const unsigned*)((const char*)(gbase) + (v1)), (LAS unsigned*)(lds + (bufoff) + ldsw + 8192), 16, 0, 0); } while (0)
#define G8_LDA(dst, b, h) do { _Pragma("unroll") for (int m = 0; m < 4; ++m) { \
        const i32x4 lo_ = *(const LAS i32x4*)(lds + G8_SA(b, h) + aoff + m * 2048), hi_ = *(const LAS i32x4*)(lds + G8_SA(b, h) + aoff + m * 2048 + 1024); \
        dst[m] = __builtin_shufflevector(lo_, hi_, 0, 1, 2, 3, 4, 5, 6, 7); } } while (0)
#define G8_LDB(dst, b, h) do { _Pragma("unroll") for (int n = 0; n < 2; ++n) { \
        const i32x4 lo_ = *(const LAS i32x4*)(lds + G8_SB(b, h) + boff + n * 2048), hi_ = *(const LAS i32x4*)(lds + G8_SB(b, h) + boff + n * 2048 + 1024); \
        dst[n] = __builtin_shufflevector(lo_, hi_, 0, 1, 2, 3, 4, 5, 6, 7); } } while (0)
#define G8_MMA(ai, bj, At, Bt) do { __builtin_amdgcn_s_setprio(1); \
        if constexpr (FP8) { _Pragma("unroll") for (int m = 0; m < 4; ++m) _Pragma("unroll") for (int n = 0; n < 2; ++n) \
            asm volatile("v_mfma_scale_f32_16x16x128_f8f6f4 %0, %1, %2, %0, %3, %3 op_sel_hi:[0,0,0]" : "+v"(acc[ai][bj][m][n]) : "v"(Bt[n]), "v"(At[m]), "v"(sc_one)); } \
        else { _Pragma("unroll") for (int m = 0; m < 4; ++m) _Pragma("unroll") for (int n = 0; n < 2; ++n) { \
            const i32x8 a_ = At[m], b_ = Bt[n]; \
            const h16x8 a0_ = __builtin_bit_cast(h16x8, __builtin_shufflevector(a_, a_, 0, 1, 2, 3)), a1_ = __builtin_bit_cast(h16x8, __builtin_shufflevector(a_, a_, 4, 5, 6, 7)); \
            const h16x8 b0_ = __builtin_bit_cast(h16x8, __builtin_shufflevector(b_, b_, 0, 1, 2, 3)), b1_ = __builtin_bit_cast(h16x8, __builtin_shufflevector(b_, b_, 4, 5, 6, 7)); \
            acc[ai][bj][m][n] = __builtin_amdgcn_mfma_f32_16x16x32_f16(b0_, a0_, acc[ai][bj][m][n], 0, 0, 0); \
            acc[ai][bj][m][n] = __builtin_amdgcn_mfma_f32_16x16x32_f16(b1_, a1_, acc[ai][bj][m][n], 0, 0, 0); } } \
        __builtin_amdgcn_s_setprio(0); } while (0)
#define G8_WAIT_V(n) asm volatile("s_waitcnt vmcnt(" #n ")" ::: "memory")
#define G8_WAIT_L(n) asm volatile("s_waitcnt lgkmcnt(" #n ")" ::: "memory")
#define G8_BAR __builtin_amdgcn_s_barrier()
#define G8_SCHED __builtin_amdgcn_sched_barrier(0)
    Unit cur, nxt; int ui = 0;
    if (!S.next(0, cur)) return;
    f32x4 acc[2][2][4][2];
#pragma unroll
    for (int a = 0; a < 2; ++a)
#pragma unroll
        for (int b = 0; b < 2; ++b)
#pragma unroll
            for (int m = 0; m < 4; ++m)
#pragma unroll
                for (int n = 0; n < 2; ++n) acc[a][b][m][n] = (f32x4){0.f, 0.f, 0.f, 0.f};
    i32x8 At[4], B0[2], B1[2];
    const int sc_one = 0x7f7f7f7f; (void)sc_one;
    unsigned va00, va01, va10, va11, vn00, vn01, vn10, vn11;
    va00 = (S.arow(cur, Rr[0]) * (unsigned)K + (unsigned)Cc[0]) * 2u; va01 = (S.arow(cur, Rr[1]) * (unsigned)K + (unsigned)Cc[1]) * 2u;
    va10 = (S.arow(cur, HALF + Rr[0]) * (unsigned)K + (unsigned)Cc[0]) * 2u; va11 = (S.arow(cur, HALF + Rr[1]) * (unsigned)K + (unsigned)Cc[1]) * 2u;
    vn00 = va00; vn01 = va01; vn10 = va10; vn11 = va11;
    const char* cB = cur.B;
    G8_STAGE(G8_SB(0, 0), cB, voffB[0], voffB[1]); G8_STAGE(G8_SA(0, 0), A, va00, va01); G8_STAGE(G8_SB(0, 1), cB + hstep, voffB[0], voffB[1]); G8_STAGE(G8_SA(0, 1), A, va10, va11);
    if (wr == 1) G8_BAR;
    G8_WAIT_V(4); G8_BAR;
    G8_STAGE(G8_SB(1, 0), cB + kstep, voffB[0], voffB[1]); G8_STAGE(G8_SA(1, 0), A + kstep, va00, va01); G8_STAGE(G8_SB(1, 1), cB + hstep + kstep, voffB[0], voffB[1]);
    G8_WAIT_V(6); G8_BAR;
    for (;;) {
        const bool has_next = S.next(ui + 1, nxt);
        const char* nB = has_next ? nxt.B : cB;
        if (has_next) {
            vn00 = (S.arow(nxt, Rr[0]) * (unsigned)K + (unsigned)Cc[0]) * 2u; vn01 = (S.arow(nxt, Rr[1]) * (unsigned)K + (unsigned)Cc[1]) * 2u;
            vn10 = (S.arow(nxt, HALF + Rr[0]) * (unsigned)K + (unsigned)Cc[0]) * 2u; vn11 = (S.arow(nxt, HALF + Rr[1]) * (unsigned)K + (unsigned)Cc[1]) * 2u;
        }
        for (int t = 0; t < nt; t += 2) {
            const bool last = (t == nt - 2);
            const char* a1 = A + (size_t)(t + 1) * kstep;
            const char* a2 = last ? A : A + (size_t)(t + 2) * kstep; const char* b2 = last ? nB : cB + (size_t)(t + 2) * kstep;
            const char* a3 = a2 + kstep; const char* b3 = b2 + kstep;
            const unsigned w00 = last ? vn00 : va00, w01 = last ? vn01 : va01, w10 = last ? vn10 : va10, w11 = last ? vn11 : va11;
            G8_LDB(B0, 0, 0); G8_SCHED; G8_LDA(At, 0, 0); G8_STAGE(G8_SA(1, 1), a1, va10, va11);
            G8_WAIT_L(8); G8_BAR; G8_WAIT_L(0); G8_MMA(0, 0, At, B0); G8_BAR; G8_SCHED;
            G8_LDB(B1, 0, 1); G8_STAGE(G8_SB(0, 0), b2, voffB[0], voffB[1]);
            G8_BAR; G8_WAIT_L(0); G8_MMA(0, 1, At, B1); G8_BAR;
            G8_LDA(At, 0, 1); G8_STAGE(G8_SA(0, 0), a2, w00, w01);
            G8_BAR; G8_WAIT_L(0); G8_MMA(1, 0, At, B0); G8_BAR; G8_SCHED;
            G8_STAGE(G8_SB(0, 1), b2 + hstep, voffB[0], voffB[1]);
            G8_WAIT_V(6); G8_BAR; G8_MMA(1, 1, At, B1); G8_BAR;
            G8_LDB(B0, 1, 0); G8_SCHED; G8_LDA(At, 1, 0); G8_STAGE(G8_SA(0, 1), a2, w10, w11);
            G8_WAIT_L(8); G8_BAR; G8_WAIT_L(0); G8_MMA(0, 0, At, B0); G8_BAR; G8_SCHED;
            G8_LDB(B1, 1, 1); G8_STAGE(G8_SB(1, 0), b3, voffB[0], voffB[1]);
            G8_BAR; G8_WAIT_L(0); G8_MMA(0, 1, At, B1); G8_BAR;
            G8_LDA(At, 1, 1); G8_STAGE(G8_SA(1, 0), a3, w00, w01);
            G8_BAR; G8_WAIT_L(0); G8_MMA(1, 0, At, B0); G8_BAR; G8_SCHED;
            G8_STAGE(G8_SB(1, 1), b3 + hstep, voffB[0], voffB[1]);
            G8_WAIT_V(6); G8_BAR; G8_MMA(1, 1, At, B1); G8_BAR;
        }
        if constexpr (FP8) asm volatile("s_nop 15\n\ts_nop 15" ::: "memory");
        E(acc, cur, wr, wc, fr, fq);
        if (!has_next) break;
#pragma unroll
        for (int a = 0; a < 2; ++a)
#pragma unroll
            for (int b = 0; b < 2; ++b)
#pragma unroll
                for (int m = 0; m < 4; ++m)
#pragma unroll
                    for (int n = 0; n < 2; ++n) acc[a][b][m][n] = (f32x4){0.f, 0.f, 0.f, 0.f};
        cur = nxt; cB = nB; va00 = vn00; va01 = vn01; va10 = vn10; va11 = vn11; ++ui;
    }
    G8_WAIT_V(0);
    if (wr == 0) G8_BAR;
    G8_BAR;
#undef G8_SA
#undef G8_SB
#undef G8_STAGE
#undef G8_LDA
#undef G8_LDB
#undef G8_MMA
#undef G8_WAIT_V
#undef G8_WAIT_L
#undef G8_BAR
#undef G8_SCHED
}

struct DenseSched {
    const char* Bt; int K, nM, nN, nwg, G, c;
    __device__ void init(const void* Bt_, int M, int N, int K_, int G_, int c_) { Bt = (const char*)Bt_; K = K_; nM = M / BM; nN = N / BM; nwg = nM * nN; G = G_; c = c_; }
    __device__ bool next(int i, Unit& u) const {
        const long L = (long)i * G + c; if (L >= nwg) return false;
        int wgid = (int)L; { const int q = nwg / 8, r = nwg % 8, xcd = wgid % 8, off = wgid / 8; wgid = (xcd < r ? xcd * (q + 1) : r * (q + 1) + (xcd - r) * q) + off; }
        const int nig = 8 * nN, gid = wgid / nig, fm = gid * 8, gsz = (nM - fm) < 8 ? (nM - fm) : 8;
        u.pm = fm + ((wgid % nig) % gsz); u.pn = (wgid % nig) / gsz; u.g = 0; u.rowbase = (unsigned)u.pm * BM;
        u.B = Bt + (size_t)u.pn * BM * K * 2; return true;
    }
    __device__ __forceinline__ unsigned arow(const Unit& u, int r) const { return u.rowbase + (unsigned)r; }
};
struct Moe1Sched {
    const char* W; const int* rowmap; int G, c;
    __device__ bool next(int i, Unit& u) const {
        const long L = (long)i * G + c; if (L >= NEXP * 512) return false;
        const int e = (int)(L / 512), w = (int)(L % 512), cc = w % 256, r = w / 256, xcd = cc % 8, j = cc / 8;
        const int mt = xcd * 4 + (j & 3), nt_ = r * 8 + (j >> 2), b = mt >> 1;
        u.pm = mt & 1; u.pn = nt_; u.g = b * NEXP + e; u.rowbase = (unsigned)u.g * CAP + (unsigned)u.pm * BM;
        u.B = W + ((size_t)e * 2 * DFF + (size_t)nt_ * BM) * DM; return true;
    }
    __device__ __forceinline__ unsigned arow(const Unit& u, int r) const { return (unsigned)rowmap[u.rowbase + r]; }
};
struct Moe2Sched {
    const char* W; int G, c;
    __device__ bool next(int i, Unit& u) const {
        const long L = (long)i * G + c; if (L >= NEXP * 128) return false;
        const int e = (int)(L / 128), w = (int)(L % 128), xcd = w % 8, j = w / 8;
        const int mt = xcd * 4 + (j & 3), nt_ = j >> 2, b = mt >> 1;
        u.pm = mt & 1; u.pn = nt_; u.g = b * NEXP + e; u.rowbase = (unsigned)u.g * CAP + (unsigned)u.pm * BM;
        u.B = W + ((size_t)e * DM + (size_t)nt_ * BM) * DFF; return true;
    }
    __device__ __forceinline__ unsigned arow(const Unit& u, int r) const { return u.rowbase + (unsigned)r; }
};

typedef const f32x4 (&AccRef)[2][2][4][2];
struct EpiQKVG {
    static constexpr bool PERM = true;
    h16* qkvg; float* codes;
    __device__ __forceinline__ void operator()(AccRef acc, const Unit& u, int wr, int wc, int fr, int fq) const {
        const int row0 = u.pm * BM + wr * 64 + fr;
        if (u.pn < 6) {
#pragma unroll
            for (int ai = 0; ai < 2; ++ai)
#pragma unroll
                for (int m = 0; m < 4; ++m) { h16* rowp = qkvg + (size_t)(row0 + ai * HALF + m * 16) * 1536 + u.pn * BM + wc * 32 + 8 * fq;
#pragma unroll
                    for (int bj = 0; bj < 2; ++bj) { const f32x4 v0 = acc[ai][bj][m][0], v1 = acc[ai][bj][m][1];
                        u32x4 w; w.x = pack_h2(v0[0], v0[1]); w.y = pack_h2(v0[2], v0[3]); w.z = pack_h2(v1[0], v1[1]); w.w = pack_h2(v1[2], v1[3]);
                        *(u32x4*)(rowp + bj * HALF) = w; } }
        } else if (wc == 0) {
#pragma unroll
            for (int ai = 0; ai < 2; ++ai)
#pragma unroll
                for (int m = 0; m < 4; ++m) { float* rowp = codes + (size_t)(row0 + ai * HALF + m * 16) * 32 + 8 * fq;
                    *(f32x4*)(rowp) = acc[ai][0][m][0]; *(f32x4*)(rowp + 4) = acc[ai][0][m][1]; }
        }
    }
};
struct EpiH16 {
    static constexpr bool PERM = true;
    h16* C; int ldc;
    __device__ __forceinline__ void operator()(AccRef acc, const Unit& u, int wr, int wc, int fr, int fq) const {
        const int row0 = u.pm * BM + wr * 64 + fr;
#pragma unroll
        for (int ai = 0; ai < 2; ++ai)
#pragma unroll
            for (int m = 0; m < 4; ++m) { h16* rowp = C + (size_t)(row0 + ai * HALF + m * 16) * ldc + u.pn * BM + wc * 32 + 8 * fq;
#pragma unroll
                for (int bj = 0; bj < 2; ++bj) { const f32x4 v0 = acc[ai][bj][m][0], v1 = acc[ai][bj][m][1];
                    u32x4 w; w.x = pack_h2(v0[0], v0[1]); w.y = pack_h2(v0[2], v0[3]); w.z = pack_h2(v1[0], v1[1]); w.w = pack_h2(v1[2], v1[3]);
                    *(u32x4*)(rowp + bj * HALF) = w; } }
    }
};
struct EpiResid {
    static constexpr bool PERM = true;
    const float* X; h16* R;
    __device__ __forceinline__ void operator()(AccRef acc, const Unit& u, int wr, int wc, int fr, int fq) const {
        const int row0 = u.pm * BM + wr * 64 + fr, col0 = u.pn * BM + wc * 32 + 8 * fq;
#pragma unroll
        for (int ai = 0; ai < 2; ++ai)
#pragma unroll
            for (int m = 0; m < 4; ++m) { const size_t off = (size_t)(row0 + ai * HALF + m * 16) * DM + col0;
#pragma unroll
                for (int bj = 0; bj < 2; ++bj) { const f32x4 x0 = *(const f32x4*)(X + off + bj * HALF), x1 = *(const f32x4*)(X + off + bj * HALF + 4);
                    const f32x4 v0 = x0 + acc[ai][bj][m][0], v1 = x1 + acc[ai][bj][m][1];
                    u32x4 w; w.x = pack_h2(v0[0], v0[1]); w.y = pack_h2(v0[2], v0[3]); w.z = pack_h2(v1[0], v1[1]); w.w = pack_h2(v1[2], v1[3]);
                    *(u32x4*)(R + off + bj * HALF) = w; } }
    }
};
struct EpiHid {
    static constexpr bool PERM = true;
    unsigned char* hid;
    __device__ __forceinline__ void operator()(AccRef acc, const Unit& u, int wr, int wc, int fr, int fq) const {
        const unsigned row0 = u.rowbase + wr * 64 + fr;
#pragma unroll
        for (int ai = 0; ai < 2; ++ai)
#pragma unroll
            for (int m = 0; m < 4; ++m) { unsigned char* rowp = hid + (size_t)(row0 + ai * HALF + m * 16) * DFF + u.pn * HALF + wc * 32 + 8 * fq;
                constexpr float ws_ = 1.0f / (float)(1 << FP8_WSHIFT);
                const f32x4 g0 = acc[ai][0][m][0] * ws_, g1 = acc[ai][0][m][1] * ws_, u0 = acc[ai][1][m][0] * ws_, u1 = acc[ai][1][m][1] * ws_;
                u32x2 w; w.x = pack_fp8x4(siluf_(g0[0]) * u0[0], siluf_(g0[1]) * u0[1], siluf_(g0[2]) * u0[2], siluf_(g0[3]) * u0[3]);
                w.y = pack_fp8x4(siluf_(g1[0]) * u1[0], siluf_(g1[1]) * u1[1], siluf_(g1[2]) * u1[2], siluf_(g1[3]) * u1[3]);
                *(u32x2*)rowp = w; }
    }
};
constexpr float Y_SCALE = 8.0f;
struct EpiDown {
    static constexpr bool PERM = true;
    unsigned char* Y; const float* selgate;
    __device__ __forceinline__ void operator()(AccRef acc, const Unit& u, int wr, int wc, int fr, int fq) const {
        const unsigned row0 = u.rowbase + wr * 64 + fr;
#pragma unroll
        for (int ai = 0; ai < 2; ++ai)
#pragma unroll
            for (int m = 0; m < 4; ++m) { const unsigned sr = row0 + ai * HALF + m * 16; const float gt = selgate[sr] * (Y_SCALE / (float)(1 << FP8_WSHIFT));
                unsigned char* rowp = Y + (size_t)sr * DM + u.pn * BM + wc * 32 + 8 * fq;
#pragma unroll
                for (int bj = 0; bj < 2; ++bj) { const f32x4 v0 = acc[ai][bj][m][0] * gt, v1 = acc[ai][bj][m][1] * gt;
                    u32x2 w; w.x = pack_fp8x4(v0[0], v0[1], v0[2], v0[3]); w.y = pack_fp8x4(v1[0], v1[1], v1[2], v1[3]);
                    *(u32x2*)(rowp + bj * HALF) = w; } }
    }
};
struct EpiPle {
    static constexpr bool PERM = true;
    const h16* H3; const float* rstd3; const float* lnw; const h16* PP; h16* R3H; float* rowsq;
    __device__ __forceinline__ void operator()(AccRef acc, const Unit& u, int wr, int wc, int fr, int fq) const {
        const int row0 = u.pm * BM + wr * 64 + fr, col0 = u.pn * BM + wc * 32 + 8 * fq;
        f32x4 winv[2][2];
#pragma unroll
        for (int bj = 0; bj < 2; ++bj)
#pragma unroll
            for (int n = 0; n < 2; ++n) { const f32x4 wv = *(const f32x4*)(lnw + col0 + bj * HALF + n * 4);
#pragma unroll
                for (int j = 0; j < 4; ++j) winv[bj][n][j] = 1.0f / wv[j]; }
#pragma unroll
        for (int ai = 0; ai < 2; ++ai)
#pragma unroll
            for (int m = 0; m < 4; ++m) { const int row = row0 + ai * HALF + m * 16; const size_t off = (size_t)row * DM + col0;
                const float inv = 1.0f / rstd3[row]; float sq = 0.f;
#pragma unroll
                for (int bj = 0; bj < 2; ++bj) { const size_t o2 = off + bj * HALF; const h16x8 hv = *(const h16x8*)(H3 + o2), pv = *(const h16x8*)(PP + o2);
                    float o[8];
#pragma unroll
                    for (int n = 0; n < 2; ++n)
#pragma unroll
                        for (int j = 0; j < 4; ++j) { const float v = (float)hv[4 * n + j] * inv * winv[bj][n][j] + sigmoidf_(acc[ai][bj][m][n][j]) * (float)pv[4 * n + j]; o[4 * n + j] = v; sq += v * v; }
                    u32x4 w; w.x = pack_h2(o[0], o[1]); w.y = pack_h2(o[2], o[3]); w.z = pack_h2(o[4], o[5]); w.w = pack_h2(o[6], o[7]); *(u32x4*)(R3H + o2) = w; }
                sq += __shfl_xor(sq, 16); sq += __shfl_xor(sq, 32);
                if (fq == 0) unsafeAtomicAdd(rowsq + row, sq); }
    }
};
}

template <class ColPtr>
__device__ void cvt_transpose(LAS unsigned char* lds, h16* dst, int N, int K, int src_ld, ColPtr cp, int blk, int nblk) {
    const int tid = threadIdx.x, w = tid >> 6, l = tid & 63, nq = tid & 31, kp = tid >> 5;
    const int ktiles = K / 256, ntiles = (N / 128) * ktiles;
    f32x4 va[8], vb[8];
    auto fetch = [&](int t) {
        const int n0 = (t / ktiles) * 128, k0 = (t % ktiles) * 256;
        const float* sp = cp(n0 + (nq >> 3) * 32);
#pragma unroll
        for (int ps = 0; ps < 8; ++ps) {
            const int kk = 2 * (kp + 16 * ps);
            if (sp) { va[ps] = *(const f32x4*)(sp + (size_t)(k0 + kk) * src_ld + ((4 * nq) & 31)); vb[ps] = *(const f32x4*)(sp + (size_t)(k0 + kk + 1) * src_ld + ((4 * nq) & 31)); }
            else { va[ps] = (f32x4){0.f, 0.f, 0.f, 0.f}; vb[ps] = va[ps]; }
        }
    };
    if (blk < ntiles) fetch(blk);
    for (int t = blk; t < ntiles; t += nblk) {
        const int n0 = (t / ktiles) * 128, k0 = (t % ktiles) * 256;
        __syncthreads();
        const int sv = (nq & 15) << 1;
#pragma unroll
        for (int ps = 0; ps < 8; ++ps) { const int d = kp + 16 * ps;
#pragma unroll
            for (int j = 0; j < 4; ++j) *(LAS unsigned*)(lds + (4 * nq + j) * 512 + ((d ^ sv) << 2)) = pack_h2(va[ps][j], vb[ps][j]); }
        if (t + nblk < ntiles) fetch(t + nblk);
        __syncthreads();
#pragma unroll 4
        for (int r = 0; r < 16; ++r) { const int row = w * 16 + r, rv = ((row >> 2) & 15) << 1;
            const u32x2 x = *(const LAS u32x2*)(lds + row * 512 + (((2 * l) ^ rv) << 2));
            *(u32x2*)(dst + (size_t)(n0 + row) * K + k0 + 4 * l) = x; }
    }
}

template <class ColPtr>
__device__ void cvt_transpose_fp8(LAS unsigned char* lds, unsigned char* dst, int N, int K, int src_ld, float scale, ColPtr cp, int blk, int nblk) {
    const int tid = threadIdx.x, w = tid >> 6, l = tid & 63, nq = tid & 31, kq = tid >> 5;
    const int ktiles = K / 256, ntiles = (N / 128) * ktiles;
    f32x4 v[4][4];
    auto fetch = [&](int t) {
        const int n0 = (t / ktiles) * 128, k0 = (t % ktiles) * 256;
        const float* sp = cp(n0 + (nq >> 3) * 32);
#pragma unroll
        for (int ps = 0; ps < 4; ++ps)
#pragma unroll
            for (int q = 0; q < 4; ++q) v[ps][q] = *(const f32x4*)(sp + (size_t)(k0 + 4 * (kq + 16 * ps) + q) * src_ld + ((4 * nq) & 31));
    };
    if (blk < ntiles) fetch(blk);
    for (int t = blk; t < ntiles; t += nblk) {
        const int n0 = (t / ktiles) * 128, k0 = (t % ktiles) * 256;
        __syncthreads();
        const int sv = (nq & 15) << 1;
#pragma unroll
        for (int ps = 0; ps < 4; ++ps) { const int d = kq + 16 * ps;
#pragma unroll
            for (int j = 0; j < 4; ++j) *(LAS unsigned*)(lds + (4 * nq + j) * 256 + ((d ^ sv) << 2)) = pack_fp8x4(v[ps][0][j] * scale, v[ps][1][j] * scale, v[ps][2][j] * scale, v[ps][3][j] * scale); }
        if (t + nblk < ntiles) fetch(t + nblk);
        __syncthreads();
#pragma unroll 4
        for (int r = 0; r < 16; ++r) { const int row = w * 16 + r, rv = ((row >> 2) & 15) << 1;
            const unsigned x = *(const LAS unsigned*)(lds + row * 256 + ((l ^ rv) << 2));
            *(unsigned*)(dst + (size_t)(n0 + row) * K + k0 + 4 * l) = x; }
    }
}

__device__ void prep_fp8_weights(const Args& a, LAS unsigned char* lds, int blk, int nblk) {
    unsigned char* ws = a.ws;
    const int tid = threadIdx.x, w = tid >> 6, l = tid & 63, nq = tid & 31, kq = tid >> 5;
    constexpr int NT = 2048 + 1024;
    const float scale = (float)(1 << FP8_WSHIFT);
    struct Tile { const float* sp; int src_ld; unsigned char* dst; int K; };
    auto decode = [&](int gt) -> Tile {
        Tile t;
        if (gt < 2048) { const int e = gt >> 7, r = gt & 127, n0 = (r >> 2) * 128, k0 = (r & 3) * 256, nb = n0 + (nq >> 3) * 32;
            const int tile = nb >> 8, within = nb & 255, f = tile * 128 + (within & 127);
            t.sp = ((within >> 7) ? a.in[I_WUP] : a.in[I_WGATE]) + (size_t)e * DM * DFF + f + (size_t)k0 * DFF; t.src_ld = DFF; t.K = DM;
            t.dst = ws + OFF_WGU + (size_t)e * 2 * DFF * DM + (size_t)n0 * DM + k0; }
        else { const int g2 = gt - 2048, e = g2 >> 6, r = g2 & 63, n0 = (r >> 3) * 128, k0 = (r & 7) * 256, nb = n0 + (nq >> 3) * 32;
            t.sp = a.in[I_WDOWN] + (size_t)e * DFF * DM + nb + (size_t)k0 * DM; t.src_ld = DM; t.K = DFF;
            t.dst = ws + OFF_WD + (size_t)e * DM * DFF + (size_t)n0 * DFF + k0; }
        return t;
    };
    f32x4 v[4][4];
    auto fetch = [&](const Tile& t) {
#pragma unroll
        for (int ps = 0; ps < 4; ++ps)
#pragma unroll
            for (int q = 0; q < 4; ++q) v[ps][q] = *(const f32x4*)(t.sp + (size_t)(4 * (kq + 16 * ps) + q) * t.src_ld + ((4 * nq) & 31));
    };
    Tile cur;
    if (blk < NT) { cur = decode(blk); fetch(cur); }
    for (int gt = blk; gt < NT; gt += nblk) {
        __syncthreads();
        const int sv = (nq & 15) << 1;
#pragma unroll
        for (int ps = 0; ps < 4; ++ps) { const int d = kq + 16 * ps;
#pragma unroll
            for (int j = 0; j < 4; ++j) *(LAS unsigned*)(lds + (4 * nq + j) * 256 + ((d ^ sv) << 2)) = pack_fp8x4(v[ps][0][j] * scale, v[ps][1][j] * scale, v[ps][2][j] * scale, v[ps][3][j] * scale); }
        unsigned char* dst = cur.dst; const int K = cur.K;
        if (gt + nblk < NT) { cur = decode(gt + nblk); fetch(cur); }
        __syncthreads();
#pragma unroll 4
        for (int r = 0; r < 16; ++r) { const int row = w * 16 + r, rv = ((row >> 2) & 15) << 1;
            const unsigned x = *(const LAS unsigned*)(lds + row * 256 + ((l ^ rv) << 2));
            *(unsigned*)(dst + (size_t)row * K + 4 * l) = x; }
    }
}

__device__ void phase_prep(const Args& a, LAS unsigned char* lds, int blk, int nblk) {
    unsigned char* ws = a.ws;
    const int tid = threadIdx.x;
    if (blk == 0 && tid < 64) ((unsigned*)(ws + OFF_CTR))[tid] = 0u;
    auto rot = [&](int off) { return (blk - off + 4 * nblk) % nblk; };
    { const float* w = a.in[I_WIN]; cvt_transpose(lds, (h16*)(ws + OFF_WINA), NA1, DM, INCOLS, [=](int n0) { return n0 < 1568 ? w + n0 : (const float*)nullptr; }, rot(0), nblk); }
    { const float* w = a.in[I_WIN]; cvt_transpose(lds, (h16*)(ws + OFF_WINHY), HYC, DM, INCOLS, [=](int n0) { return w + 1568 + n0; }, rot(56), nblk); }
    { const float* w = a.in[I_WOUT]; cvt_transpose(lds, (h16*)(ws + OFF_WOUT), DM, DM, DM, [=](int n0) { return w + n0; }, rot(104), nblk); }
    { const float* w = a.in[I_WPG]; cvt_transpose(lds, (h16*)(ws + OFF_WG), DM, DM, DM, [=](int n0) { return w + n0; }, rot(136), nblk); }
    { const float* w = a.in[I_WPP]; cvt_transpose(lds, (h16*)(ws + OFF_WP), DM, 256, DM, [=](int n0) { return w + n0; }, rot(168), nblk); }
    prep_fp8_weights(a, lds, blk, nblk);
    { const f32x4* p = (const f32x4*)a.in[I_P]; u32x2* d = (u32x2*)(ws + OFF_P16); const size_t n4 = (size_t)NTOK * 256 / 4;
        for (size_t i = (size_t)blk * NTHREADS + tid; i < n4; i += (size_t)nblk * NTHREADS) { const f32x4 v = p[i]; u32x2 o; o.x = pack_h2(v[0], v[1]); o.y = pack_h2(v[2], v[3]); d[i] = o; } }
}

__device__ void phase_rmsnorm_h16(const float* X, const float* w, h16* H, int blk, int nblk) {
    constexpr int RP = 4;
    const int lane = threadIdx.x & 63, gw = blk * 8 + (threadIdx.x >> 6), nw = nblk * 8;
    f32x4 wv[4];
#pragma unroll
    for (int j = 0; j < 4; ++j) wv[j] = *(const f32x4*)(w + j * 256 + lane * 4);
    for (int row0 = gw * RP; row0 < NTOK; row0 += nw * RP) {
        f32x4 v[RP][4];
#pragma unroll
        for (int r = 0; r < RP; ++r)
#pragma unroll
            for (int j = 0; j < 4; ++j) v[r][j] = *(const f32x4*)(X + (size_t)(row0 + r) * DM + j * 256 + lane * 4);
#pragma unroll
        for (int r = 0; r < RP; ++r) {
            float ss = 0.f;
#pragma unroll
            for (int j = 0; j < 4; ++j) ss += v[r][j][0] * v[r][j][0] + v[r][j][1] * v[r][j][1] + v[r][j][2] * v[r][j][2] + v[r][j][3] * v[r][j][3];
            ss = wave_sum(ss);
            const float rstd = rsqrtf(ss * (1.0f / DM) + EPS);
            h16* hp = H + (size_t)(row0 + r) * DM;
#pragma unroll
            for (int j = 0; j < 4; ++j) { u32x2 o; o.x = pack_h2(v[r][j][0] * rstd * wv[j][0], v[r][j][1] * rstd * wv[j][1]); o.y = pack_h2(v[r][j][2] * rstd * wv[j][2], v[r][j][3] * rstd * wv[j][3]);
                *(u32x2*)(hp + j * 256 + lane * 4) = o; }
        }
    }
}

__device__ void phase_combine_norm(const h16* R, const unsigned char* Y, const int* slotmap, const float* w, h16* H, float* rstd3, float* rowsq, int blk, int nblk) {
    constexpr int RP = 2;
    const int lane = threadIdx.x & 63, gw = blk * 8 + (threadIdx.x >> 6), nw = nblk * 8;
    f32x4 wv[4];
#pragma unroll
    for (int j = 0; j < 4; ++j) wv[j] = *(const f32x4*)(w + j * 256 + lane * 4);
    for (int row0 = gw * RP; row0 < NTOK; row0 += nw * RP) {
        f32x4 v[RP][4]; int myslot[RP];
#pragma unroll
        for (int r = 0; r < RP; ++r) {
            myslot[r] = (lane < NEXP) ? slotmap[(size_t)(row0 + r) * NEXP + lane] : -1;
#pragma unroll
            for (int j = 0; j < 4; ++j) { const h16x4 hv = *(const h16x4*)(R + (size_t)(row0 + r) * DM + j * 256 + lane * 4); v[r][j] = (f32x4){(float)hv[0], (float)hv[1], (float)hv[2], (float)hv[3]}; }
        }
#pragma unroll
        for (int r = 0; r < RP; ++r) {
            unsigned long long mask = __ballot(myslot[r] >= 0);
            const int b = (row0 + r) / SEQ;
            while (mask) {
                const int e = __builtin_ctzll(mask); mask &= mask - 1;
                const int sl = __shfl(myslot[r], e);
                const unsigned char* yp = Y + ((size_t)(b * NEXP + e) * CAP + sl) * DM;
                unsigned y4[4];
#pragma unroll
                for (int j = 0; j < 4; ++j) y4[j] = *(const unsigned*)(yp + j * 256 + lane * 4);
#pragma unroll
                for (int j = 0; j < 4; ++j) { const f32x2 lo = __builtin_amdgcn_cvt_pk_f32_fp8((int)y4[j], false), hi = __builtin_amdgcn_cvt_pk_f32_fp8((int)y4[j], true);
                    v[r][j][0] += lo[0] * (1.0f / g8::Y_SCALE); v[r][j][1] += lo[1] * (1.0f / g8::Y_SCALE); v[r][j][2] += hi[0] * (1.0f / g8::Y_SCALE); v[r][j][3] += hi[1] * (1.0f / g8::Y_SCALE); }
            }
        }
#pragma unroll
        for (int r = 0; r < RP; ++r) {
            float ss = 0.f;
#pragma unroll
            for (int j = 0; j < 4; ++j) { ss += v[r][j][0] * v[r][j][0] + v[r][j][1] * v[r][j][1] + v[r][j][2] * v[r][j][2] + v[r][j][3] * v[r][j][3]; }
            ss = wave_sum(ss);
            const float rstd = rsqrtf(ss * (1.0f / DM) + EPS);
            if (lane == 0) { rstd3[row0 + r] = rstd; rowsq[row0 + r] = 0.f; }
            h16* hp = H + (size_t)(row0 + r) * DM;
#pragma unroll
            for (int j = 0; j < 4; ++j) { u32x2 o; o.x = pack_h2(v[r][j][0] * rstd * wv[j][0], v[r][j][1] * rstd * wv[j][1]); o.y = pack_h2(v[r][j][2] * rstd * wv[j][2], v[r][j][3] * rstd * wv[j][3]);
                *(u32x2*)(hp + j * 256 + lane * 4) = o; }
        }
    }
}

__device__ void phase_final_norm(const h16* R3H, const float* rowsq, const float* w, float* out, int blk, int nblk) {
    constexpr int RP = 4;
    const int lane = threadIdx.x & 63, gw = blk * 8 + (threadIdx.x >> 6), nw = nblk * 8;
    f32x4 wv[4];
#pragma unroll
    for (int j = 0; j < 4; ++j) wv[j] = *(const f32x4*)(w + j * 256 + lane * 4);
    for (int row0 = gw * RP; row0 < NTOK; row0 += nw * RP) {
        h16x4 v[RP][4]; float sq[RP];
#pragma unroll
        for (int r = 0; r < RP; ++r) { sq[r] = rowsq[row0 + r];
#pragma unroll
            for (int j = 0; j < 4; ++j) v[r][j] = *(const h16x4*)(R3H + (size_t)(row0 + r) * DM + j * 256 + lane * 4); }
#pragma unroll
        for (int r = 0; r < RP; ++r) {
            const float rstd = rsqrtf(sq[r] * (1.0f / DM) + EPS);
#pragma unroll
            for (int j = 0; j < 4; ++j) { f32x4 o;
#pragma unroll
                for (int q = 0; q < 4; ++q) o[q] = (float)v[r][j][q] * rstd * wv[j][q];
                *(f32x4*)(out + (size_t)(row0 + r) * DM + j * 256 + lane * 4) = o; }
        }
    }
}

__device__ void phase_router(const h16* R, const float* w, const float* wrouter, unsigned char* H8, float* probs, LAS unsigned char* lds, int blk, int nblk) {
    constexpr int RP = 2;
    LAS float* wrT = (LAS float*)lds;
    const int tid = threadIdx.x, lane = tid & 63, gw = blk * 8 + (tid >> 6), nw = nblk * 8;
    __syncthreads();
    { float tmp[32];
#pragma unroll
        for (int q = 0; q < 32; ++q) { const int i = tid + NTHREADS * q, e = i >> 10, k = i & 1023; tmp[q] = wrouter[k * NEXP + e]; }
#pragma unroll
        for (int q = 0; q < 32; ++q) wrT[tid + NTHREADS * q] = tmp[q]; }
    __syncthreads();
    f32x4 wv[4];
#pragma unroll
    for (int j = 0; j < 4; ++j) wv[j] = *(const f32x4*)(w + j * 256 + lane * 4);
    const bool b5 = lane & 32, b4 = lane & 16, b3 = lane & 8, b2 = lane & 4;
    const int mye = (b5 ? 8 : 0) + (b4 ? 4 : 0) + (b3 ? 2 : 0) + (b2 ? 1 : 0);
    for (int row0 = gw * RP; row0 < NTOK; row0 += nw * RP) {
        f32x4 v[RP][4];
#pragma unroll
        for (int r = 0; r < RP; ++r)
#pragma unroll
            for (int j = 0; j < 4; ++j) { const h16x4 hv = *(const h16x4*)(R + (size_t)(row0 + r) * DM + j * 256 + lane * 4); v[r][j] = (f32x4){(float)hv[0], (float)hv[1], (float)hv[2], (float)hv[3]}; }
#pragma unroll
        for (int r = 0; r < RP; ++r) {
            float ss = 0.f;
#pragma unroll
            for (int j = 0; j < 4; ++j) ss += v[r][j][0] * v[r][j][0] + v[r][j][1] * v[r][j][1] + v[r][j][2] * v[r][j][2] + v[r][j][3] * v[r][j][3];
            ss = wave_sum(ss);
            const float rstd = rsqrtf(ss * (1.0f / DM) + EPS);
            unsigned char* hp = H8 + (size_t)(row0 + r) * DM;
#pragma unroll
            for (int j = 0; j < 4; ++j) { v[r][j] = v[r][j] * rstd * wv[j]; *(unsigned*)(hp + j * 256 + lane * 4) = pack_fp8x4(v[r][j][0], v[r][j][1], v[r][j][2], v[r][j][3]); }
        }
        float s8a[RP][8];
#pragma unroll
        for (int i = 0; i < 8; ++i) { asm volatile("" ::: "memory");
            f32x4 wa4[4], wb4[4];
#pragma unroll
            for (int j = 0; j < 4; ++j) { wa4[j] = *(const LAS f32x4*)(wrT + i * DM + j * 256 + lane * 4); wb4[j] = *(const LAS f32x4*)(wrT + (i + 8) * DM + j * 256 + lane * 4); }
#pragma unroll
            for (int r = 0; r < RP; ++r) { float sa = 0.f, sb = 0.f;
#pragma unroll
                for (int j = 0; j < 4; ++j) { sa += v[r][j][0] * wa4[j][0] + v[r][j][1] * wa4[j][1] + v[r][j][2] * wa4[j][2] + v[r][j][3] * wa4[j][3];
                                              sb += v[r][j][0] * wb4[j][0] + v[r][j][1] * wb4[j][1] + v[r][j][2] * wb4[j][2] + v[r][j][3] * wb4[j][3]; }
                const float send = b5 ? sa : sb, keep = b5 ? sb : sa; s8a[r][i] = keep + __shfl_xor(send, 32); } }
#pragma unroll
        for (int r = 0; r < RP; ++r) {
            float s8[8], s4[4], s2[2], lg;
#pragma unroll
            for (int i = 0; i < 8; ++i) s8[i] = s8a[r][i];
#pragma unroll
            for (int i = 0; i < 4; ++i) { const float send = b4 ? s8[i] : s8[i + 4], keep = b4 ? s8[i + 4] : s8[i]; s4[i] = keep + __shfl_xor(send, 16); }
#pragma unroll
            for (int i = 0; i < 2; ++i) { const float send = b3 ? s4[i] : s4[i + 2], keep = b3 ? s4[i + 2] : s4[i]; s2[i] = keep + __shfl_xor(send, 8); }
            { const float send = b2 ? s2[0] : s2[1], keep = b2 ? s2[1] : s2[0]; lg = keep + __shfl_xor(send, 4); }
            lg += __shfl_xor(lg, 1); lg += __shfl_xor(lg, 2);
            float mx = lg;
#pragma unroll
            for (int o = 4; o <= 32; o <<= 1) mx = fmaxf(mx, __shfl_xor(mx, o));
            const float ex = expf(lg - mx); float den = ex;
#pragma unroll
            for (int o = 4; o <= 32; o <<= 1) den += __shfl_xor(den, o);
            if ((lane & 3) == 0) { const int row = row0 + r, b = row / SEQ, t = row % SEQ; probs[((size_t)b * NEXP + mye) * SEQ + t] = ex / den; }
        }
    }
}

__device__ void phase_topk(const float* probs, int* selidx, float* selgate, int* slotmap, LAS unsigned char* lds, int blk, int nblk) {
    LAS int* hist = (LAS int*)lds;
    LAS int* red = hist + 256;
    const int tid = threadIdx.x, lane = tid & 63, wid = tid >> 6;
    for (int g = blk; g < NB * NEXP; g += nblk) {
        const float* pp = probs + (size_t)g * SEQ;
        unsigned key[8]; float pv[8];
        { const f32x4 a = *(const f32x4*)(pp + tid * 8), b = *(const f32x4*)(pp + tid * 8 + 4);
#pragma unroll
          for (int j = 0; j < 4; ++j) { pv[j] = a[j]; pv[4 + j] = b[j]; }
#pragma unroll
          for (int j = 0; j < 8; ++j) key[j] = __float_as_uint(pv[j]); }
        unsigned prefix = 0; int krem = CAP;
#pragma unroll 1
        for (int ps = 0; ps < 4; ++ps) {
            const int shift = ps == 0 ? 23 : ps == 1 ? 15 : ps == 2 ? 7 : 0, bits = ps == 3 ? 7 : 8;
            const unsigned mhi = ~((1u << (shift + bits)) - 1u), dmask = (1u << bits) - 1u;
            __syncthreads();
            if (tid < 256) hist[tid] = 0;
            __syncthreads();
#pragma unroll
            for (int j = 0; j < 8; ++j) if ((key[j] & mhi) == (prefix & mhi)) __hip_atomic_fetch_add(hist + ((key[j] >> shift) & dmask), 1, __ATOMIC_RELAXED, __HIP_MEMORY_SCOPE_WORKGROUP);
            __syncthreads();
            if (wid == 0) {
                int c[4], tot = 0;
#pragma unroll
                for (int q = 0; q < 4; ++q) { c[q] = hist[4 * lane + q]; tot += c[q]; }
                int S = tot;
#pragma unroll
                for (int o = 1; o < 64; o <<= 1) { const int t = __shfl_down(S, o); if (lane + o < 64) S += t; }
                const int above = S - tot;
                if (above < krem && krem <= S) {
                    int acc = above, dsel = 4 * lane, kn = krem; bool done = false;
#pragma unroll
                    for (int q = 3; q >= 0; --q) { if (!done && acc + c[q] >= krem) { dsel = 4 * lane + q; kn = krem - acc; done = true; } if (!done) acc += c[q]; }
                    red[0] = dsel; red[1] = kn;
                }
            }
            __syncthreads();
            prefix |= (unsigned)red[0] << shift; krem = red[1];
        }
        int cgt = 0, ceq = 0;
#pragma unroll
        for (int j = 0; j < 8; ++j) { cgt += (key[j] > prefix) ? 1 : 0; ceq += (key[j] == prefix) ? 1 : 0; }
        int sg = cgt, se = ceq;
#pragma unroll
        for (int o = 1; o < 64; o <<= 1) { const int a = __shfl_up(sg, o), b = __shfl_up(se, o); if (lane >= o) { sg += a; se += b; } }
        __syncthreads();
        if (lane == 63) { red[32 + wid] = sg; red[48 + wid] = se; }
        __syncthreads();
        int bg = 0, be = 0;
#pragma unroll
        for (int w = 0; w < 8; ++w) { const int x = red[32 + w], y = red[48 + w]; if (w < wid) { bg += x; be += y; } }
        int pg = bg + sg - cgt, pe = be + se - ceq;
        const int need = krem;
#pragma unroll
        for (int j = 0; j < 8; ++j) {
            const bool gt = key[j] > prefix, eq = key[j] == prefix;
            const bool take = gt || (eq && pe < need);
            const int slot = pg + (pe < need ? pe : need);
            if (take) { selidx[(size_t)g * CAP + slot] = (g / NEXP) * SEQ + tid * 8 + j; selgate[(size_t)g * CAP + slot] = pv[j]; }
            slotmap[((size_t)(g / NEXP) * SEQ + tid * 8 + j) * NEXP + (g % NEXP)] = take ? slot : -1;
            pg += gt ? 1 : 0; pe += eq ? 1 : 0;
        }
    }
}

struct __attribute__((packed, aligned(2))) H8U { h16 v[8]; };
__device__ void phase_filters(const Args& a, h16* GR, LAS unsigned char* lds, int blk, int nblk) {
    constexpr int NP = 16;
    LAS float* z = (LAS float*)lds;
    LAS float* h1 = z + NP * 32;
    LAS float* h2 = h1 + NP * 64;
    const int tid = threadIdx.x;
    const float* w1 = a.in[I_FW1]; const float* b1 = a.in[I_FB1]; const float* fr1 = a.in[I_FFR1];
    const float* w2 = a.in[I_FW2]; const float* b2 = a.in[I_FB2]; const float* fr2 = a.in[I_FFR2];
    const float* w3 = a.in[I_FW3]; const float* hb = a.in[I_HBIAS];
    const float MIND = logf(1e-2f) / 1.5f, MAXD = logf(1e-2f) / 0.3f;
    for (int it = blk; it < SEQ / NP; it += nblk) {
        const int t0 = it * NP;
        __syncthreads();
        if (tid < NP * 17) { const int pos = tid / 17, i = tid % 17, t = t0 + pos; float v;
            if (i == 0) v = (float)t / (float)(SEQ - 1);
            else { const int bi = (i - 1) & 7; const float f = 1e-4f + (float)bi * ((7.0f - 1e-4f) / 7.0f); const float wp = 6.283185307179586f * (float)t / (float)SEQ; const float ang = f * wp;
                float sn, cs; sincos_f(ang, sn, cs); v = (i <= 8) ? cs : -sn; }
            z[pos * 32 + i] = v; }
        __syncthreads();
#pragma unroll
        for (int hf = 0; hf < NP / 8; ++hf) { const int pos = hf * 8 + (tid >> 6), j = tid & 63; float s = b1[j];
#pragma unroll
            for (int i = 0; i < 17; ++i) s += z[pos * 32 + i] * w1[i * 64 + j];
            h1[pos * 64 + j] = sin_f(fr1[j] * s); }
        __syncthreads();
#pragma unroll
        for (int hf = 0; hf < NP / 8; ++hf) { const int pos = hf * 8 + (tid >> 6), j = tid & 63; float s = b2[j];
#pragma unroll 16
            for (int i = 0; i < 64; ++i) s += h1[pos * 64 + i] * w2[i * 64 + j];
            h2[j * NP + pos] = sin_f(fr2[j] * s); }
        __syncthreads();
#pragma unroll 1
        for (int q = 0; q < 4; ++q) {
            const int col = q * 512 + tid; float acc[NP];
#pragma unroll
            for (int p = 0; p < NP; ++p) acc[p] = 0.f;
#pragma unroll 16
            for (int j = 0; j < 64; ++j) { const float wv = w3[j * 2048 + col];
#pragma unroll
                for (int p4 = 0; p4 < NP / 4; ++p4) { const f32x4 hv = *(const LAS f32x4*)(h2 + j * NP + p4 * 4);
#pragma unroll
                    for (int p = 0; p < 4; ++p) acc[p4 * 4 + p] += hv[p] * wv; } }
            const int o = col >> 10, dir = (col >> 9) & 1, c = col & 511;
            const float delta = fabsf(MIND + (float)c * ((MAXD - MIND) / 511.0f));
            h16* gp = GR + ((size_t)o * HYW + c) * 8192;
            float vals[NP];
#pragma unroll
            for (int p = 0; p < NP; ++p) { const int t = t0 + p; const float tl = (float)t / (float)(SEQ - 1); float v = acc[p] * expf(-tl * delta);
                if (dir == 0 && t == 0) v += hb[o * HYW + c];
                vals[p] = v * HY_SCALE; }
            if (dir == 0) {
                h16x8 lo, hi;
#pragma unroll
                for (int q = 0; q < 8; ++q) { lo[q] = (h16)vals[15 - q]; hi[q] = (h16)vals[7 - q]; }
                *(h16x8*)(gp + 4080 - t0) = lo; *(h16x8*)(gp + 4088 - t0) = hi;
            } else {
                H8U lo, hi;
#pragma unroll
                for (int q = 0; q < 8; ++q) { lo.v[q] = (h16)vals[q]; hi.v[q] = (h16)vals[8 + q]; }
                if (t0 == 0) {
#pragma unroll
                    for (int q = 1; q < 8; ++q) gp[4095 + q] = lo.v[q];
                    gp[8191] = (h16)0.f;
                } else *(H8U*)(gp + 4095 + t0) = lo;
                *(H8U*)(gp + 4095 + t0 + 8) = hi;
            }
        }
    }
}

constexpr int HY_ROW = 8192, HY_UIMG = 16 * HY_ROW, HY_RING = 24;
__device__ __forceinline__ int hy_uoff(int b, int s) { return b * HY_ROW + ((((s >> 3) ^ b) << 4) | ((s & 7) << 1)); }
#define HY_MFMA(acc_, a_, b_) asm volatile("v_mfma_f32_16x16x32_f16 %0, %1, %2, %0" : "+v"(acc_) : "v"(a_), "v"(b_))
__device__ void phase_hyena(const h16* __restrict__ hy, h16* __restrict__ z2, const h16* __restrict__ gr, const float* __restrict__ cw, const float* __restrict__ cb, unsigned* __restrict__ queue0, LAS unsigned char* lds, int reps) {
    const int tid = threadIdx.x, w = __builtin_amdgcn_readfirstlane(tid >> 6), l = tid & 63, bcol = l & 15, kg = l >> 4;
    LAS unsigned char* uimg = lds; LAS unsigned char* ring = lds + HY_UIMG;
    LAS int* qslot = (LAS int*)(lds + HY_UIMG + HY_RING * 1024);
    const int lbase = 4095 - (l & 15) + 8 * (l >> 4);
#pragma unroll 1
    for (int rep = 0; rep < reps; ++rep) {
    unsigned* queue = queue0 + rep;
    for (;;) {
        __syncthreads();
        if (tid == 0) *qslot = (int)atomicAdd(queue, 1u);
        __syncthreads();
        const int c = *qslot;
        if (c >= HYW) break;
        { const float w0 = cw[c], w1 = cw[HYC + c], w2 = cw[2 * HYC + c], bb = cb[c]; const int t0 = tid * 8;
#pragma unroll 8
            for (int b = 0; b < NB; ++b) {
                const h16* src = hy + (size_t)c * NTOK + (size_t)b * SEQ;
                const h16x8 rv = *(const h16x8*)(src + t0);
                const float rm = (t0 > 0) ? (float)src[t0 - 1] : 0.f, rp = (t0 + 8 < SEQ) ? (float)src[t0 + 8] : 0.f;
                float r[10]; r[0] = rm; r[9] = rp;
#pragma unroll
                for (int j = 0; j < 8; ++j) r[1 + j] = (float)rv[j];
                h16x8 o;
#pragma unroll
                for (int j = 0; j < 8; ++j) o[j] = (h16)(bb + w0 * r[j] + w1 * r[j + 1] + w2 * r[j + 2]);
                *(LAS h16x8*)(uimg + b * HY_ROW + ((tid ^ b) << 4)) = o;
            } }
#pragma unroll 1
        for (int o = 0; o < 2; ++o) {
            const h16* grp = gr + ((size_t)o * HYW + c) * 8192;
            f32x4 acc[8][4];
#pragma unroll
            for (int i = 0; i < 8; ++i)
#pragma unroll
                for (int m = 0; m < 4; ++m) acc[i][m] = (f32x4){0.f, 0.f, 0.f, 0.f};
            { const int phi = -256 + w; if (phi >= -254) { const H8U v0 = *(const H8U*)(grp + lbase - 16 * phi); *(LAS h16x8*)(ring + ((phi + 264) % HY_RING) * 1024 + l * 16) = __builtin_bit_cast(h16x8, v0); } }
            h16x8 fragA = __builtin_bit_cast(h16x8, *(const H8U*)(grp + lbase - 16 * (-248 + w))), fragB = {};
            __syncthreads();
#define HY_STEP(st_, fcur_, fnext_) do { \
                const int d0 = -64 + 2 * (st_); \
                if ((st_) < 62) fnext_ = __builtin_bit_cast(h16x8, *(const H8U*)(grp + lbase - 16 * (4 * (d0 + 4) + w))); \
                const int sbase = (4 * d0 - 2 + 264) % HY_RING; \
                _Pragma("unroll") for (int dd = 0; dd < 2; ++dd) { \
                    const int delta = d0 + dd; \
                    if (delta >= -63) { \
                        h16x8 A6[6]; \
                        _Pragma("unroll") for (int q = 0; q < 6; ++q) { int sl = sbase + 4 * dd + q; sl = sl >= HY_RING ? sl - HY_RING : sl; A6[q] = *(const LAS h16x8*)(ring + sl * 1024 + l * 16); } \
                        _Pragma("unroll") for (int i = 0; i < 8; ++i) { \
                            const int s1 = w + 8 * i - delta; \
                            if ((unsigned)s1 < 64u) { \
                                const int ch = 8 * s1 + kg; \
                                const h16x8 B0 = *(const LAS h16x8*)(uimg + bcol * HY_ROW + ((ch ^ bcol) << 4)), B1 = *(const LAS h16x8*)(uimg + bcol * HY_ROW + (((ch + 4) ^ bcol) << 4)); \
                                __builtin_amdgcn_s_setprio(1); \
                                _Pragma("unroll") for (int m = 0; m < 4; ++m) { HY_MFMA(acc[i][m], A6[m + 2], B0); HY_MFMA(acc[i][m], A6[m], B1); } \
                                __builtin_amdgcn_s_setprio(0); \
                            } } } } \
                if ((st_) < 63) *(LAS h16x8*)(ring + ((4 * (d0 + 2) + w + 264) % HY_RING) * 1024 + l * 16) = fcur_; \
                asm volatile("s_waitcnt lgkmcnt(0)" ::: "memory"); __builtin_amdgcn_s_barrier(); asm volatile("" ::: "memory"); \
            } while (0)
#pragma unroll 1
            for (int st = 0; st < 64; st += 2) { HY_STEP(st, fragA, fragB); HY_STEP(st + 1, fragB, fragA); }
#undef HY_STEP
            asm volatile("s_nop 15\n\ts_nop 15" ::: "memory");
            const int ch = (o + 1) * HYW + c;
            const float w0 = cw[ch], w1 = cw[HYC + ch], w2 = cw[2 * HYC + ch], bb = cb[ch];
            int kg_e = kg, bcol_e = bcol; asm volatile("" : "+v"(kg_e), "+v"(bcol_e));
            const h16* xsrc = hy + (size_t)ch * NTOK + (size_t)bcol_e * SEQ;
#pragma unroll
            for (int ih = 0; ih < 4; ++ih) {
                h16x4 xv[2][4]; h16 xm[2][4], xp[2][4];
#pragma unroll
                for (int ii = 0; ii < 2; ++ii)
#pragma unroll
                    for (int m = 0; m < 4; ++m) {
                        const int t = 64 * (w + 8 * (2 * ih + ii)) + 16 * m + 4 * kg_e;
                        xv[ii][m] = *(const h16x4*)(xsrc + t);
                        xm[ii][m] = (t > 0) ? xsrc[t - 1] : (h16)0.f; xp[ii][m] = (t + 4 < SEQ) ? xsrc[t + 4] : (h16)0.f;
                    }
#pragma unroll
                for (int ii = 0; ii < 2; ++ii)
#pragma unroll
                    for (int m = 0; m < 4; ++m) {
                        const int i = 2 * ih + ii;
                        const int t = 64 * (w + 8 * i) + 16 * m + 4 * kg_e;
                        float r[6]; r[0] = (float)xm[ii][m]; r[5] = (float)xp[ii][m];
#pragma unroll
                        for (int jj = 0; jj < 4; ++jj) r[1 + jj] = (float)xv[ii][m][jj];
                        h16x4 zo;
#pragma unroll
                        for (int jj = 0; jj < 4; ++jj) zo[jj] = (h16)((bb + w0 * r[jj] + w1 * r[jj + 1] + w2 * r[jj + 2]) * acc[i][m][jj] * (1.0f / HY_SCALE));
                        if (o == 0) *(LAS h16x4*)(uimg + hy_uoff(bcol_e, t)) = zo;
                        else *(h16x4*)(z2 + (size_t)c * NTOK + (size_t)bcol_e * SEQ + t) = zo;
                    }
                asm volatile("" ::: "memory");
            }
        }
    }
}
}

__device__ __forceinline__ float wave_incl_scan(float x) {
#define DPP_ADD(ctrl, rmask, bctl) x += __builtin_bit_cast(float, __builtin_amdgcn_update_dpp(0, __builtin_bit_cast(int, x), ctrl, rmask, 0xf, bctl))
    DPP_ADD(0x111, 0xf, true);
    DPP_ADD(0x112, 0xf, true);
    DPP_ADD(0x114, 0xf, true);
    DPP_ADD(0x118, 0xf, true);
    DPP_ADD(0x142, 0xa, false);
    DPP_ADD(0x143, 0xc, false);
#undef DPP_ADD
    return x;
}

constexpr int GL_QD = 0, GL_KI = 8192, GL_KDT = 16384, GL_P = 24576, GL_VT = 32768, GL_EDL = 49152, GL_WA = 49408, GL_BA = 53504, GL_QS = 54272, GL_KS = 62464, GL_VS = 70656, GL_CS = 87040;
__device__ __forceinline__ int gsw(int row, int col) { return row * 128 + ((((col >> 3) ^ (row & 7)) << 4) | ((col & 7) << 1)); }
#define GLA_BAR() do { asm volatile("s_waitcnt lgkmcnt(0)" ::: "memory"); __builtin_amdgcn_s_barrier(); asm volatile("" ::: "memory"); } while (0)
__device__ void phase_gla(const h16* __restrict__ qkvg, const float* __restrict__ codes, const float* __restrict__ waf, const float* __restrict__ baf,
                          const float* __restrict__ wab, const float* __restrict__ bab, h16* __restrict__ of, h16* __restrict__ ob, LAS unsigned char* lds, int first, int stride, int reps) {
    const int tid = threadIdx.x, w = __builtin_amdgcn_readfirstlane(tid >> 6), l = tid & 63, m16 = l & 15, kg = l >> 4;
    LAS float* EDL = (LAS float*)(lds + GL_EDL); LAS float* WA = (LAS float*)(lds + GL_WA); LAS float* BA = (LAS float*)(lds + GL_BA);
    for (int item = first; item < NB * 8 * reps; item += stride) {
        const int b = (item >> 3) % NB, h = (item >> 1) & 3, dir = item & 1;
        const float* wa = dir ? wab : waf; const float* ba = dir ? bab : baf; h16* O = dir ? ob : of;
        __syncthreads();
        for (int i = tid; i < 16 * 64; i += NTHREADS) WA[i] = wa[(i >> 6) * 256 + h * 64 + (i & 63)];
        if (tid < 64) BA[tid] = ba[h * 64 + tid];
        f32x4 S[4];
#pragma unroll
        for (int m = 0; m < 4; ++m) S[m] = (f32x4){0.f, 0.f, 0.f, 0.f};
        h16x8 pq, pk, pv0, pv1; f32x4 pc;
#define GLA_ROW(n_, c_) ((size_t)b * SEQ + (dir ? (SEQ - 1 - (64 * (n_) + (c_))) : (64 * (n_) + (c_))))
#define GLA_FETCH(n_) do { const size_t rq_ = GLA_ROW(n_, tid >> 3); pq = *(const h16x8*)(qkvg + rq_ * 1536 + h * 64 + (tid & 7) * 8); pk = *(const h16x8*)(qkvg + rq_ * 1536 + 256 + h * 64 + (tid & 7) * 8); \
            const size_t rv0_ = GLA_ROW(n_, tid >> 4), rv1_ = GLA_ROW(n_, 32 + (tid >> 4)); pv0 = *(const h16x8*)(qkvg + rv0_ * 1536 + 512 + h * 128 + (tid & 15) * 8); pv1 = *(const h16x8*)(qkvg + rv1_ * 1536 + 512 + h * 128 + (tid & 15) * 8); \
            if (tid < 256) pc = *(const f32x4*)(codes + GLA_ROW(n_, tid >> 2) * 32 + dir * 16 + (tid & 3) * 4); } while (0)
#define GLA_PARK() do { { const int t_ = tid >> 3, p_ = tid & 7; *(LAS h16x8*)(lds + GL_QS + t_ * 128 + ((p_ ^ (t_ & 7)) << 4)) = pq; *(LAS h16x8*)(lds + GL_KS + t_ * 128 + ((p_ ^ (t_ & 7)) << 4)) = pk; } \
            { const int t0_ = tid >> 4, t1_ = 32 + (tid >> 4), p_ = tid & 15; *(LAS h16x8*)(lds + GL_VS + t0_ * 256 + ((p_ ^ ((t0_ & 7) << 1)) << 4)) = pv0; *(LAS h16x8*)(lds + GL_VS + t1_ * 256 + ((p_ ^ ((t1_ & 7) << 1)) << 4)) = pv1; } \
            if (tid < 256) *(LAS f32x4*)(lds + GL_CS + (tid >> 2) * 80 + (tid & 3) * 16) = pc; } while (0)
        GLA_FETCH(0);
        GLA_PARK();
        GLA_FETCH(1);
#pragma unroll 1
        for (int n = 0; n < SEQ / 64; ++n) {
            GLA_BAR();
            {
                const h16x8 cq = *(const LAS h16x8*)(lds + GL_QS + l * 128 + ((w ^ (l & 7)) << 4)), ck = *(const LAS h16x8*)(lds + GL_KS + l * 128 + ((w ^ (l & 7)) << 4));
                const h16x8 cv0 = *(const LAS h16x8*)(lds + GL_VS + l * 256 + (((2 * w) ^ ((l & 7) << 1)) << 4)), cv1 = *(const LAS h16x8*)(lds + GL_VS + l * 256 + (((2 * w + 1) ^ ((l & 7) << 1)) << 4));
                f32x4 cc[4];
#pragma unroll
                for (int r = 0; r < 4; ++r) cc[r] = *(const LAS f32x4*)(lds + GL_CS + l * 80 + r * 16);
                float z[8];
                { const f32x4 b0 = *(const LAS f32x4*)(BA + 8 * w), b1 = *(const LAS f32x4*)(BA + 8 * w + 4);
#pragma unroll
                  for (int j = 0; j < 4; ++j) { z[j] = b0[j]; z[4 + j] = b1[j]; } }
#pragma unroll
                for (int r = 0; r < 16; ++r) { const float cr = cc[r >> 2][r & 3]; const f32x4 w0 = *(const LAS f32x4*)(WA + r * 64 + 8 * w), w1 = *(const LAS f32x4*)(WA + r * 64 + 8 * w + 4);
#pragma unroll
                    for (int j = 0; j < 4; ++j) { z[j] += cr * w0[j]; z[4 + j] += cr * w1[j]; } }
                h16x8 qd, ki, kd; float edl[8];
#pragma unroll
                for (int j = 0; j < 8; ++j) {
                    const float ls = fminf(z[j], 0.f) - __logf(1.0f + __expf(-fabsf(z[j])));
                    float bb = ls * (1.0f / 16.0f);
                    bb = wave_incl_scan(bb);
                    const float bl = __builtin_bit_cast(float, __builtin_amdgcn_readlane(__builtin_bit_cast(int, bb), 63));
                    const float E = __expf(bb), Ei = 1.0f / E, el = __expf(bl);
                    edl[j] = el;
                    qd[j] = (h16)((float)cq[j] * 0.125f * E); const float kiv = (float)ck[j] * Ei; ki[j] = (h16)kiv; kd[j] = (h16)(kiv * el);
                }
                *(LAS h16x8*)(lds + GL_QD + l * 128 + ((w ^ (l & 7)) << 4)) = qd;
                *(LAS h16x8*)(lds + GL_KI + l * 128 + ((w ^ (l & 7)) << 4)) = ki;
#pragma unroll
                for (int j = 0; j < 8; ++j) *(LAS h16*)(lds + GL_KDT + gsw(8 * w + j, l)) = kd[j];
#pragma unroll
                for (int j = 0; j < 8; ++j) { *(LAS h16*)(lds + GL_VT + gsw(16 * w + j, l)) = cv0[j]; *(LAS h16*)(lds + GL_VT + gsw(16 * w + 8 + j, l)) = cv1[j]; }
                if (l == 0) {
#pragma unroll
                    for (int j = 0; j < 8; ++j) EDL[8 * w + j] = edl[j]; }
            }
            GLA_BAR();
            {
                const int mi = w & 3;
                h16x8 Aq[2];
                Aq[0] = *(const LAS h16x8*)(lds + GL_QD + gsw(16 * mi + m16, 8 * kg)); Aq[1] = *(const LAS h16x8*)(lds + GL_QD + gsw(16 * mi + m16, 32 + 8 * kg));
#pragma unroll
                for (int q = 0; q < 2; ++q) {
                    const int nj = 2 * (w >> 2) + q;
                    if (nj <= mi) {
                        const h16x8 B0 = *(const LAS h16x8*)(lds + GL_KI + gsw(16 * nj + m16, 8 * kg)), B1 = *(const LAS h16x8*)(lds + GL_KI + gsw(16 * nj + m16, 32 + 8 * kg));
                        f32x4 p = (f32x4){0.f, 0.f, 0.f, 0.f};
                        p = __builtin_amdgcn_mfma_f32_16x16x32_f16(Aq[0], B0, p, 0, 0, 0);
                        p = __builtin_amdgcn_mfma_f32_16x16x32_f16(Aq[1], B1, p, 0, 0, 0);
#pragma unroll
                        for (int r = 0; r < 4; ++r) { const int c = 16 * mi + 4 * kg + r, cp = 16 * nj + m16; const bool keep = dir ? (cp < c) : (cp <= c);
                            *(LAS h16*)(lds + GL_P + gsw(c, cp)) = (h16)(keep ? p[r] : 0.f); }
                    } else if ((nj >> 1) == (mi >> 1)) {
#pragma unroll
                        for (int r = 0; r < 4; ++r) *(LAS h16*)(lds + GL_P + gsw(16 * mi + 4 * kg + r, 16 * nj + m16)) = (h16)0.f;
                    }
                }
            }
            GLA_BAR();
            {
                h16x8 Bv[2];
                Bv[0] = *(const LAS h16x8*)(lds + GL_VT + gsw(16 * w + m16, 8 * kg)); Bv[1] = *(const LAS h16x8*)(lds + GL_VT + gsw(16 * w + m16, 32 + 8 * kg));
                h16x8 Sf[2];
#pragma unroll
                for (int ks = 0; ks < 2; ++ks)
#pragma unroll
                    for (int j = 0; j < 4; ++j) { Sf[ks][j] = (h16)S[2 * ks][j]; Sf[ks][4 + j] = (h16)S[2 * ks + 1][j]; }
#pragma unroll
                for (int mi = 0; mi < 4; ++mi) {
                    f32x4 o = (f32x4){0.f, 0.f, 0.f, 0.f};
#pragma unroll
                    for (int ks = 0; ks < 2; ++ks) {
                        if (!(ks == 1 && mi < 2)) { const h16x8 Ap = *(const LAS h16x8*)(lds + GL_P + gsw(16 * mi + m16, 32 * ks + 8 * kg)); o = __builtin_amdgcn_mfma_f32_16x16x32_f16(Ap, Bv[ks], o, 0, 0, 0); }
                        const h16x4 a0 = *(const LAS h16x4*)(lds + GL_QD + gsw(16 * mi + m16, 32 * ks + 4 * kg)), a1 = *(const LAS h16x4*)(lds + GL_QD + gsw(16 * mi + m16, 32 * ks + 16 + 4 * kg));
                        h16x8 Aqs;
#pragma unroll
                        for (int j = 0; j < 4; ++j) { Aqs[j] = a0[j]; Aqs[4 + j] = a1[j]; }
                        o = __builtin_amdgcn_mfma_f32_16x16x32_f16(Aqs, Sf[ks], o, 0, 0, 0);
                    }
#pragma unroll
                    for (int r = 0; r < 4; ++r) { const int c = 16 * mi + 4 * kg + r; const int tok = dir ? (SEQ - 1 - (64 * n + c)) : (64 * n + c);
                        O[((size_t)b * SEQ + tok) * 512 + h * 128 + 16 * w + m16] = (h16)o[r]; }
                }
#pragma unroll
                for (int mt = 0; mt < 4; ++mt) {
                    const f32x4 e4 = *(const LAS f32x4*)(EDL + 16 * mt + 4 * kg);
                    S[mt] = S[mt] * e4;
#pragma unroll
                    for (int ks = 0; ks < 2; ++ks) { const h16x8 Ak = *(const LAS h16x8*)(lds + GL_KDT + gsw(16 * mt + m16, 32 * ks + 8 * kg)); S[mt] = __builtin_amdgcn_mfma_f32_16x16x32_f16(Ak, Bv[ks], S[mt], 0, 0, 0); }
                }
            }
            if (n + 1 < SEQ / 64) GLA_PARK();
            if (n + 2 < SEQ / 64) GLA_FETCH(n + 2);
        }
    }
}

__device__ void phase_mixbuild(const h16* __restrict__ of, const h16* __restrict__ ob, const h16* __restrict__ qkvg, const float* __restrict__ nw, const h16* __restrict__ z2,
                               h16* __restrict__ mix, LAS unsigned char* lds, int blk, int nblk) {
    LAS h16* tileT = (LAS h16*)lds;
    const int tid = threadIdx.x;
    float nwv[8];
#pragma unroll
    for (int j = 0; j < 8; ++j) nwv[j] = nw[(tid & 15) * 8 + j];
    for (int sl = blk; sl < NTOK / 64; sl += nblk) {
        const int tok0 = sl * 64;
        h16x8 zv[8];
#pragma unroll
        for (int i = 0; i < 8; ++i) zv[i] = *(const h16x8*)(z2 + (size_t)tid * NTOK + tok0 + 8 * i);
#pragma unroll 2
        for (int i = 0; i < 8; ++i) {
            const int task = tid + NTHREADS * i, token = task >> 6, head = (task >> 4) & 3, part = task & 15;
            const size_t row = (size_t)tok0 + token;
            const h16x8 a = *(const h16x8*)(of + row * 512 + head * 128 + part * 8), b = *(const h16x8*)(ob + row * 512 + head * 128 + part * 8);
            const h16x8 g = *(const h16x8*)(qkvg + row * 1536 + 1024 + head * 128 + part * 8);
            float o[8], ss = 0.f;
#pragma unroll
            for (int j = 0; j < 8; ++j) { o[j] = (float)a[j] + (float)b[j]; ss += o[j] * o[j]; }
            ss += __shfl_xor(ss, 1); ss += __shfl_xor(ss, 2); ss += __shfl_xor(ss, 4); ss += __shfl_xor(ss, 8);
            const float rstd = rsqrtf(ss * (1.0f / 128.0f) + EPS);
            h16x8 r;
#pragma unroll
            for (int j = 0; j < 8; ++j) r[j] = (h16)(o[j] * rstd * nwv[j] * siluf_((float)g[j]));
            *(h16x8*)(mix + row * DM + head * 128 + part * 8) = r;
        }
        __syncthreads();
#pragma unroll
        for (int i = 0; i < 8; ++i)
#pragma unroll
            for (int j = 0; j < 8; ++j) tileT[(8 * i + j) * 520 + tid] = zv[i][j];
        __syncthreads();
#pragma unroll
        for (int i = 0; i < 8; ++i) { const int idx = tid + NTHREADS * i, token = idx >> 6, c8 = (idx & 63) * 8;
            *(h16x8*)(mix + (size_t)(tok0 + token) * DM + 512 + c8) = *(const LAS h16x8*)(tileT + token * 520 + c8); }
    }
}

enum { PH_PREP = 0, PH_NORM1, PH_FILT, PH_G1A, PH_G1B, PH_GLA, PH_HYENA, PH_GLAMIX, PH_G2, PH_ROUTER, PH_TOPK, PH_MOE1, PH_MOE2, PH_NORM3, PH_G5, PH_G6, PH_FINAL, PH_COUNT };

template <bool COOP>
__global__ __launch_bounds__(NTHREADS, 2) void mega(Args a) {
    extern __shared__ __attribute__((aligned(16))) unsigned char shm[];
    LAS unsigned char* lds = (LAS unsigned char*)shm;
    const int blk = blockIdx.x, nblk = gridDim.x;
    unsigned char* ws = a.ws;
#ifndef PROBE_MASK
#define PROBE_MASK 0u
#endif
#define RUN(P, SYNC, ...) if (a.ph_lo <= (P) && (P) < a.ph_hi) { { __syncthreads(); const float pscale = 1.f; (void)pscale; __VA_ARGS__ } \
        if constexpr (((PROBE_MASK >> (P)) & 1u) != 0u && (P) != PH_GLA && (P) != PH_HYENA) { if (COOP) cg::this_grid().sync(); __syncthreads(); const float pscale = 0.f; (void)pscale; __VA_ARGS__ } \
        if (COOP && (SYNC)) { if ((P) + 1 < a.ph_hi) cg::this_grid().sync(); } }
    RUN(PH_PREP, false, phase_prep(a, lds, blk, nblk);)
    RUN(PH_NORM1, false, phase_rmsnorm_h16(a.in[I_X], a.in[I_LNMIX], (h16*)(ws + OFF_H), blk, nblk);)
    RUN(PH_FILT, true, phase_filters(a, (h16*)(ws + OFF_GR), lds, blk, nblk);)
    RUN(PH_G1A, false, { g8::DenseSched S; S.init(ws + OFF_WINA, NTOK, NA1, DM, nblk, blk); g8::EpiQKVG E{(h16*)(ws + OFF_QKVG), (float*)(ws + OFF_CODES)};
        g8::gemm_phase(lds, (const char*)(ws + OFF_H), DM, S, E); })
    RUN(PH_G1B, true, { g8::DenseSched S; S.init(ws + OFF_H, HYC, NTOK, DM, nblk, blk); g8::EpiH16 E{(h16*)(ws + OFF_HY), NTOK};
        g8::gemm_phase(lds, (const char*)(ws + OFF_WINHY), DM, S, E); })
    RUN(PH_GLA, false, { const int ng = nblk >= 2 * NB * 8 ? NB * 8 : nblk;
        if (blk >= nblk - ng) phase_gla((const h16*)(ws + OFF_QKVG), (const float*)(ws + OFF_CODES), a.in[I_WAF], a.in[I_BAF], a.in[I_WAB], a.in[I_BAB], (h16*)(ws + OFF_OF), (h16*)(ws + OFF_OB), lds, blk - (nblk - ng), ng, 1 + (int)((PROBE_MASK >> 5) & 1u)); })
    RUN(PH_HYENA, true, phase_hyena((const h16*)(ws + OFF_HY), (h16*)(ws + OFF_Z2), (const h16*)(ws + OFF_GR), a.in[I_HCW], a.in[I_HCB], (unsigned*)(ws + OFF_CTR), lds, 1 + (int)((PROBE_MASK >> 6) & 1u));)
    RUN(PH_GLAMIX, true, phase_mixbuild((const h16*)(ws + OFF_OF), (const h16*)(ws + OFF_OB), (const h16*)(ws + OFF_QKVG), a.in[I_GLANW], (const h16*)(ws + OFF_Z2), (h16*)(ws + OFF_H), lds, blk, nblk);)
    RUN(PH_G2, true, { g8::DenseSched S; S.init(ws + OFF_WOUT, NTOK, DM, DM, nblk, blk); g8::EpiResid E{a.in[I_X], (h16*)a.out};
        g8::gemm_phase(lds, (const char*)(ws + OFF_H), DM, S, E); })
    RUN(PH_ROUTER, true, phase_router((const h16*)a.out, a.in[I_LNFFN], a.in[I_WROUTER], ws + OFF_H, (float*)(ws + OFF_PROBS), lds, blk, nblk);)
    RUN(PH_TOPK, true, phase_topk((const float*)(ws + OFF_PROBS), (int*)(ws + OFF_SELIDX), (float*)(ws + OFF_SELGATE), (int*)(ws + OFF_SLOTMAP), lds, blk, nblk);)
    RUN(PH_MOE1, true, { g8::Moe1Sched S{(const char*)(ws + OFF_WGU), (const int*)(ws + OFF_SELIDX), nblk, blk}; g8::EpiHid E{ws + OFF_HID};
        g8::gemm_phase<g8::EpiHid, g8::Moe1Sched, true>(lds, (const char*)(ws + OFF_H), DM / 2, S, E); })
    RUN(PH_MOE2, true, { g8::Moe2Sched S{(const char*)(ws + OFF_WD), nblk, blk}; g8::EpiDown E{ws + OFF_Y, (const float*)(ws + OFF_SELGATE)};
        g8::gemm_phase<g8::EpiDown, g8::Moe2Sched, true>(lds, (const char*)(ws + OFF_HID), DFF / 2, S, E); })
    RUN(PH_NORM3, false, phase_combine_norm((const h16*)a.out, ws + OFF_Y, (const int*)(ws + OFF_SLOTMAP), a.in[I_LNPLE], (h16*)(ws + OFF_H3), (float*)(ws + OFF_RSTD3), (float*)(ws + OFF_ROWSQ), blk, nblk);)
    RUN(PH_G5, true, { g8::DenseSched S; S.init(ws + OFF_WP, NTOK, DM, 256, nblk, blk); g8::EpiH16 E{(h16*)(ws + OFF_PP), DM};
        g8::gemm_phase(lds, (const char*)(ws + OFF_P16), 256, S, E); })
    RUN(PH_G6, true, { g8::DenseSched S; S.init(ws + OFF_WG, NTOK, DM, DM, nblk, blk); g8::EpiPle E{(const h16*)(ws + OFF_H3), (const float*)(ws + OFF_RSTD3), a.in[I_LNPLE], (const h16*)(ws + OFF_PP), (h16*)(ws + OFF_R3H), (float*)(ws + OFF_ROWSQ)};
        g8::gemm_phase(lds, (const char*)(ws + OFF_H3), DM, S, E); })
    RUN(PH_FINAL, false, phase_final_norm((const h16*)(ws + OFF_R3H), (const float*)(ws + OFF_ROWSQ), a.in[I_FNW], a.out, blk, nblk);)
}

extern "C" void kernel_launch(void* const* d_in, const int* in_sizes, int n_in, void* d_out, int out_size, void* d_ws, size_t ws_size, hipStream_t stream) {
    static int grid = 0;
    if (grid == 0) {
        if (n_in != N_IN || out_size != NTOK * DM || ws_size < WS_END) { fprintf(stderr, "kernel_launch: unexpected shapes (n_in %d, out %d, ws %zu, need %zu)\n", n_in, out_size, ws_size, (size_t)WS_END); grid = -1; return; }
        int dev = 0, cus = 0, per_cu = 0;
        (void)hipGetDevice(&dev); (void)hipDeviceGetAttribute(&cus, hipDeviceAttributeMultiprocessorCount, dev);
        (void)hipFuncSetAttribute((const void*)mega<true>, hipFuncAttributeMaxDynamicSharedMemorySize, LDS_BYTES);
        (void)hipOccupancyMaxActiveBlocksPerMultiprocessor(&per_cu, (const void*)mega<true>, NTHREADS, LDS_BYTES);
        if (per_cu < 1) { fprintf(stderr, "kernel_launch: occupancy query says %d blocks per CU\n", per_cu); per_cu = 1; }
        grid = cus * (per_cu > 1 ? 1 : per_cu);
        (void)hipGetLastError();
    }
    if (grid < 0) return;
    Args a{};
    for (int i = 0; i < N_IN; ++i) a.in[i] = (const float*)d_in[i];
    a.out = (float*)d_out; a.ws = (unsigned char*)d_ws;
    a.ph_lo = 0; a.ph_hi = PH_COUNT;
    void* args[] = {&a};
    hipError_t e = hipLaunchCooperativeKernel((const void*)mega<true>, dim3(grid), dim3(NTHREADS), args, LDS_BYTES, stream);
    if (e != hipSuccess) fprintf(stderr, "kernel_launch: cooperative launch failed: %s (grid %d)\n", hipGetErrorString(e), grid);
}
```

```cpp
#include <hip/hip_runtime.h>
#include <hip/hip_cooperative_groups.h>
#include <cstdio>
#include <cstdint>
#include <cstddef>

namespace cg = cooperative_groups;

#define LAS __attribute__((address_space(3)))
typedef _Float16 h16;
typedef _Float16 h16x8 __attribute__((ext_vector_type(8)));
typedef _Float16 h16x4 __attribute__((ext_vector_type(4)));
typedef _Float16 h16x2 __attribute__((ext_vector_type(2)));
typedef float f32x4 __attribute__((ext_vector_type(4)));
typedef float f32x2 __attribute__((ext_vector_type(2)));
typedef unsigned u32x4 __attribute__((ext_vector_type(4)));
typedef unsigned u32x2 __attribute__((ext_vector_type(2)));
typedef int i32x8 __attribute__((ext_vector_type(8)));
typedef int i32x4 __attribute__((ext_vector_type(4)));

constexpr int NB = 16, SEQ = 4096, DM = 1024, NTOK = NB * SEQ;
constexpr int INCOLS = 3104;
constexpr int NEXP = 16, CAP = 512, DFF = 2048;
constexpr int HYW = 512, HYC = 1536;
constexpr float EPS = 1e-6f;

enum { I_X = 0, I_P, I_LNMIX, I_WIN, I_WAF, I_BAF, I_WAB, I_BAB, I_GLANW, I_HCW, I_HCB, I_FW1, I_FB1, I_FFR1, I_FW2, I_FB2, I_FFR2,
       I_FW3, I_HBIAS, I_WOUT, I_LNFFN, I_WROUTER, I_WGATE, I_WUP, I_WDOWN, I_LNPLE, I_WPG, I_WPP, I_FNW, N_IN };

constexpr size_t AL(size_t x) { return (x + 255) & ~(size_t)255; }
constexpr int NA1 = 1792;
constexpr size_t OFF_WINA = 0;
constexpr size_t OFF_WINHY = OFF_WINA + AL((size_t)NA1 * DM * 2);
constexpr size_t OFF_WOUT = OFF_WINHY + AL((size_t)HYC * DM * 2);
constexpr size_t OFF_WGU = OFF_WOUT + AL((size_t)DM * DM * 2);
constexpr size_t OFF_WD = OFF_WGU + AL((size_t)NEXP * 2 * DFF * DM * 2);
constexpr size_t OFF_WG = OFF_WD + AL((size_t)NEXP * DM * DFF * 2);
constexpr size_t OFF_WP = OFF_WG + AL((size_t)DM * DM * 2);
constexpr size_t OFF_P16 = OFF_WP + AL((size_t)DM * 256 * 2);
constexpr size_t OFF_PROBS = OFF_P16 + AL((size_t)NTOK * 256 * 2);
constexpr size_t OFF_SELIDX = OFF_PROBS + AL((size_t)NB * NEXP * SEQ * 4);
constexpr size_t OFF_SELGATE = OFF_SELIDX + AL((size_t)NB * NEXP * CAP * 4);
constexpr size_t OFF_SLOTMAP = OFF_SELGATE + AL((size_t)NB * NEXP * CAP * 4);
constexpr size_t OFF_CTR = OFF_SLOTMAP + AL((size_t)NTOK * NEXP * 4);
constexpr size_t OFF_XBAR = OFF_CTR + 256;
constexpr size_t OFF_BIG = OFF_XBAR + AL(3456 * 4);
constexpr size_t OFF_QKVG = OFF_BIG;
constexpr size_t OFF_HY = OFF_QKVG + AL((size_t)NTOK * 1536 * 2);
constexpr size_t OFF_CODES = OFF_HY + AL((size_t)HYC * NTOK * 2);
constexpr size_t OFF_OF = OFF_CODES + AL((size_t)NTOK * 32 * 4);
constexpr size_t OFF_OB = OFF_OF + AL((size_t)NTOK * 512 * 2);
constexpr size_t OFF_GR = OFF_OB + AL((size_t)NTOK * 512 * 2);
constexpr size_t OFF_H = OFF_GR + AL((size_t)2 * HYW * 8192 * 2);
constexpr size_t OFF_Z2 = OFF_H + AL((size_t)NTOK * DM * 2);
constexpr size_t END_A = OFF_Z2 + AL((size_t)HYW * NTOK * 2);
constexpr size_t OFF_HID = OFF_BIG;
constexpr size_t OFF_Y = OFF_HID + AL((size_t)NB * NEXP * CAP * DFF * 2);
constexpr size_t END_B = OFF_Y + AL((size_t)NB * NEXP * CAP * DM * 2);
static_assert(OFF_H >= OFF_Y, "h2 (read by the up/gate GEMM) must not be overwritten by HID");
constexpr size_t OFF_H3 = OFF_BIG;
constexpr size_t OFF_PP = OFF_H3 + AL((size_t)NTOK * DM * 2);
constexpr size_t OFF_R3H = OFF_PP + AL((size_t)NTOK * DM * 2);
constexpr size_t OFF_RSTD3 = OFF_R3H + AL((size_t)NTOK * DM * 2);
constexpr size_t OFF_ROWSQ = OFF_RSTD3 + AL((size_t)NTOK * 4);
constexpr size_t END_C = OFF_ROWSQ + AL((size_t)NTOK * 4);
constexpr size_t WS_END = END_A > END_B ? (END_A > END_C ? END_A : END_C) : (END_B > END_C ? END_B : END_C);

constexpr int NTHREADS = 512;
constexpr int LDS_BYTES = 156 * 1024;
constexpr float HY_SCALE = 64.0f;
constexpr int FP8_WSHIFT = 5;


struct Args {
    const float* in[N_IN];
    float* out;
    unsigned char* ws;
    int ph_lo, ph_hi;
};

__device__ __forceinline__ float wave_sum(float v) {
#pragma unroll
    for (int o = 32; o >= 1; o >>= 1) v += __shfl_xor(v, o);
    return v;
}
__device__ __forceinline__ float sigmoidf_(float x) { return 1.0f / (1.0f + __expf(-x)); }
__device__ __forceinline__ float siluf_(float x) { return x / (1.0f + __expf(-x)); }
__device__ __forceinline__ unsigned pack_h2(float a, float b) {
    h16x2 v; v.x = (h16)a; v.y = (h16)b; return __builtin_bit_cast(unsigned, v);
}


__device__ __forceinline__ void sincos_f(float x, float& s, float& c) {
    const float kf = rintf(x * 0.6366197723675814f);
    float r = fmaf(kf, -1.5707963705062866f, x); r = fmaf(kf, 4.371139000186241e-8f, r);
    const float r2 = r * r;
    const float sp = r + r * r2 * (-1.6666667e-1f + r2 * (8.3333338e-3f + r2 * (-1.9841270e-4f + r2 * 2.7557319e-6f)));
    const float cp = 1.0f + r2 * (-0.5f + r2 * (4.1666668e-2f + r2 * (-1.3888889e-3f + r2 * (2.4801587e-5f - r2 * 2.7557319e-7f))));
    const int k = (int)kf & 3;
    s = (k == 0) ? sp : (k == 1) ? cp : (k == 2) ? -sp : -cp;
    c = (k == 0) ? cp : (k == 1) ? -sp : (k == 2) ? -cp : sp;
}
__device__ __forceinline__ float sin_f(float x) { float s, c; sincos_f(x, s, c); return s; }

__device__ __forceinline__ unsigned pack_fp8x4(float a, float b, float c, float d) {
    int r = 0; r = __builtin_amdgcn_cvt_pk_fp8_f32(a, b, r, false); r = __builtin_amdgcn_cvt_pk_fp8_f32(c, d, r, true); return (unsigned)r;
}

namespace g8 {
constexpr int BM = 256, BK = 64, HALF = 128, HTB = HALF * BK * 2, STAGE_BYTES = 8 * HTB;
__device__ __forceinline__ int lds_byte(int r, int c) { const int st = (r >> 4) * 2 + (c >> 5), rr = r & 15, cc = c & 31, ob = rr * 64 + cc * 2; return st * 1024 + (ob ^ (((ob >> 9) & 1) << 5)); }
__device__ __forceinline__ void stage_rc(int b, int& R, int& C) { const int st = b / 1024, sb = b % 1024, swz = sb ^ (((sb >> 9) & 1) << 5); R = (st >> 1) * 16 + swz / 64; C = (st & 1) * 32 + (swz % 64) / 2; }
__device__ __forceinline__ int perm32(int rho) { const int n = rho >> 4, i = rho & 15; return 8 * (i >> 2) + 4 * n + (i & 3); }

struct Unit { const char* B; int pm, pn, g; unsigned rowbase; };

template <class Epi, class Sched, bool FP8 = false>
__device__ __forceinline__ void gemm_phase(LAS unsigned char* lds, const char* A, const int K, const Sched& S, const Epi& E) {
    const int tid = threadIdx.x, wid = __builtin_amdgcn_readfirstlane(tid >> 6), lane = tid & 63, wr = wid >> 2, wc = wid & 3, fr = lane & 15, fq = lane >> 4;
    const int nt = K / BK;
    int Rr[2], Cc[2]; unsigned voffB[2];
#pragma unroll
    for (int i = 0; i < 2; ++i) { stage_rc(tid * 16 + i * 8192, Rr[i], Cc[i]); const int Rb = Epi::PERM ? ((Rr[i] & ~31) + perm32(Rr[i] & 31)) : Rr[i];
        voffB[i] = (unsigned)(Rb * K + Cc[i]) * 2u; }
    const size_t kstep = (size_t)(BK * 2);
    const size_t hstep = (size_t)HALF * K * 2;
    const unsigned ldsw = (unsigned)wid * 1024u;
    const int aoff = lds_byte(wr * 64 + fr, fq * 8), boff = lds_byte(wc * 32 + fr, fq * 8);
#define G8_SA(b, h) (((b) * 2 + (h)) * HTB)
#define G8_SB(b, h) ((4 + (b) * 2 + (h)) * HTB)
#define G8_STAGE(bufoff, gbase, v0, v1) do { \
        __builtin_amdgcn_global_load_lds((const unsigned*)((const char*)(gbase) + (v0)), (LAS unsigned*)(lds + (bufoff) + ldsw), 16, 0, 0); \
        __builtin_amdgcn_global_load_lds((const unsigned*)((const char*)(gbase) + (v1)), (LAS unsigned*)(lds + (bufoff) + ldsw + 8192), 16, 0, 0); } while (0)
#define G8_LDA(dst, b, h) do { _Pragma("unroll") for (int m = 0; m < 4; ++m) { \
        const i32x4 lo_ = *(const LAS i32x4*)(lds + G8_SA(b, h) + aoff + m * 2048), hi_ = *(const LAS i32x4*)(lds + G8_SA(b, h) + aoff + m * 2048 + 1024); \
        dst[m] = __builtin_shufflevector(lo_, hi_, 0, 1, 2, 3, 4, 5, 6, 7); } } while (0)
#define G8_LDB(dst, b, h) do { _Pragma("unroll") for (int n = 0; n < 2; ++n) { \
        const i32x4 lo_ = *(const LAS i32x4*)(lds + G8_SB(b, h) + boff + n * 2048), hi_ = *(const LAS i32x4*)(lds + G8_SB(b, h) + boff + n * 2048 + 1024); \
        dst[n] = __builtin_shufflevector(lo_, hi_, 0, 1, 2, 3, 4, 5, 6, 7); } } while (0)
#define G8_MMA(ai, bj, At, Bt) do { __builtin_amdgcn_s_setprio(1); \
        if constexpr (FP8) { _Pragma("unroll") for (int m = 0; m < 4; ++m) _Pragma("unroll") for (int n = 0; n < 2; ++n) \
            asm volatile("v_mfma_scale_f32_16x16x128_f8f6f4 %0, %1, %2, %0, %3, %3 op_sel_hi:[0,0,0]" : "+v"(acc[ai][bj][m][n]) : "v"(Bt[n]), "v"(At[m]), "v"(sc_one)); } \
        else { _Pragma("unroll") for (int m = 0; m < 4; ++m) _Pragma("unroll") for (int n = 0; n < 2; ++n) { \
            const i32x8 a_ = At[m], b_ = Bt[n]; \
            const h16x8 a0_ = __builtin_bit_cast(h16x8, __builtin_shufflevector(a_, a_, 0, 1, 2, 3)), a1_ = __builtin_bit_cast(h16x8, __builtin_shufflevector(a_, a_, 4, 5, 6, 7)); \
            const h16x8 b0_ = __builtin_bit_cast(h16x8, __builtin_shufflevector(b_, b_, 0, 1, 2, 3)), b1_ = __builtin_bit_cast(h16x8, __builtin_shufflevector(b_, b_, 4, 5, 6, 7)); \
            acc[ai][bj][m][n] = __builtin_amdgcn_mfma_f32_16x16x32_f16(b0_, a0_, acc[ai][bj][m][n], 0, 0, 0); \
            acc[ai][bj][m][n] = __builtin_amdgcn_mfma_f32_16x16x32_f16(b1_, a1_, acc[ai][bj][m][n], 0, 0, 0); } } \
        __builtin_amdgcn_s_setprio(0); } while (0)
#define G8_WAIT_V(n) asm volatile("s_waitcnt vmcnt(" #n ")" ::: "memory")
#define G8_WAIT_L(n) asm volatile("s_waitcnt lgkmcnt(" #n ")" ::: "memory")
#define G8_BAR __builtin_amdgcn_s_barrier()
#define G8_SCHED __builtin_amdgcn_sched_barrier(0)
    Unit cur, nxt; int ui = 0;
    if (!S.next(0, cur)) return;
    f32x4 acc[2][2][4][2];
#pragma unroll
    for (int a = 0; a < 2; ++a)
#pragma unroll
        for (int b = 0; b < 2; ++b)
#pragma unroll
            for (int m = 0; m < 4; ++m)
#pragma unroll
                for (int n = 0; n < 2; ++n) acc[a][b][m][n] = (f32x4){0.f, 0.f, 0.f, 0.f};
    i32x8 At[4], B0[2], B1[2];
    const int sc_one = 0x7f7f7f7f; (void)sc_one;
    unsigned va00, va01, va10, va11, vn00, vn01, vn10, vn11;
    va00 = (S.arow(cur, Rr[0]) * (unsigned)K + (unsigned)Cc[0]) * 2u; va01 = (S.arow(cur, Rr[1]) * (unsigned)K + (unsigned)Cc[1]) * 2u;
    va10 = (S.arow(cur, HALF + Rr[0]) * (unsigned)K + (unsigned)Cc[0]) * 2u; va11 = (S.arow(cur, HALF + Rr[1]) * (unsigned)K + (unsigned)Cc[1]) * 2u;
    vn00 = va00; vn01 = va01; vn10 = va10; vn11 = va11;
    const char* cB = cur.B;
    G8_STAGE(G8_SB(0, 0), cB, voffB[0], voffB[1]); G8_STAGE(G8_SA(0, 0), A, va00, va01); G8_STAGE(G8_SB(0, 1), cB + hstep, voffB[0], voffB[1]); G8_STAGE(G8_SA(0, 1), A, va10, va11);
    if (wr == 1) G8_BAR;
    G8_WAIT_V(4); G8_BAR;
    G8_STAGE(G8_SB(1, 0), cB + kstep, voffB[0], voffB[1]); G8_STAGE(G8_SA(1, 0), A + kstep, va00, va01); G8_STAGE(G8_SB(1, 1), cB + hstep + kstep, voffB[0], voffB[1]);
    G8_WAIT_V(6); G8_BAR;
    for (;;) {
        const bool has_next = S.next(ui + 1, nxt);
        const char* nB = has_next ? nxt.B : cB;
        if (has_next) {
            vn00 = (S.arow(nxt, Rr[0]) * (unsigned)K + (unsigned)Cc[0]) * 2u; vn01 = (S.arow(nxt, Rr[1]) * (unsigned)K + (unsigned)Cc[1]) * 2u;
            vn10 = (S.arow(nxt, HALF + Rr[0]) * (unsigned)K + (unsigned)Cc[0]) * 2u; vn11 = (S.arow(nxt, HALF + Rr[1]) * (unsigned)K + (unsigned)Cc[1]) * 2u;
        }
        for (int t = 0; t < nt; t += 2) {
            const bool last = (t == nt - 2);
            const char* a1 = A + (size_t)(t + 1) * kstep;
            const char* a2 = last ? A : A + (size_t)(t + 2) * kstep; const char* b2 = last ? nB : cB + (size_t)(t + 2) * kstep;
            const char* a3 = a2 + kstep; const char* b3 = b2 + kstep;
            const unsigned w00 = last ? vn00 : va00, w01 = last ? vn01 : va01, w10 = last ? vn10 : va10, w11 = last ? vn11 : va11;
            G8_LDB(B0, 0, 0); G8_SCHED; G8_LDA(At, 0, 0); G8_STAGE(G8_SA(1, 1), a1, va10, va11);
            G8_WAIT_L(8); G8_BAR; G8_WAIT_L(0); G8_MMA(0, 0, At, B0); G8_BAR; G8_SCHED;
            G8_LDB(B1, 0, 1); G8_STAGE(G8_SB(0, 0), b2, voffB[0], voffB[1]);
            G8_BAR; G8_WAIT_L(0); G8_MMA(0, 1, At, B1); G8_BAR;
            G8_LDA(At, 0, 1); G8_STAGE(G8_SA(0, 0), a2, w00, w01);
            G8_BAR; G8_WAIT_L(0); G8_MMA(1, 0, At, B0); G8_BAR; G8_SCHED;
            G8_STAGE(G8_SB(0, 1), b2 + hstep, voffB[0], voffB[1]);
            G8_WAIT_V(6); G8_BAR; G8_MMA(1, 1, At, B1); G8_BAR;
            G8_LDB(B0, 1, 0); G8_SCHED; G8_LDA(At, 1, 0); G8_STAGE(G8_SA(0, 1), a2, w10, w11);
            G8_WAIT_L(8); G8_BAR; G8_WAIT_L(0); G8_MMA(0, 0, At, B0); G8_BAR; G8_SCHED;
            G8_LDB(B1, 1, 1); G8_STAGE(G8_SB(1, 0), b3, voffB[0], voffB[1]);
            G8_BAR; G8_WAIT_L(0); G8_MMA(0, 1, At, B1); G8_BAR;
            G8_LDA(At, 1, 1); G8_STAGE(G8_SA(1, 0), a3, w00, w01);
            G8_BAR; G8_WAIT_L(0); G8_MMA(1, 0, At, B0); G8_BAR; G8_SCHED;
            G8_STAGE(G8_SB(1, 1), b3 + hstep, voffB[0], voffB[1]);
            G8_WAIT_V(6); G8_BAR; G8_MMA(1, 1, At, B1); G8_BAR;
        }
        if constexpr (FP8) asm volatile("s_nop 15\n\ts_nop 15" ::: "memory");
        E(acc, cur, wr, wc, fr, fq);
        if (!has_next) break;
#pragma unroll
        for (int a = 0; a < 2; ++a)
#pragma unroll
            for (int b = 0; b < 2; ++b)
#pragma unroll
                for (int m = 0; m < 4; ++m)
#pragma unroll
                    for (int n = 0; n < 2; ++n) acc[a][b][m][n] = (f32x4){0.f, 0.f, 0.f, 0.f};
        cur = nxt; cB = nB; va00 = vn00; va01 = vn01; va10 = vn10; va11 = vn11; ++ui;
    }
    G8_WAIT_V(0);
    if (wr == 0) G8_BAR;
    G8_BAR;
#undef G8_SA
#undef G8_SB
#undef G8_STAGE
#undef G8_LDA
#undef G8_LDB
#undef G8_MMA
#undef G8_WAIT_V
#undef G8_WAIT_L
#undef G8_BAR
#undef G8_SCHED
}

struct DenseSched {
    const char* Bt; int K, nM, nN, nwg, G, c;
    __device__ void init(const void* Bt_, int M, int N, int K_, int G_, int c_) { Bt = (const char*)Bt_; K = K_; nM = M / BM; nN = N / BM; nwg = nM * nN; G = G_; c = c_; }
    __device__ bool next(int i, Unit& u) const {
        const long L = (long)i * G + c; if (L >= nwg) return false;
        int wgid = (int)L; { const int q = nwg / 8, r = nwg % 8, xcd = wgid % 8, off = wgid / 8; wgid = (xcd < r ? xcd * (q + 1) : r * (q + 1) + (xcd - r) * q) + off; }
        const int nig = 8 * nN, gid = wgid / nig, fm = gid * 8, gsz = (nM - fm) < 8 ? (nM - fm) : 8;
        u.pm = fm + ((wgid % nig) % gsz); u.pn = (wgid % nig) / gsz; u.g = 0; u.rowbase = (unsigned)u.pm * BM;
        u.B = Bt + (size_t)u.pn * BM * K * 2; return true;
    }
    __device__ __forceinline__ unsigned arow(const Unit& u, int r) const { return u.rowbase + (unsigned)r; }
};
struct Moe1Sched {
    const char* W; const int* rowmap; int G, c;
    __device__ bool next(int i, Unit& u) const {
        const long L = (long)i * G + c; if (L >= NEXP * 512) return false;
        const int e = (int)(L / 512), w = (int)(L % 512), cc = w % 256, r = w / 256, xcd = cc % 8, j = cc / 8;
        const int mt = xcd * 4 + (j & 3), nt_ = r * 8 + (j >> 2), b = mt >> 1;
        u.pm = mt & 1; u.pn = nt_; u.g = b * NEXP + e; u.rowbase = (unsigned)u.g * CAP + (unsigned)u.pm * BM;
        u.B = W + ((size_t)e * 2 * DFF + (size_t)nt_ * BM) * DM; return true;
    }
    __device__ __forceinline__ unsigned arow(const Unit& u, int r) const { return (unsigned)rowmap[u.rowbase + r]; }
};
struct Moe2Sched {
    const char* W; int G, c;
    __device__ bool next(int i, Unit& u) const {
        const long L = (long)i * G + c; if (L >= NEXP * 128) return false;
        const int e = (int)(L / 128), w = (int)(L % 128), xcd = w % 8, j = w / 8;
        const int mt = xcd * 4 + (j & 3), nt_ = j >> 2, b = mt >> 1;
        u.pm = mt & 1; u.pn = nt_; u.g = b * NEXP + e; u.rowbase = (unsigned)u.g * CAP + (unsigned)u.pm * BM;
        u.B = W + ((size_t)e * DM + (size_t)nt_ * BM) * DFF; return true;
    }
    __device__ __forceinline__ unsigned arow(const Unit& u, int r) const { return u.rowbase + (unsigned)r; }
};

typedef const f32x4 (&AccRef)[2][2][4][2];
struct EpiQKVG {
    static constexpr bool PERM = true;
    h16* qkvg; float* codes;
    __device__ __forceinline__ void operator()(AccRef acc, const Unit& u, int wr, int wc, int fr, int fq) const {
        const int row0 = u.pm * BM + wr * 64 + fr;
        if (u.pn < 6) {
#pragma unroll
            for (int ai = 0; ai < 2; ++ai)
#pragma unroll
                for (int m = 0; m < 4; ++m) { h16* rowp = qkvg + (size_t)(row0 + ai * HALF + m * 16) * 1536 + u.pn * BM + wc * 32 + 8 * fq;
#pragma unroll
                    for (int bj = 0; bj < 2; ++bj) { const f32x4 v0 = acc[ai][bj][m][0], v1 = acc[ai][bj][m][1];
                        u32x4 w; w.x = pack_h2(v0[0], v0[1]); w.y = pack_h2(v0[2], v0[3]); w.z = pack_h2(v1[0], v1[1]); w.w = pack_h2(v1[2], v1[3]);
                        *(u32x4*)(rowp + bj * HALF) = w; } }
        } else if (wc == 0) {
#pragma unroll
            for (int ai = 0; ai < 2; ++ai)
#pragma unroll
                for (int m = 0; m < 4; ++m) { float* rowp = codes + (size_t)(row0 + ai * HALF + m * 16) * 32 + 8 * fq;
                    *(f32x4*)(rowp) = acc[ai][0][m][0]; *(f32x4*)(rowp + 4) = acc[ai][0][m][1]; }
        }
    }
};
struct EpiH16 {
    static constexpr bool PERM = true;
    h16* C; int ldc;
    __device__ __forceinline__ void operator()(AccRef acc, const Unit& u, int wr, int wc, int fr, int fq) const {
        const int row0 = u.pm * BM + wr * 64 + fr;
#pragma unroll
        for (int ai = 0; ai < 2; ++ai)
#pragma unroll
            for (int m = 0; m < 4; ++m) { h16* rowp = C + (size_t)(row0 + ai * HALF + m * 16) * ldc + u.pn * BM + wc * 32 + 8 * fq;
#pragma unroll
                for (int bj = 0; bj < 2; ++bj) { const f32x4 v0 = acc[ai][bj][m][0], v1 = acc[ai][bj][m][1];
                    u32x4 w; w.x = pack_h2(v0[0], v0[1]); w.y = pack_h2(v0[2], v0[3]); w.z = pack_h2(v1[0], v1[1]); w.w = pack_h2(v1[2], v1[3]);
                    *(u32x4*)(rowp + bj * HALF) = w; } }
    }
};
struct EpiResid {
    static constexpr bool PERM = true;
    const float* X; h16* R;
    __device__ __forceinline__ void operator()(AccRef acc, const Unit& u, int wr, int wc, int fr, int fq) const {
        const int row0 = u.pm * BM + wr * 64 + fr, col0 = u.pn * BM + wc * 32 + 8 * fq;
#pragma unroll
        for (int ai = 0; ai < 2; ++ai)
#pragma unroll
            for (int m = 0; m < 4; ++m) { const size_t off = (size_t)(row0 + ai * HALF + m * 16) * DM + col0;
#pragma unroll
                for (int bj = 0; bj < 2; ++bj) { const f32x4 x0 = *(const f32x4*)(X + off + bj * HALF), x1 = *(const f32x4*)(X + off + bj * HALF + 4);
                    const f32x4 v0 = x0 + acc[ai][bj][m][0], v1 = x1 + acc[ai][bj][m][1];
                    u32x4 w; w.x = pack_h2(v0[0], v0[1]); w.y = pack_h2(v0[2], v0[3]); w.z = pack_h2(v1[0], v1[1]); w.w = pack_h2(v1[2], v1[3]);
                    *(u32x4*)(R + off + bj * HALF) = w; } }
    }
};
struct EpiHid {
    static constexpr bool PERM = true;
    unsigned char* hid;
    __device__ __forceinline__ void operator()(AccRef acc, const Unit& u, int wr, int wc, int fr, int fq) const {
        const unsigned row0 = u.rowbase + wr * 64 + fr;
#pragma unroll
        for (int ai = 0; ai < 2; ++ai)
#pragma unroll
            for (int m = 0; m < 4; ++m) { unsigned char* rowp = hid + (size_t)(row0 + ai * HALF + m * 16) * DFF + u.pn * HALF + wc * 32 + 8 * fq;
                constexpr float ws_ = 1.0f / (float)(1 << FP8_WSHIFT);
                const f32x4 g0 = acc[ai][0][m][0] * ws_, g1 = acc[ai][0][m][1] * ws_, u0 = acc[ai][1][m][0] * ws_, u1 = acc[ai][1][m][1] * ws_;
                u32x2 w; w.x = pack_fp8x4(siluf_(g0[0]) * u0[0], siluf_(g0[1]) * u0[1], siluf_(g0[2]) * u0[2], siluf_(g0[3]) * u0[3]);
                w.y = pack_fp8x4(siluf_(g1[0]) * u1[0], siluf_(g1[1]) * u1[1], siluf_(g1[2]) * u1[2], siluf_(g1[3]) * u1[3]);
                *(u32x2*)rowp = w; }
    }
};
constexpr float Y_SCALE = 8.0f;
struct EpiDown {
    static constexpr bool PERM = true;
    unsigned char* Y; const float* selgate;
    __device__ __forceinline__ void operator()(AccRef acc, const Unit& u, int wr, int wc, int fr, int fq) const {
        const unsigned row0 = u.rowbase + wr * 64 + fr;
#pragma unroll
        for (int ai = 0; ai < 2; ++ai)
#pragma unroll
            for (int m = 0; m < 4; ++m) { const unsigned sr = row0 + ai * HALF + m * 16; const float gt = selgate[sr] * (Y_SCALE / (float)(1 << FP8_WSHIFT));
                unsigned char* rowp = Y + (size_t)sr * DM + u.pn * BM + wc * 32 + 8 * fq;
#pragma unroll
                for (int bj = 0; bj < 2; ++bj) { const f32x4 v0 = acc[ai][bj][m][0] * gt, v1 = acc[ai][bj][m][1] * gt;
                    u32x2 w; w.x = pack_fp8x4(v0[0], v0[1], v0[2], v0[3]); w.y = pack_fp8x4(v1[0], v1[1], v1[2], v1[3]);
                    *(u32x2*)(rowp + bj * HALF) = w; } }
    }
};
struct EpiPle {
    static constexpr bool PERM = true;
    const h16* H3; const float* rstd3; const float* lnw; const h16* PP; h16* R3H; float* rowsq;
    __device__ __forceinline__ void operator()(AccRef acc, const Unit& u, int wr, int wc, int fr, int fq) const {
        const int row0 = u.pm * BM + wr * 64 + fr, col0 = u.pn * BM + wc * 32 + 8 * fq;
        f32x4 winv[2][2];
#pragma unroll
        for (int bj = 0; bj < 2; ++bj)
#pragma unroll
            for (int n = 0; n < 2; ++n) { const f32x4 wv = *(const f32x4*)(lnw + col0 + bj * HALF + n * 4);
#pragma unroll
                for (int j = 0; j < 4; ++j) winv[bj][n][j] = 1.0f / wv[j]; }
#pragma unroll
        for (int ai = 0; ai < 2; ++ai)
#pragma unroll
            for (int m = 0; m < 4; ++m) { const int row = row0 + ai * HALF + m * 16; const size_t off = (size_t)row * DM + col0;
                const float inv = 1.0f / rstd3[row]; float sq = 0.f;
#pragma unroll
                for (int bj = 0; bj < 2; ++bj) { const size_t o2 = off + bj * HALF; const h16x8 hv = *(const h16x8*)(H3 + o2), pv = *(const h16x8*)(PP + o2);
                    float o[8];
#pragma unroll
                    for (int n = 0; n < 2; ++n)
#pragma unroll
                        for (int j = 0; j < 4; ++j) { const float v = (float)hv[4 * n + j] * inv * winv[bj][n][j] + sigmoidf_(acc[ai][bj][m][n][j]) * (float)pv[4 * n + j]; o[4 * n + j] = v; sq += v * v; }
                    u32x4 w; w.x = pack_h2(o[0], o[1]); w.y = pack_h2(o[2], o[3]); w.z = pack_h2(o[4], o[5]); w.w = pack_h2(o[6], o[7]); *(u32x4*)(R3H + o2) = w; }
                sq += __shfl_xor(sq, 16); sq += __shfl_xor(sq, 32);
                if (fq == 0) unsafeAtomicAdd(rowsq + row, sq); }
    }
};
}

template <class ColPtr>
__device__ __forceinline__ void cvt_transpose(LAS unsigned char* lds, h16* dst, int N, int K, int src_ld, ColPtr cp, int blk, int nblk) {
    const int tid = threadIdx.x, w = tid >> 6, l = tid & 63, nq = tid & 31, kp = tid >> 5;
    const int ktiles = K / 256, ntiles = (N / 128) * ktiles;
    f32x4 va[8], vb[8];
    auto fetch = [&](int t) {
        const int n0 = (t / ktiles) * 128, k0 = (t % ktiles) * 256;
        const float* sp = cp(n0 + (nq >> 3) * 32);
#pragma unroll
        for (int ps = 0; ps < 8; ++ps) {
            const int kk = 2 * (kp + 16 * ps);
            if (sp) { va[ps] = *(const f32x4*)(sp + (size_t)(k0 + kk) * src_ld + ((4 * nq) & 31)); vb[ps] = *(const f32x4*)(sp + (size_t)(k0 + kk + 1) * src_ld + ((4 * nq) & 31)); }
            else { va[ps] = (f32x4){0.f, 0.f, 0.f, 0.f}; vb[ps] = va[ps]; }
        }
    };
    if (blk < ntiles) fetch(blk);
    for (int t = blk; t < ntiles; t += nblk) {
        const int n0 = (t / ktiles) * 128, k0 = (t % ktiles) * 256;
        __syncthreads();
        const int sv = (nq & 15) << 1;
#pragma unroll
        for (int ps = 0; ps < 8; ++ps) { const int d = kp + 16 * ps;
#pragma unroll
            for (int j = 0; j < 4; ++j) *(LAS unsigned*)(lds + (4 * nq + j) * 512 + ((d ^ sv) << 2)) = pack_h2(va[ps][j], vb[ps][j]); }
        if (t + nblk < ntiles) fetch(t + nblk);
        __syncthreads();
#pragma unroll 4
        for (int r = 0; r < 16; ++r) { const int row = w * 16 + r, rv = ((row >> 2) & 15) << 1;
            const u32x2 x = *(const LAS u32x2*)(lds + row * 512 + (((2 * l) ^ rv) << 2));
            *(u32x2*)(dst + (size_t)(n0 + row) * K + k0 + 4 * l) = x; }
    }
}

template <class ColPtr>
__device__ __forceinline__ void cvt_transpose_fp8(LAS unsigned char* lds, unsigned char* dst, int N, int K, int src_ld, float scale, ColPtr cp, int blk, int nblk) {
    const int tid = threadIdx.x, w = tid >> 6, l = tid & 63, nq = tid & 31, kq = tid >> 5;
    const int ktiles = K / 256, ntiles = (N / 128) * ktiles;
    f32x4 v[4][4];
    auto fetch = [&](int t) {
        const int n0 = (t / ktiles) * 128, k0 = (t % ktiles) * 256;
        const float* sp = cp(n0 + (nq >> 3) * 32);
#pragma unroll
        for (int ps = 0; ps < 4; ++ps)
#pragma unroll
            for (int q = 0; q < 4; ++q) v[ps][q] = *(const f32x4*)(sp + (size_t)(k0 + 4 * (kq + 16 * ps) + q) * src_ld + ((4 * nq) & 31));
    };
    if (blk < ntiles) fetch(blk);
    for (int t = blk; t < ntiles; t += nblk) {
        const int n0 = (t / ktiles) * 128, k0 = (t % ktiles) * 256;
        __syncthreads();
        const int sv = (nq & 15) << 1;
#pragma unroll
        for (int ps = 0; ps < 4; ++ps) { const int d = kq + 16 * ps;
#pragma unroll
            for (int j = 0; j < 4; ++j) *(LAS unsigned*)(lds + (4 * nq + j) * 256 + ((d ^ sv) << 2)) = pack_fp8x4(v[ps][0][j] * scale, v[ps][1][j] * scale, v[ps][2][j] * scale, v[ps][3][j] * scale); }
        if (t + nblk < ntiles) fetch(t + nblk);
        __syncthreads();
#pragma unroll 4
        for (int r = 0; r < 16; ++r) { const int row = w * 16 + r, rv = ((row >> 2) & 15) << 1;
            const unsigned x = *(const LAS unsigned*)(lds + row * 256 + ((l ^ rv) << 2));
            *(unsigned*)(dst + (size_t)(n0 + row) * K + k0 + 4 * l) = x; }
    }
}

__device__ __forceinline__ void prep_fp8_weights(const Args& a, LAS unsigned char* lds, int blk, int nblk) {
    unsigned char* ws = a.ws;
    const int tid = threadIdx.x, w = tid >> 6, l = tid & 63, nq = tid & 31, kq = tid >> 5;
    constexpr int NT = 2048 + 1024;
    const float scale = (float)(1 << FP8_WSHIFT);
    struct Tile { const float* sp; int src_ld; unsigned char* dst; int K; };
    auto decode = [&](int gt) -> Tile {
        Tile t;
        if (gt < 2048) { const int e = gt >> 7, r = gt & 127, n0 = (r >> 2) * 128, k0 = (r & 3) * 256, nb = n0 + (nq >> 3) * 32;
            const int tile = nb >> 8, within = nb & 255, f = tile * 128 + (within & 127);
            t.sp = ((within >> 7) ? a.in[I_WUP] : a.in[I_WGATE]) + (size_t)e * DM * DFF + f + (size_t)k0 * DFF; t.src_ld = DFF; t.K = DM;
            t.dst = ws + OFF_WGU + (size_t)e * 2 * DFF * DM + (size_t)n0 * DM + k0; }
        else { const int g2 = gt - 2048, e = g2 >> 6, r = g2 & 63, n0 = (r >> 3) * 128, k0 = (r & 7) * 256, nb = n0 + (nq >> 3) * 32;
            t.sp = a.in[I_WDOWN] + (size_t)e * DFF * DM + nb + (size_t)k0 * DM; t.src_ld = DM; t.K = DFF;
            t.dst = ws + OFF_WD + (size_t)e * DM * DFF + (size_t)n0 * DFF + k0; }
        return t;
    };
    f32x4 v[4][4];
    auto fetch = [&](const Tile& t) {
#pragma unroll
        for (int ps = 0; ps < 4; ++ps)
#pragma unroll
            for (int q = 0; q < 4; ++q) v[ps][q] = *(const f32x4*)(t.sp + (size_t)(4 * (kq + 16 * ps) + q) * t.src_ld + ((4 * nq) & 31));
    };
    Tile cur;
    if (blk < NT) { cur = decode(blk); fetch(cur); }
    for (int gt = blk; gt < NT; gt += nblk) {
        __syncthreads();
        const int sv = (nq & 15) << 1;
#pragma unroll
        for (int ps = 0; ps < 4; ++ps) { const int d = kq + 16 * ps;
#pragma unroll
            for (int j = 0; j < 4; ++j) *(LAS unsigned*)(lds + (4 * nq + j) * 256 + ((d ^ sv) << 2)) = pack_fp8x4(v[ps][0][j] * scale, v[ps][1][j] * scale, v[ps][2][j] * scale, v[ps][3][j] * scale); }
        unsigned char* dst = cur.dst; const int K = cur.K;
        if (gt + nblk < NT) { cur = decode(gt + nblk); fetch(cur); }
        __syncthreads();
#pragma unroll 4
        for (int r = 0; r < 16; ++r) { const int row = w * 16 + r, rv = ((row >> 2) & 15) << 1;
            const unsigned x = *(const LAS unsigned*)(lds + row * 256 + ((l ^ rv) << 2));
            *(unsigned*)(dst + (size_t)row * K + 4 * l) = x; }
    }
}

__device__ __forceinline__ void phase_prep(const Args& a, LAS unsigned char* lds, int blk, int nblk) {
    unsigned char* ws = a.ws;
    const int tid = threadIdx.x;
    if (blk == 0) { if (tid < 64) ((unsigned*)(ws + OFF_CTR))[tid] = 0u;
        for (int i = tid; i < 3456; i += NTHREADS) ((unsigned*)(ws + OFF_XBAR))[i] = 0u; }
    auto rot = [&](int off) { return (blk - off + 4 * nblk) % nblk; };
    { const float* w = a.in[I_WIN]; cvt_transpose(lds, (h16*)(ws + OFF_WINA), NA1, DM, INCOLS, [=](int n0) { return n0 < 1568 ? w + n0 : (const float*)nullptr; }, rot(0), nblk); }
    { const float* w = a.in[I_WIN]; cvt_transpose(lds, (h16*)(ws + OFF_WINHY), HYC, DM, INCOLS, [=](int n0) { return w + 1568 + n0; }, rot(56), nblk); }
    { const float* w = a.in[I_WOUT]; cvt_transpose(lds, (h16*)(ws + OFF_WOUT), DM, DM, DM, [=](int n0) { return w + n0; }, rot(104), nblk); }
    { const float* w = a.in[I_WPG]; cvt_transpose(lds, (h16*)(ws + OFF_WG), DM, DM, DM, [=](int n0) { return w + n0; }, rot(136), nblk); }
    { const float* w = a.in[I_WPP]; cvt_transpose(lds, (h16*)(ws + OFF_WP), DM, 256, DM, [=](int n0) { return w + n0; }, rot(168), nblk); }
    prep_fp8_weights(a, lds, blk, nblk);
    { const f32x4* p = (const f32x4*)a.in[I_P]; u32x2* d = (u32x2*)(ws + OFF_P16); const size_t n4 = (size_t)NTOK * 256 / 4;
        for (size_t i = (size_t)blk * NTHREADS + tid; i < n4; i += (size_t)nblk * NTHREADS) { const f32x4 v = p[i]; u32x2 o; o.x = pack_h2(v[0], v[1]); o.y = pack_h2(v[2], v[3]); d[i] = o; } }
}

__device__ __forceinline__ void phase_rmsnorm_h16(const float* X, const float* w, h16* H, int blk, int nblk) {
    constexpr int RP = 4;
    const int lane = threadIdx.x & 63, gw = blk * 8 + (threadIdx.x >> 6), nw = nblk * 8;
    f32x4 wv[4];
#pragma unroll
    for (int j = 0; j < 4; ++j) wv[j] = *(const f32x4*)(w + j * 256 + lane * 4);
    for (int row0 = gw * RP; row0 < NTOK; row0 += nw * RP) {
        f32x4 v[RP][4];
#pragma unroll
        for (int r = 0; r < RP; ++r)
#pragma unroll
            for (int j = 0; j < 4; ++j) v[r][j] = *(const f32x4*)(X + (size_t)(row0 + r) * DM + j * 256 + lane * 4);
#pragma unroll
        for (int r = 0; r < RP; ++r) {
            float ss = 0.f;
#pragma unroll
            for (int j = 0; j < 4; ++j) ss += v[r][j][0] * v[r][j][0] + v[r][j][1] * v[r][j][1] + v[r][j][2] * v[r][j][2] + v[r][j][3] * v[r][j][3];
            ss = wave_sum(ss);
            const float rstd = rsqrtf(ss * (1.0f / DM) + EPS);
            h16* hp = H + (size_t)(row0 + r) * DM;
#pragma unroll
            for (int j = 0; j < 4; ++j) { u32x2 o; o.x = pack_h2(v[r][j][0] * rstd * wv[j][0], v[r][j][1] * rstd * wv[j][1]); o.y = pack_h2(v[r][j][2] * rstd * wv[j][2], v[r][j][3] * rstd * wv[j][3]);
                *(u32x2*)(hp + j * 256 + lane * 4) = o; }
        }
    }
}

__device__ __forceinline__ void phase_combine_norm(const h16* R, const unsigned char* Y, const int* slotmap, const float* w, h16* H, float* rstd3, float* rowsq, int blk, int nblk) {
    constexpr int RP = 2;
    const int lane = threadIdx.x & 63, gw = blk * 8 + (threadIdx.x >> 6), nw = nblk * 8;
    f32x4 wv[4];
#pragma unroll
    for (int j = 0; j < 4; ++j) wv[j] = *(const f32x4*)(w + j * 256 + lane * 4);
    for (int row0 = gw * RP; row0 < NTOK; row0 += nw * RP) {
        f32x4 v[RP][4]; int myslot[RP];
#pragma unroll
        for (int r = 0; r < RP; ++r) {
            myslot[r] = (lane < NEXP) ? slotmap[(size_t)(row0 + r) * NEXP + lane] : -1;
#pragma unroll
            for (int j = 0; j < 4; ++j) { const h16x4 hv = *(const h16x4*)(R + (size_t)(row0 + r) * DM + j * 256 + lane * 4); v[r][j] = (f32x4){(float)hv[0], (float)hv[1], (float)hv[2], (float)hv[3]}; }
        }
#pragma unroll
        for (int r = 0; r < RP; ++r) {
            unsigned long long mask = __ballot(myslot[r] >= 0);
            const int b = (row0 + r) / SEQ;
            while (mask) {
                const int e = __builtin_ctzll(mask); mask &= mask - 1;
                const int sl = __shfl(myslot[r], e);
                const unsigned char* yp = Y + ((size_t)(b * NEXP + e) * CAP + sl) * DM;
                unsigned y4[4];
#pragma unroll
                for (int j = 0; j < 4; ++j) y4[j] = *(const unsigned*)(yp + j * 256 + lane * 4);
#pragma unroll
                for (int j = 0; j < 4; ++j) { const f32x2 lo = __builtin_amdgcn_cvt_pk_f32_fp8((int)y4[j], false), hi = __builtin_amdgcn_cvt_pk_f32_fp8((int)y4[j], true);
                    v[r][j][0] += lo[0] * (1.0f / g8::Y_SCALE); v[r][j][1] += lo[1] * (1.0f / g8::Y_SCALE); v[r][j][2] += hi[0] * (1.0f / g8::Y_SCALE); v[r][j][3] += hi[1] * (1.0f / g8::Y_SCALE); }
            }
        }
#pragma unroll
        for (int r = 0; r < RP; ++r) {
            float ss = 0.f;
#pragma unroll
            for (int j = 0; j < 4; ++j) { ss += v[r][j][0] * v[r][j][0] + v[r][j][1] * v[r][j][1] + v[r][j][2] * v[r][j][2] + v[r][j][3] * v[r][j][3]; }
            ss = wave_sum(ss);
            const float rstd = rsqrtf(ss * (1.0f / DM) + EPS);
            if (lane == 0) { rstd3[row0 + r] = rstd; rowsq[row0 + r] = 0.f; }
            h16* hp = H + (size_t)(row0 + r) * DM;
#pragma unroll
            for (int j = 0; j < 4; ++j) { u32x2 o; o.x = pack_h2(v[r][j][0] * rstd * wv[j][0], v[r][j][1] * rstd * wv[j][1]); o.y = pack_h2(v[r][j][2] * rstd * wv[j][2], v[r][j][3] * rstd * wv[j][3]);
                *(u32x2*)(hp + j * 256 + lane * 4) = o; }
        }
    }
}

__device__ __forceinline__ void phase_final_norm(const h16* R3H, const float* rowsq, const float* w, float* out, int blk, int nblk) {
    constexpr int RP = 4;
    const int lane = threadIdx.x & 63, gw = blk * 8 + (threadIdx.x >> 6), nw = nblk * 8;
    f32x4 wv[4];
#pragma unroll
    for (int j = 0; j < 4; ++j) wv[j] = *(const f32x4*)(w + j * 256 + lane * 4);
    for (int row0 = gw * RP; row0 < NTOK; row0 += nw * RP) {
        h16x4 v[RP][4]; float sq[RP];
#pragma unroll
        for (int r = 0; r < RP; ++r) { sq[r] = rowsq[row0 + r];
#pragma unroll
            for (int j = 0; j < 4; ++j) v[r][j] = *(const h16x4*)(R3H + (size_t)(row0 + r) * DM + j * 256 + lane * 4); }
#pragma unroll
        for (int r = 0; r < RP; ++r) {
            const float rstd = rsqrtf(sq[r] * (1.0f / DM) + EPS);
#pragma unroll
            for (int j = 0; j < 4; ++j) { f32x4 o;
#pragma unroll
                for (int q = 0; q < 4; ++q) o[q] = (float)v[r][j][q] * rstd * wv[j][q];
                *(f32x4*)(out + (size_t)(row0 + r) * DM + j * 256 + lane * 4) = o; }
        }
    }
}

__device__ __forceinline__ void phase_router(const h16* R, const float* w, const float* wrouter, unsigned char* H8, float* probs, LAS unsigned char* lds, int blk, int nblk) {
    constexpr int RP = 2;
    LAS float* wrT = (LAS float*)lds;
    const int tid = threadIdx.x, lane = tid & 63, gw = blk * 8 + (tid >> 6), nw = nblk * 8;
    __syncthreads();
    { float tmp[32];
#pragma unroll
        for (int q = 0; q < 32; ++q) { const int i = tid + NTHREADS * q, e = i >> 10, k = i & 1023; tmp[q] = wrouter[k * NEXP + e]; }
#pragma unroll
        for (int q = 0; q < 32; ++q) wrT[tid + NTHREADS * q] = tmp[q]; }
    __syncthreads();
    f32x4 wv[4];
#pragma unroll
    for (int j = 0; j < 4; ++j) wv[j] = *(const f32x4*)(w + j * 256 + lane * 4);
    const bool b5 = lane & 32, b4 = lane & 16, b3 = lane & 8, b2 = lane & 4;
    const int mye = (b5 ? 8 : 0) + (b4 ? 4 : 0) + (b3 ? 2 : 0) + (b2 ? 1 : 0);
    for (int row0 = gw * RP; row0 < NTOK; row0 += nw * RP) {
        f32x4 v[RP][4];
#pragma unroll
        for (int r = 0; r < RP; ++r)
#pragma unroll
            for (int j = 0; j < 4; ++j) { const h16x4 hv = *(const h16x4*)(R + (size_t)(row0 + r) * DM + j * 256 + lane * 4); v[r][j] = (f32x4){(float)hv[0], (float)hv[1], (float)hv[2], (float)hv[3]}; }
#pragma unroll
        for (int r = 0; r < RP; ++r) {
            float ss = 0.f;
#pragma unroll
            for (int j = 0; j < 4; ++j) ss += v[r][j][0] * v[r][j][0] + v[r][j][1] * v[r][j][1] + v[r][j][2] * v[r][j][2] + v[r][j][3] * v[r][j][3];
            ss = wave_sum(ss);
            const float rstd = rsqrtf(ss * (1.0f / DM) + EPS);
            unsigned char* hp = H8 + (size_t)(row0 + r) * DM;
#pragma unroll
            for (int j = 0; j < 4; ++j) { v[r][j] = v[r][j] * rstd * wv[j]; *(unsigned*)(hp + j * 256 + lane * 4) = pack_fp8x4(v[r][j][0], v[r][j][1], v[r][j][2], v[r][j][3]); }
        }
        float s8a[RP][8];
#pragma unroll
        for (int i = 0; i < 8; ++i) { asm volatile("" ::: "memory");
            f32x4 wa4[4], wb4[4];
#pragma unroll
            for (int j = 0; j < 4; ++j) { wa4[j] = *(const LAS f32x4*)(wrT + i * DM + j * 256 + lane * 4); wb4[j] = *(const LAS f32x4*)(wrT + (i + 8) * DM + j * 256 + lane * 4); }
#pragma unroll
            for (int r = 0; r < RP; ++r) { float sa = 0.f, sb = 0.f;
#pragma unroll
                for (int j = 0; j < 4; ++j) { sa += v[r][j][0] * wa4[j][0] + v[r][j][1] * wa4[j][1] + v[r][j][2] * wa4[j][2] + v[r][j][3] * wa4[j][3];
                                              sb += v[r][j][0] * wb4[j][0] + v[r][j][1] * wb4[j][1] + v[r][j][2] * wb4[j][2] + v[r][j][3] * wb4[j][3]; }
                const float send = b5 ? sa : sb, keep = b5 ? sb : sa; s8a[r][i] = keep + __shfl_xor(send, 32); } }
#pragma unroll
        for (int r = 0; r < RP; ++r) {
            float s8[8], s4[4], s2[2], lg;
#pragma unroll
            for (int i = 0; i < 8; ++i) s8[i] = s8a[r][i];
#pragma unroll
            for (int i = 0; i < 4; ++i) { const float send = b4 ? s8[i] : s8[i + 4], keep = b4 ? s8[i + 4] : s8[i]; s4[i] = keep + __shfl_xor(send, 16); }
#pragma unroll
            for (int i = 0; i < 2; ++i) { const float send = b3 ? s4[i] : s4[i + 2], keep = b3 ? s4[i + 2] : s4[i]; s2[i] = keep + __shfl_xor(send, 8); }
            { const float send = b2 ? s2[0] : s2[1], keep = b2 ? s2[1] : s2[0]; lg = keep + __shfl_xor(send, 4); }
            lg += __shfl_xor(lg, 1); lg += __shfl_xor(lg, 2);
            float mx = lg;
#pragma unroll
            for (int o = 4; o <= 32; o <<= 1) mx = fmaxf(mx, __shfl_xor(mx, o));
            const float ex = expf(lg - mx); float den = ex;
#pragma unroll
            for (int o = 4; o <= 32; o <<= 1) den += __shfl_xor(den, o);
            if ((lane & 3) == 0) { const int row = row0 + r, b = row / SEQ, t = row % SEQ; probs[((size_t)b * NEXP + mye) * SEQ + t] = ex / den; }
        }
    }
}

__device__ __forceinline__ void phase_topk(const float* probs, int* selidx, float* selgate, int* slotmap, LAS unsigned char* lds, int blk, int nblk) {
    LAS int* hist = (LAS int*)lds;
    LAS int* red = hist + 256;
    const int tid = threadIdx.x, lane = tid & 63, wid = tid >> 6;
    for (int g = blk; g < NB * NEXP; g += nblk) {
        const float* pp = probs + (size_t)g * SEQ;
        unsigned key[8]; float pv[8];
        { const f32x4 a = *(const f32x4*)(pp + tid * 8), b = *(const f32x4*)(pp + tid * 8 + 4);
#pragma unroll
          for (int j = 0; j < 4; ++j) { pv[j] = a[j]; pv[4 + j] = b[j]; }
#pragma unroll
          for (int j = 0; j < 8; ++j) key[j] = __float_as_uint(pv[j]); }
        unsigned prefix = 0; int krem = CAP;
#pragma unroll 1
        for (int ps = 0; ps < 4; ++ps) {
            const int shift = ps == 0 ? 23 : ps == 1 ? 15 : ps == 2 ? 7 : 0, bits = ps == 3 ? 7 : 8;
            const unsigned mhi = ~((1u << (shift + bits)) - 1u), dmask = (1u << bits) - 1u;
            __syncthreads();
            if (tid < 256) hist[tid] = 0;
            __syncthreads();
#pragma unroll
            for (int j = 0; j < 8; ++j) if ((key[j] & mhi) == (prefix & mhi)) __hip_atomic_fetch_add(hist + ((key[j] >> shift) & dmask), 1, __ATOMIC_RELAXED, __HIP_MEMORY_SCOPE_WORKGROUP);
            __syncthreads();
            if (wid == 0) {
                int c[4], tot = 0;
#pragma unroll
                for (int q = 0; q < 4; ++q) { c[q] = hist[4 * lane + q]; tot += c[q]; }
                int S = tot;
#pragma unroll
                for (int o = 1; o < 64; o <<= 1) { const int t = __shfl_down(S, o); if (lane + o < 64) S += t; }
                const int above = S - tot;
                if (above < krem && krem <= S) {
                    int acc = above, dsel = 4 * lane, kn = krem; bool done = false;
#pragma unroll
                    for (int q = 3; q >= 0; --q) { if (!done && acc + c[q] >= krem) { dsel = 4 * lane + q; kn = krem - acc; done = true; } if (!done) acc += c[q]; }
                    red[0] = dsel; red[1] = kn;
                }
            }
            __syncthreads();
            prefix |= (unsigned)red[0] << shift; krem = red[1];
        }
        int cgt = 0, ceq = 0;
#pragma unroll
        for (int j = 0; j < 8; ++j) { cgt += (key[j] > prefix) ? 1 : 0; ceq += (key[j] == prefix) ? 1 : 0; }
        int sg = cgt, se = ceq;
#pragma unroll
        for (int o = 1; o < 64; o <<= 1) { const int a = __shfl_up(sg, o), b = __shfl_up(se, o); if (lane >= o) { sg += a; se += b; } }
        __syncthreads();
        if (lane == 63) { red[32 + wid] = sg; red[48 + wid] = se; }
        __syncthreads();
        int bg = 0, be = 0;
#pragma unroll
        for (int w = 0; w < 8; ++w) { const int x = red[32 + w], y = red[48 + w]; if (w < wid) { bg += x; be += y; } }
        int pg = bg + sg - cgt, pe = be + se - ceq;
        const int need = krem;
#pragma unroll
        for (int j = 0; j < 8; ++j) {
            const bool gt = key[j] > prefix, eq = key[j] == prefix;
            const bool take = gt || (eq && pe < need);
            const int slot = pg + (pe < need ? pe : need);
            if (take) { selidx[(size_t)g * CAP + slot] = (g / NEXP) * SEQ + tid * 8 + j; selgate[(size_t)g * CAP + slot] = pv[j]; }
            slotmap[((size_t)(g / NEXP) * SEQ + tid * 8 + j) * NEXP + (g % NEXP)] = take ? slot : -1;
            pg += gt ? 1 : 0; pe += eq ? 1 : 0;
        }
    }
}

struct __attribute__((packed, aligned(2))) H8U { h16 v[8]; };
__device__ __forceinline__ void phase_filters(const Args& a, h16* GR, LAS unsigned char* lds, int blk, int nblk) {
    constexpr int NP = 16;
    LAS float* z = (LAS float*)lds;
    LAS float* h1 = z + NP * 32;
    LAS float* h2 = h1 + NP * 64;
    const int tid = threadIdx.x;
    const float* w1 = a.in[I_FW1]; const float* b1 = a.in[I_FB1]; const float* fr1 = a.in[I_FFR1];
    const float* w2 = a.in[I_FW2]; const float* b2 = a.in[I_FB2]; const float* fr2 = a.in[I_FFR2];
    const float* w3 = a.in[I_FW3]; const float* hb = a.in[I_HBIAS];
    const float MIND = logf(1e-2f) / 1.5f, MAXD = logf(1e-2f) / 0.3f;
    for (int it = blk; it < SEQ / NP; it += nblk) {
        const int t0 = it * NP;
        __syncthreads();
        if (tid < NP * 17) { const int pos = tid / 17, i = tid % 17, t = t0 + pos; float v;
            if (i == 0) v = (float)t / (float)(SEQ - 1);
            else { const int bi = (i - 1) & 7; const float f = 1e-4f + (float)bi * ((7.0f - 1e-4f) / 7.0f); const float wp = 6.283185307179586f * (float)t / (float)SEQ; const float ang = f * wp;
                float sn, cs; sincos_f(ang, sn, cs); v = (i <= 8) ? cs : -sn; }
            z[pos * 32 + i] = v; }
        __syncthreads();
#pragma unroll
        for (int hf = 0; hf < NP / 8; ++hf) { const int pos = hf * 8 + (tid >> 6), j = tid & 63; float s = b1[j];
#pragma unroll
            for (int i = 0; i < 17; ++i) s += z[pos * 32 + i] * w1[i * 64 + j];
            h1[pos * 64 + j] = sin_f(fr1[j] * s); }
        __syncthreads();
#pragma unroll
        for (int hf = 0; hf < NP / 8; ++hf) { const int pos = hf * 8 + (tid >> 6), j = tid & 63; float s = b2[j];
#pragma unroll 16
            for (int i = 0; i < 64; ++i) s += h1[pos * 64 + i] * w2[i * 64 + j];
            h2[j * NP + pos] = sin_f(fr2[j] * s); }
        __syncthreads();
#pragma unroll 1
        for (int q = 0; q < 4; ++q) {
            const int col = q * 512 + tid; float acc[NP];
#pragma unroll
            for (int p = 0; p < NP; ++p) acc[p] = 0.f;
#pragma unroll 16
            for (int j = 0; j < 64; ++j) { const float wv = w3[j * 2048 + col];
#pragma unroll
                for (int p4 = 0; p4 < NP / 4; ++p4) { const f32x4 hv = *(const LAS f32x4*)(h2 + j * NP + p4 * 4);
#pragma unroll
                    for (int p = 0; p < 4; ++p) acc[p4 * 4 + p] += hv[p] * wv; } }
            const int o = col >> 10, dir = (col >> 9) & 1, c = col & 511;
            const float delta = fabsf(MIND + (float)c * ((MAXD - MIND) / 511.0f));
            h16* gp = GR + ((size_t)o * HYW + c) * 8192;
            float vals[NP];
#pragma unroll
            for (int p = 0; p < NP; ++p) { const int t = t0 + p; const float tl = (float)t / (float)(SEQ - 1); float v = acc[p] * expf(-tl * delta);
                if (dir == 0 && t == 0) v += hb[o * HYW + c];
                vals[p] = v * HY_SCALE; }
            if (dir == 0) {
                h16x8 lo, hi;
#pragma unroll
                for (int q = 0; q < 8; ++q) { lo[q] = (h16)vals[15 - q]; hi[q] = (h16)vals[7 - q]; }
                *(h16x8*)(gp + 4080 - t0) = lo; *(h16x8*)(gp + 4088 - t0) = hi;
            } else {
                H8U lo, hi;
#pragma unroll
                for (int q = 0; q < 8; ++q) { lo.v[q] = (h16)vals[q]; hi.v[q] = (h16)vals[8 + q]; }
                if (t0 == 0) {
#pragma unroll
                    for (int q = 1; q < 8; ++q) gp[4095 + q] = lo.v[q];
                    gp[8191] = (h16)0.f;
                } else *(H8U*)(gp + 4095 + t0) = lo;
                *(H8U*)(gp + 4095 + t0 + 8) = hi;
            }
        }
    }
}

constexpr int HY_ROW = 8192, HY_UIMG = 16 * HY_ROW, HY_RING = 24;
__device__ __forceinline__ int hy_uoff(int b, int s) { return b * HY_ROW + ((((s >> 3) ^ b) << 4) | ((s & 7) << 1)); }
#define HY_MFMA(acc_, a_, b_) asm volatile("v_mfma_f32_16x16x32_f16 %0, %1, %2, %0" : "+v"(acc_) : "v"(a_), "v"(b_))
__device__ __forceinline__ void phase_hyena(const h16* __restrict__ hy, h16* __restrict__ z2, const h16* __restrict__ gr, const float* __restrict__ cw, const float* __restrict__ cb, unsigned* __restrict__ queue0, LAS unsigned char* lds, int reps) {
    const int tid = threadIdx.x, w = __builtin_amdgcn_readfirstlane(tid >> 6), l = tid & 63, bcol = l & 15, kg = l >> 4;
    LAS unsigned char* uimg = lds; LAS unsigned char* ring = lds + HY_UIMG;
    LAS int* qslot = (LAS int*)(lds + HY_UIMG + HY_RING * 1024);
    const int lbase = 4095 - (l & 15) + 8 * (l >> 4);
#pragma unroll 1
    for (int rep = 0; rep < reps; ++rep) {
    unsigned* queue = queue0 + rep;
    for (;;) {
        __syncthreads();
        if (tid == 0) *qslot = (int)atomicAdd(queue, 1u);
        __syncthreads();
        const int c = *qslot;
        if (c >= HYW) break;
        { const float w0 = cw[c], w1 = cw[HYC + c], w2 = cw[2 * HYC + c], bb = cb[c]; const int t0 = tid * 8;
#pragma unroll 8
            for (int b = 0; b < NB; ++b) {
                const h16* src = hy + (size_t)c * NTOK + (size_t)b * SEQ;
                const h16x8 rv = *(const h16x8*)(src + t0);
                const float rm = (t0 > 0) ? (float)src[t0 - 1] : 0.f, rp = (t0 + 8 < SEQ) ? (float)src[t0 + 8] : 0.f;
                float r[10]; r[0] = rm; r[9] = rp;
#pragma unroll
                for (int j = 0; j < 8; ++j) r[1 + j] = (float)rv[j];
                h16x8 o;
#pragma unroll
                for (int j = 0; j < 8; ++j) o[j] = (h16)(bb + w0 * r[j] + w1 * r[j + 1] + w2 * r[j + 2]);
                *(LAS h16x8*)(uimg + b * HY_ROW + ((tid ^ b) << 4)) = o;
            } }
#pragma unroll 1
        for (int o = 0; o < 2; ++o) {
            const h16* grp = gr + ((size_t)o * HYW + c) * 8192;
            f32x4 acc[8][4];
#pragma unroll
            for (int i = 0; i < 8; ++i)
#pragma unroll
                for (int m = 0; m < 4; ++m) acc[i][m] = (f32x4){0.f, 0.f, 0.f, 0.f};
            { const int phi = -256 + w; if (phi >= -254) { const H8U v0 = *(const H8U*)(grp + lbase - 16 * phi); *(LAS h16x8*)(ring + ((phi + 264) % HY_RING) * 1024 + l * 16) = __builtin_bit_cast(h16x8, v0); } }
            h16x8 fragA = __builtin_bit_cast(h16x8, *(const H8U*)(grp + lbase - 16 * (-248 + w))), fragB = {};
            __syncthreads();
#define HY_STEP(st_, fcur_, fnext_) do { \
                const int d0 = -64 + 2 * (st_); \
                if ((st_) < 62) fnext_ = __builtin_bit_cast(h16x8, *(const H8U*)(grp + lbase - 16 * (4 * (d0 + 4) + w))); \
                const int sbase = (4 * d0 - 2 + 264) % HY_RING; \
                _Pragma("unroll") for (int dd = 0; dd < 2; ++dd) { \
                    const int delta = d0 + dd; \
                    if (delta >= -63) { \
                        h16x8 A6[6]; \
                        _Pragma("unroll") for (int q = 0; q < 6; ++q) { int sl = sbase + 4 * dd + q; sl = sl >= HY_RING ? sl - HY_RING : sl; A6[q] = *(const LAS h16x8*)(ring + sl * 1024 + l * 16); } \
                        _Pragma("unroll") for (int i = 0; i < 8; ++i) { \
                            const int s1 = w + 8 * i - delta; \
                            if ((unsigned)s1 < 64u) { \
                                const int ch = 8 * s1 + kg; \
                                const h16x8 B0 = *(const LAS h16x8*)(uimg + bcol * HY_ROW + ((ch ^ bcol) << 4)), B1 = *(const LAS h16x8*)(uimg + bcol * HY_ROW + (((ch + 4) ^ bcol) << 4)); \
                                __builtin_amdgcn_s_setprio(1); \
                                _Pragma("unroll") for (int m = 0; m < 4; ++m) { HY_MFMA(acc[i][m], A6[m + 2], B0); HY_MFMA(acc[i][m], A6[m], B1); } \
                                __builtin_amdgcn_s_setprio(0); \
                            } } } } \
                if ((st_) < 63) *(LAS h16x8*)(ring + ((4 * (d0 + 2) + w + 264) % HY_RING) * 1024 + l * 16) = fcur_; \
                asm volatile("s_waitcnt lgkmcnt(0)" ::: "memory"); __builtin_amdgcn_s_barrier(); asm volatile("" ::: "memory"); \
            } while (0)
#pragma unroll 1
            for (int st = 0; st < 64; st += 2) { HY_STEP(st, fragA, fragB); HY_STEP(st + 1, fragB, fragA); }
#undef HY_STEP
            asm volatile("s_nop 15\n\ts_nop 15" ::: "memory");
            const int ch = (o + 1) * HYW + c;
            const float w0 = cw[ch], w1 = cw[HYC + ch], w2 = cw[2 * HYC + ch], bb = cb[ch];
            int kg_e = kg, bcol_e = bcol; asm volatile("" : "+v"(kg_e), "+v"(bcol_e));
            const h16* xsrc = hy + (size_t)ch * NTOK + (size_t)bcol_e * SEQ;
#pragma unroll
            for (int ih = 0; ih < 4; ++ih) {
                h16x4 xv[2][4]; h16 xm[2][4], xp[2][4];
#pragma unroll
                for (int ii = 0; ii < 2; ++ii)
#pragma unroll
                    for (int m = 0; m < 4; ++m) {
                        const int t = 64 * (w + 8 * (2 * ih + ii)) + 16 * m + 4 * kg_e;
                        xv[ii][m] = *(const h16x4*)(xsrc + t);
                        xm[ii][m] = (t > 0) ? xsrc[t - 1] : (h16)0.f; xp[ii][m] = (t + 4 < SEQ) ? xsrc[t + 4] : (h16)0.f;
                    }
#pragma unroll
                for (int ii = 0; ii < 2; ++ii)
#pragma unroll
                    for (int m = 0; m < 4; ++m) {
                        const int i = 2 * ih + ii;
                        const int t = 64 * (w + 8 * i) + 16 * m + 4 * kg_e;
                        float r[6]; r[0] = (float)xm[ii][m]; r[5] = (float)xp[ii][m];
#pragma unroll
                        for (int jj = 0; jj < 4; ++jj) r[1 + jj] = (float)xv[ii][m][jj];
                        h16x4 zo;
#pragma unroll
                        for (int jj = 0; jj < 4; ++jj) zo[jj] = (h16)((bb + w0 * r[jj] + w1 * r[jj + 1] + w2 * r[jj + 2]) * acc[i][m][jj] * (1.0f / HY_SCALE));
                        if (o == 0) *(LAS h16x4*)(uimg + hy_uoff(bcol_e, t)) = zo;
                        else *(h16x4*)(z2 + (size_t)c * NTOK + (size_t)bcol_e * SEQ + t) = zo;
                    }
                asm volatile("" ::: "memory");
            }
        }
    }
}
}

__device__ __forceinline__ float wave_incl_scan(float x) {
#define DPP_ADD(ctrl, rmask, bctl) x += __builtin_bit_cast(float, __builtin_amdgcn_update_dpp(0, __builtin_bit_cast(int, x), ctrl, rmask, 0xf, bctl))
    DPP_ADD(0x111, 0xf, true);
    DPP_ADD(0x112, 0xf, true);
    DPP_ADD(0x114, 0xf, true);
    DPP_ADD(0x118, 0xf, true);
    DPP_ADD(0x142, 0xa, false);
    DPP_ADD(0x143, 0xc, false);
#undef DPP_ADD
    return x;
}

constexpr int GL_QD = 0, GL_KI = 8192, GL_KDT = 16384, GL_P = 24576, GL_VT = 32768, GL_EDL = 49152, GL_WA = 49408, GL_BA = 53504, GL_QS = 54272, GL_KS = 62464, GL_VS = 70656, GL_CS = 87040;
__device__ __forceinline__ int gsw(int row, int col) { return row * 128 + ((((col >> 3) ^ (row & 7)) << 4) | ((col & 7) << 1)); }
#define GLA_BAR() do { asm volatile("s_waitcnt lgkmcnt(0)" ::: "memory"); __builtin_amdgcn_s_barrier(); asm volatile("" ::: "memory"); } while (0)
__device__ __forceinline__ void phase_gla(const h16* __restrict__ qkvg, const float* __restrict__ codes, const float* __restrict__ waf, const float* __restrict__ baf,
                          const float* __restrict__ wab, const float* __restrict__ bab, h16* __restrict__ of, h16* __restrict__ ob, LAS unsigned char* lds, int first, int stride, int reps) {
    const int tid = threadIdx.x, w = __builtin_amdgcn_readfirstlane(tid >> 6), l = tid & 63, m16 = l & 15, kg = l >> 4;
    LAS float* EDL = (LAS float*)(lds + GL_EDL); LAS float* WA = (LAS float*)(lds + GL_WA); LAS float* BA = (LAS float*)(lds + GL_BA);
    for (int item = first; item < NB * 8 * reps; item += stride) {
        const int b = (item >> 3) % NB, h = (item >> 1) & 3, dir = item & 1;
        const float* wa = dir ? wab : waf; const float* ba = dir ? bab : baf; h16* O = dir ? ob : of;
        __syncthreads();
        for (int i = tid; i < 16 * 64; i += NTHREADS) WA[i] = wa[(i >> 6) * 256 + h * 64 + (i & 63)];
        if (tid < 64) BA[tid] = ba[h * 64 + tid];
        f32x4 S[4];
#pragma unroll
        for (int m = 0; m < 4; ++m) S[m] = (f32x4){0.f, 0.f, 0.f, 0.f};
        h16x8 pq, pk, pv0, pv1; f32x4 pc;
#define GLA_ROW(n_, c_) ((size_t)b * SEQ + (dir ? (SEQ - 1 - (64 * (n_) + (c_))) : (64 * (n_) + (c_))))
#define GLA_FETCH(n_) do { const size_t rq_ = GLA_ROW(n_, tid >> 3); pq = *(const h16x8*)(qkvg + rq_ * 1536 + h * 64 + (tid & 7) * 8); pk = *(const h16x8*)(qkvg + rq_ * 1536 + 256 + h * 64 + (tid & 7) * 8); \
            const size_t rv0_ = GLA_ROW(n_, tid >> 4), rv1_ = GLA_ROW(n_, 32 + (tid >> 4)); pv0 = *(const h16x8*)(qkvg + rv0_ * 1536 + 512 + h * 128 + (tid & 15) * 8); pv1 = *(const h16x8*)(qkvg + rv1_ * 1536 + 512 + h * 128 + (tid & 15) * 8); \
            if (tid < 256) pc = *(const f32x4*)(codes + GLA_ROW(n_, tid >> 2) * 32 + dir * 16 + (tid & 3) * 4); } while (0)
#define GLA_PARK() do { { const int t_ = tid >> 3, p_ = tid & 7; *(LAS h16x8*)(lds + GL_QS + t_ * 128 + ((p_ ^ (t_ & 7)) << 4)) = pq; *(LAS h16x8*)(lds + GL_KS + t_ * 128 + ((p_ ^ (t_ & 7)) << 4)) = pk; } \
            { const int t0_ = tid >> 4, t1_ = 32 + (tid >> 4), p_ = tid & 15; *(LAS h16x8*)(lds + GL_VS + t0_ * 256 + ((p_ ^ ((t0_ & 7) << 1)) << 4)) = pv0; *(LAS h16x8*)(lds + GL_VS + t1_ * 256 + ((p_ ^ ((t1_ & 7) << 1)) << 4)) = pv1; } \
            if (tid < 256) *(LAS f32x4*)(lds + GL_CS + (tid >> 2) * 80 + (tid & 3) * 16) = pc; } while (0)
        GLA_FETCH(0);
        GLA_PARK();
        GLA_FETCH(1);
#pragma unroll 1
        for (int n = 0; n < SEQ / 64; ++n) {
            GLA_BAR();
            {
                const h16x8 cq = *(const LAS h16x8*)(lds + GL_QS + l * 128 + ((w ^ (l & 7)) << 4)), ck = *(const LAS h16x8*)(lds + GL_KS + l * 128 + ((w ^ (l & 7)) << 4));
                const h16x8 cv0 = *(const LAS h16x8*)(lds + GL_VS + l * 256 + (((2 * w) ^ ((l & 7) << 1)) << 4)), cv1 = *(const LAS h16x8*)(lds + GL_VS + l * 256 + (((2 * w + 1) ^ ((l & 7) << 1)) << 4));
                f32x4 cc[4];
#pragma unroll
                for (int r = 0; r < 4; ++r) cc[r] = *(const LAS f32x4*)(lds + GL_CS + l * 80 + r * 16);
                float z[8];
                { const f32x4 b0 = *(const LAS f32x4*)(BA + 8 * w), b1 = *(const LAS f32x4*)(BA + 8 * w + 4);
#pragma unroll
                  for (int j = 0; j < 4; ++j) { z[j] = b0[j]; z[4 + j] = b1[j]; } }
#pragma unroll
                for (int r = 0; r < 16; ++r) { const float cr = cc[r >> 2][r & 3]; const f32x4 w0 = *(const LAS f32x4*)(WA + r * 64 + 8 * w), w1 = *(const LAS f32x4*)(WA + r * 64 + 8 * w + 4);
#pragma unroll
                    for (int j = 0; j < 4; ++j) { z[j] += cr * w0[j]; z[4 + j] += cr * w1[j]; } }
                h16x8 qd, ki, kd; float edl[8];
#pragma unroll
                for (int j = 0; j < 8; ++j) {
                    const float ls = fminf(z[j], 0.f) - __logf(1.0f + __expf(-fabsf(z[j])));
                    float bb = ls * (1.0f / 16.0f);
                    bb = wave_incl_scan(bb);
                    const float bl = __builtin_bit_cast(float, __builtin_amdgcn_readlane(__builtin_bit_cast(int, bb), 63));
                    const float E = __expf(bb), Ei = 1.0f / E, el = __expf(bl);
                    edl[j] = el;
                    qd[j] = (h16)((float)cq[j] * 0.125f * E); const float kiv = (float)ck[j] * Ei; ki[j] = (h16)kiv; kd[j] = (h16)(kiv * el);
                }
                *(LAS h16x8*)(lds + GL_QD + l * 128 + ((w ^ (l & 7)) << 4)) = qd;
                *(LAS h16x8*)(lds + GL_KI + l * 128 + ((w ^ (l & 7)) << 4)) = ki;
#pragma unroll
                for (int j = 0; j < 8; ++j) *(LAS h16*)(lds + GL_KDT + gsw(8 * w + j, l)) = kd[j];
#pragma unroll
                for (int j = 0; j < 8; ++j) { *(LAS h16*)(lds + GL_VT + gsw(16 * w + j, l)) = cv0[j]; *(LAS h16*)(lds + GL_VT + gsw(16 * w + 8 + j, l)) = cv1[j]; }
                if (l == 0) {
#pragma unroll
                    for (int j = 0; j < 8; ++j) EDL[8 * w + j] = edl[j]; }
            }
            GLA_BAR();
            {
                const int mi = w & 3;
                h16x8 Aq[2];
                Aq[0] = *(const LAS h16x8*)(lds + GL_QD + gsw(16 * mi + m16, 8 * kg)); Aq[1] = *(const LAS h16x8*)(lds + GL_QD + gsw(16 * mi + m16, 32 + 8 * kg));
#pragma unroll
                for (int q = 0; q < 2; ++q) {
                    const int nj = 2 * (w >> 2) + q;
                    if (nj <= mi) {
                        const h16x8 B0 = *(const LAS h16x8*)(lds + GL_KI + gsw(16 * nj + m16, 8 * kg)), B1 = *(const LAS h16x8*)(lds + GL_KI + gsw(16 * nj + m16, 32 + 8 * kg));
                        f32x4 p = (f32x4){0.f, 0.f, 0.f, 0.f};
                        p = __builtin_amdgcn_mfma_f32_16x16x32_f16(Aq[0], B0, p, 0, 0, 0);
                        p = __builtin_amdgcn_mfma_f32_16x16x32_f16(Aq[1], B1, p, 0, 0, 0);
#pragma unroll
                        for (int r = 0; r < 4; ++r) { const int c = 16 * mi + 4 * kg + r, cp = 16 * nj + m16; const bool keep = dir ? (cp < c) : (cp <= c);
                            *(LAS h16*)(lds + GL_P + gsw(c, cp)) = (h16)(keep ? p[r] : 0.f); }
                    } else if ((nj >> 1) == (mi >> 1)) {
#pragma unroll
                        for (int r = 0; r < 4; ++r) *(LAS h16*)(lds + GL_P + gsw(16 * mi + 4 * kg + r, 16 * nj + m16)) = (h16)0.f;
                    }
                }
            }
            GLA_BAR();
            {
                h16x8 Bv[2];
                Bv[0] = *(const LAS h16x8*)(lds + GL_VT + gsw(16 * w + m16, 8 * kg)); Bv[1] = *(const LAS h16x8*)(lds + GL_VT + gsw(16 * w + m16, 32 + 8 * kg));
                h16x8 Sf[2];
#pragma unroll
                for (int ks = 0; ks < 2; ++ks)
#pragma unroll
                    for (int j = 0; j < 4; ++j) { Sf[ks][j] = (h16)S[2 * ks][j]; Sf[ks][4 + j] = (h16)S[2 * ks + 1][j]; }
#pragma unroll
                for (int mi = 0; mi < 4; ++mi) {
                    f32x4 o = (f32x4){0.f, 0.f, 0.f, 0.f};
#pragma unroll
                    for (int ks = 0; ks < 2; ++ks) {
                        if (!(ks == 1 && mi < 2)) { const h16x8 Ap = *(const LAS h16x8*)(lds + GL_P + gsw(16 * mi + m16, 32 * ks + 8 * kg)); o = __builtin_amdgcn_mfma_f32_16x16x32_f16(Ap, Bv[ks], o, 0, 0, 0); }
                        const h16x4 a0 = *(const LAS h16x4*)(lds + GL_QD + gsw(16 * mi + m16, 32 * ks + 4 * kg)), a1 = *(const LAS h16x4*)(lds + GL_QD + gsw(16 * mi + m16, 32 * ks + 16 + 4 * kg));
                        h16x8 Aqs;
#pragma unroll
                        for (int j = 0; j < 4; ++j) { Aqs[j] = a0[j]; Aqs[4 + j] = a1[j]; }
                        o = __builtin_amdgcn_mfma_f32_16x16x32_f16(Aqs, Sf[ks], o, 0, 0, 0);
                    }
#pragma unroll
                    for (int r = 0; r < 4; ++r) { const int c = 16 * mi + 4 * kg + r; const int tok = dir ? (SEQ - 1 - (64 * n + c)) : (64 * n + c);
                        O[((size_t)b * SEQ + tok) * 512 + h * 128 + 16 * w + m16] = (h16)o[r]; }
                }
#pragma unroll
                for (int mt = 0; mt < 4; ++mt) {
                    const f32x4 e4 = *(const LAS f32x4*)(EDL + 16 * mt + 4 * kg);
                    S[mt] = S[mt] * e4;
#pragma unroll
                    for (int ks = 0; ks < 2; ++ks) { const h16x8 Ak = *(const LAS h16x8*)(lds + GL_KDT + gsw(16 * mt + m16, 32 * ks + 8 * kg)); S[mt] = __builtin_amdgcn_mfma_f32_16x16x32_f16(Ak, Bv[ks], S[mt], 0, 0, 0); }
                }
            }
            if (n + 1 < SEQ / 64) GLA_PARK();
            if (n + 2 < SEQ / 64) GLA_FETCH(n + 2);
        }
    }
}

__device__ __forceinline__ void phase_mixbuild(const h16* __restrict__ of, const h16* __restrict__ ob, const h16* __restrict__ qkvg, const float* __restrict__ nw, const h16* __restrict__ z2,
                               h16* __restrict__ mix, LAS unsigned char* lds, int blk, int nblk) {
    LAS h16* tileT = (LAS h16*)lds;
    const int tid = threadIdx.x;
    float nwv[8];
#pragma unroll
    for (int j = 0; j < 8; ++j) nwv[j] = nw[(tid & 15) * 8 + j];
    for (int sl = blk; sl < NTOK / 64; sl += nblk) {
        const int tok0 = sl * 64;
        h16x8 zv[8];
#pragma unroll
        for (int i = 0; i < 8; ++i) zv[i] = *(const h16x8*)(z2 + (size_t)tid * NTOK + tok0 + 8 * i);
#pragma unroll 2
        for (int i = 0; i < 8; ++i) {
            const int task = tid + NTHREADS * i, token = task >> 6, head = (task >> 4) & 3, part = task & 15;
            const size_t row = (size_t)tok0 + token;
            const h16x8 a = *(const h16x8*)(of + row * 512 + head * 128 + part * 8), b = *(const h16x8*)(ob + row * 512 + head * 128 + part * 8);
            const h16x8 g = *(const h16x8*)(qkvg + row * 1536 + 1024 + head * 128 + part * 8);
            float o[8], ss = 0.f;
#pragma unroll
            for (int j = 0; j < 8; ++j) { o[j] = (float)a[j] + (float)b[j]; ss += o[j] * o[j]; }
            ss += __shfl_xor(ss, 1); ss += __shfl_xor(ss, 2); ss += __shfl_xor(ss, 4); ss += __shfl_xor(ss, 8);
            const float rstd = rsqrtf(ss * (1.0f / 128.0f) + EPS);
            h16x8 r;
#pragma unroll
            for (int j = 0; j < 8; ++j) r[j] = (h16)(o[j] * rstd * nwv[j] * siluf_((float)g[j]));
            *(h16x8*)(mix + row * DM + head * 128 + part * 8) = r;
        }
        __syncthreads();
#pragma unroll
        for (int i = 0; i < 8; ++i)
#pragma unroll
            for (int j = 0; j < 8; ++j) tileT[(8 * i + j) * 520 + tid] = zv[i][j];
        __syncthreads();
#pragma unroll
        for (int i = 0; i < 8; ++i) { const int idx = tid + NTHREADS * i, token = idx >> 6, c8 = (idx & 63) * 8;
            *(h16x8*)(mix + (size_t)(tok0 + token) * DM + 512 + c8) = *(const LAS h16x8*)(tileT + token * 520 + c8); }
    }
}

#define XB_TMO      128
#define XB_XCNT(j)  (256  + 64 * (j))
#define XB_XSUB(j)  (1280 + 64 * (j))
#define XB_XGEN(j)  (2304 + 64 * (j))
#define XB_TOP      3328
#define XB_TOPGEN   3392
#define XCD_BAR_WORDS 3456
#define XB_SPIN_CAP (1u << 22)
__device__ __forceinline__ unsigned xb_ld(unsigned* p)              { return __hip_atomic_load(p, __ATOMIC_RELAXED, __HIP_MEMORY_SCOPE_AGENT); }
__device__ __forceinline__ unsigned xb_add(unsigned* p, unsigned v) { return __hip_atomic_fetch_add(p, v, __ATOMIC_RELAXED, __HIP_MEMORY_SCOPE_AGENT); }
__device__ __forceinline__ unsigned xb_xcc_id() { return (unsigned)__builtin_amdgcn_s_getreg((3 << 11) | 20) & 0xFu; }
#define XB_SPIN(cond, bar) do { unsigned _sp = 0; while (cond) { __builtin_amdgcn_s_sleep(1); \
    if ((++_sp & 255u) == 0u) { if (xb_ld(&(bar)[XB_TMO])) break; if (_sp > XB_SPIN_CAP) { atomicAdd(&(bar)[XB_TMO], 1u); break; } } } } while (0)
struct XcdBarrier { unsigned* bar; unsigned x; volatile LAS unsigned* st; };
__device__ __forceinline__ void xcd_barrier_post(unsigned* bar) {
    if (threadIdx.x == 0) (void)xb_add(&bar[XB_XCNT(xb_xcc_id())], 1u);
}
__device__ __forceinline__ void xcd_barrier_complete(unsigned* bar, unsigned x, unsigned& nloc, unsigned& nx) {
    const unsigned G = gridDim.x * gridDim.y * gridDim.z;
    unsigned sum, cnt, mine, sp = 0u;
    for (;;) {
        sum = 0u; cnt = 0u; mine = 0u;
#pragma unroll
        for (unsigned j = 0; j < 16; ++j) { const unsigned c = xb_ld(&bar[XB_XCNT(j)]); sum += c; cnt += (c > 0u) ? 1u : 0u; mine = (j == x) ? c : mine; }
        if (sum == G) break;
        __builtin_amdgcn_s_sleep(1);
        if ((++sp & 255u) == 0u) { if (xb_ld(&bar[XB_TMO])) break; if (sp > XB_SPIN_CAP) { atomicAdd(&bar[XB_TMO], 1u); break; } }
    }
    nloc = mine > 0u ? mine : 1u; nx = cnt > 0u ? cnt : 1u;
}
__device__ __forceinline__ void xcd_barrier(unsigned* bar_, volatile LAS unsigned* st_) {
    XcdBarrier b; b.bar = bar_; b.x = xb_xcc_id(); b.st = st_;
    asm volatile("s_waitcnt vmcnt(0)" ::: "memory");
    __syncthreads();
    if (threadIdx.x == 0) {
        unsigned* bar = b.bar;
        __builtin_amdgcn_s_waitcnt(0);
        unsigned nloc = b.st[0], nx = b.st[1];
        if (nloc == 0u) { xcd_barrier_complete(bar, b.x, nloc, nx); b.st[0] = nloc; b.st[1] = nx; }
        const unsigned old = xb_add(&bar[XB_XSUB(b.x)], 1u);
        const unsigned gen = old / nloc;
        if (old + 1u == (gen + 1u) * nloc) {
            __builtin_amdgcn_fence(__ATOMIC_RELEASE, "agent");
            asm volatile("s_waitcnt vmcnt(0)" ::: "memory");
            const unsigned og = xb_add(&bar[XB_TOP], 1u);
            const unsigned tg = og / nx;
            if (og + 1u == (tg + 1u) * nx) xb_add(&bar[XB_TOPGEN], 1u);
            else XB_SPIN(xb_ld(&bar[XB_TOPGEN]) == tg, bar);
            __builtin_amdgcn_fence(__ATOMIC_ACQUIRE, "agent");
            xb_add(&bar[XB_XGEN(b.x)], 1u);
            asm volatile("s_waitcnt vmcnt(0)" ::: "memory");
        } else {
            XB_SPIN(xb_ld(&bar[XB_XGEN(b.x)]) == gen, bar);
            __builtin_amdgcn_fence(__ATOMIC_ACQUIRE, "agent");
            asm volatile("s_waitcnt vmcnt(0)" ::: "memory");
        }
    }
    __syncthreads();
}

enum { PH_PREP = 0, PH_NORM1, PH_FILT, PH_G1A, PH_G1B, PH_GLA, PH_HYENA, PH_GLAMIX, PH_G2, PH_ROUTER, PH_TOPK, PH_MOE1, PH_MOE2, PH_NORM3, PH_G5, PH_G6, PH_FINAL, PH_COUNT };

template <bool COOP>
__global__ __launch_bounds__(NTHREADS, 2) void mega(Args a) {
    extern __shared__ __attribute__((aligned(16))) unsigned char shm[];
    LAS unsigned char* lds = (LAS unsigned char*)shm;
    const int blk = blockIdx.x, nblk = gridDim.x;
    unsigned char* ws = a.ws;
#ifndef PROBE_MASK
#define PROBE_MASK 0u
#endif
#define RUN(P, SYNC, ...) if (a.ph_lo <= (P) && (P) < a.ph_hi) { { __syncthreads(); const float pscale = 1.f; (void)pscale; __VA_ARGS__ } \
        if constexpr (((PROBE_MASK >> (P)) & 1u) != 0u && (P) != PH_GLA && (P) != PH_HYENA) { if (COOP) cg::this_grid().sync(); __syncthreads(); const float pscale = 0.f; (void)pscale; __VA_ARGS__ } \
        if (COOP && (SYNC) != 0 && (P) + 1 < a.ph_hi) { if ((SYNC) == 1) { cg::this_grid().sync(); xcd_barrier_post((unsigned*)(a.ws + OFF_XBAR)); } else xcd_barrier((unsigned*)(a.ws + OFF_XBAR), (volatile LAS unsigned*)(lds + LDS_BYTES - 16)); } }
    if (threadIdx.x < 4) ((volatile LAS unsigned*)(lds + LDS_BYTES - 16))[threadIdx.x] = 0u;
    __syncthreads();
    RUN(PH_PREP, 0, phase_prep(a, lds, blk, nblk);)
    RUN(PH_NORM1, 0, phase_rmsnorm_h16(a.in[I_X], a.in[I_LNMIX], (h16*)(ws + OFF_H), blk, nblk);)
    RUN(PH_FILT, 1, phase_filters(a, (h16*)(ws + OFF_GR), lds, blk, nblk);)
    RUN(PH_G1A, 0, { g8::DenseSched S; S.init(ws + OFF_WINA, NTOK, NA1, DM, nblk, blk); g8::EpiQKVG E{(h16*)(ws + OFF_QKVG), (float*)(ws + OFF_CODES)};
        g8::gemm_phase(lds, (const char*)(ws + OFF_H), DM, S, E); })
    RUN(PH_G1B, 2, { g8::DenseSched S; S.init(ws + OFF_H, HYC, NTOK, DM, nblk, blk); g8::EpiH16 E{(h16*)(ws + OFF_HY), NTOK};
        g8::gemm_phase(lds, (const char*)(ws + OFF_WINHY), DM, S, E); })
    RUN(PH_GLA, 0, { const int ng = nblk >= 2 * NB * 8 ? NB * 8 : nblk;
        if (blk >= nblk - ng) phase_gla((const h16*)(ws + OFF_QKVG), (const float*)(ws + OFF_CODES), a.in[I_WAF], a.in[I_BAF], a.in[I_WAB], a.in[I_BAB], (h16*)(ws + OFF_OF), (h16*)(ws + OFF_OB), lds, blk - (nblk - ng), ng, 1 + (int)((PROBE_MASK >> 5) & 1u)); })
    RUN(PH_HYENA, 2, phase_hyena((const h16*)(ws + OFF_HY), (h16*)(ws + OFF_Z2), (const h16*)(ws + OFF_GR), a.in[I_HCW], a.in[I_HCB], (unsigned*)(ws + OFF_CTR), lds, 1 + (int)((PROBE_MASK >> 6) & 1u));)
    RUN(PH_GLAMIX, 2, phase_mixbuild((const h16*)(ws + OFF_OF), (const h16*)(ws + OFF_OB), (const h16*)(ws + OFF_QKVG), a.in[I_GLANW], (const h16*)(ws + OFF_Z2), (h16*)(ws + OFF_H), lds, blk, nblk);)
    RUN(PH_G2, 2, { g8::DenseSched S; S.init(ws + OFF_WOUT, NTOK, DM, DM, nblk, blk); g8::EpiResid E{a.in[I_X], (h16*)a.out};
        g8::gemm_phase(lds, (const char*)(ws + OFF_H), DM, S, E); })
    RUN(PH_ROUTER, 2, phase_router((const h16*)a.out, a.in[I_LNFFN], a.in[I_WROUTER], ws + OFF_H, (float*)(ws + OFF_PROBS), lds, blk, nblk);)
    RUN(PH_TOPK, 2, phase_topk((const float*)(ws + OFF_PROBS), (int*)(ws + OFF_SELIDX), (float*)(ws + OFF_SELGATE), (int*)(ws + OFF_SLOTMAP), lds, blk, nblk);)
    RUN(PH_MOE1, 2, { g8::Moe1Sched S{(const char*)(ws + OFF_WGU), (const int*)(ws + OFF_SELIDX), nblk, blk}; g8::EpiHid E{ws + OFF_HID};
        g8::gemm_phase<g8::EpiHid, g8::Moe1Sched, true>(lds, (const char*)(ws + OFF_H), DM / 2, S, E); })
    RUN(PH_MOE2, 2, { g8::Moe2Sched S{(const char*)(ws + OFF_WD), nblk, blk}; g8::EpiDown E{ws + OFF_Y, (const float*)(ws + OFF_SELGATE)};
        g8::gemm_phase<g8::EpiDown, g8::Moe2Sched, true>(lds, (const char*)(ws + OFF_HID), DFF / 2, S, E); })
    RUN(PH_NORM3, 0, phase_combine_norm((const h16*)a.out, ws + OFF_Y, (const int*)(ws + OFF_SLOTMAP), a.in[I_LNPLE], (h16*)(ws + OFF_H3), (float*)(ws + OFF_RSTD3), (float*)(ws + OFF_ROWSQ), blk, nblk);)
    RUN(PH_G5, 2, { g8::DenseSched S; S.init(ws + OFF_WP, NTOK, DM, 256, nblk, blk); g8::EpiH16 E{(h16*)(ws + OFF_PP), DM};
        g8::gemm_phase(lds, (const char*)(ws + OFF_P16), 256, S, E); })
    RUN(PH_G6, 2, { g8::DenseSched S; S.init(ws + OFF_WG, NTOK, DM, DM, nblk, blk); g8::EpiPle E{(const h16*)(ws + OFF_H3), (const float*)(ws + OFF_RSTD3), a.in[I_LNPLE], (const h16*)(ws + OFF_PP), (h16*)(ws + OFF_R3H), (float*)(ws + OFF_ROWSQ)};
        g8::gemm_phase(lds, (const char*)(ws + OFF_H3), DM, S, E); })
    RUN(PH_FINAL, 0, phase_final_norm((const h16*)(ws + OFF_R3H), (const float*)(ws + OFF_ROWSQ), a.in[I_FNW], a.out, blk, nblk);)
}

extern "C" void kernel_launch(void* const* d_in, const int* in_sizes, int n_in, void* d_out, int out_size, void* d_ws, size_t ws_size, hipStream_t stream) {
    static int grid = 0;
    if (grid == 0) {
        if (n_in != N_IN || out_size != NTOK * DM || ws_size < WS_END) { fprintf(stderr, "kernel_launch: unexpected shapes (n_in %d, out %d, ws %zu, need %zu)\n", n_in, out_size, ws_size, (size_t)WS_END); grid = -1; return; }
        int dev = 0, cus = 0, per_cu = 0;
        (void)hipGetDevice(&dev); (void)hipDeviceGetAttribute(&cus, hipDeviceAttributeMultiprocessorCount, dev);
        (void)hipFuncSetAttribute((const void*)mega<true>, hipFuncAttributeMaxDynamicSharedMemorySize, LDS_BYTES);
        (void)hipOccupancyMaxActiveBlocksPerMultiprocessor(&per_cu, (const void*)mega<true>, NTHREADS, LDS_BYTES);
        if (per_cu < 1) { fprintf(stderr, "kernel_launch: occupancy query says %d blocks per CU\n", per_cu); per_cu = 1; }
        grid = cus * (per_cu > 1 ? 1 : per_cu);
        (void)hipGetLastError();
    }
    if (grid < 0) return;
    Args a{};
    for (int i = 0; i < N_IN; ++i) a.in[i] = (const float*)d_in[i];
    a.out = (float*)d_out; a.ws = (unsigned char*)d_ws;
    a.ph_lo = 0; a.ph_hi = PH_COUNT;
    void* args[] = {&a};
    hipError_t e = hipLaunchCooperativeKernel((const void*)mega<true>, dim3(grid), dim3(NTHREADS), args, LDS_BYTES, stream);
    if (e != hipSuccess) fprintf(stderr, "kernel_launch: cooperative launch failed: %s (grid %d)\n", hipGetErrorString(e), grid);
}
```

```cpp
#include <hip/hip_runtime.h>
#include <hip/hip_cooperative_groups.h>
#include <cstdio>
#include <cstdint>
#include <cstddef>

namespace cg = cooperative_groups;

#define LAS __attribute__((address_space(3)))
typedef _Float16 h16;
typedef _Float16 h16x8 __attribute__((ext_vector_type(8)));
typedef _Float16 h16x4 __attribute__((ext_vector_type(4)));
typedef _Float16 h16x2 __attribute__((ext_vector_type(2)));
typedef float f32x4 __attribute__((ext_vector_type(4)));
typedef float f32x2 __attribute__((ext_vector_type(2)));
typedef unsigned u32x4 __attribute__((ext_vector_type(4)));
typedef unsigned u32x2 __attribute__((ext_vector_type(2)));
typedef int i32x8 __attribute__((ext_vector_type(8)));
typedef int i32x4 __attribute__((ext_vector_type(4)));

constexpr int NB = 16, SEQ = 4096, DM = 1024, NTOK = NB * SEQ;
constexpr int INCOLS = 3104;
constexpr int NEXP = 16, CAP = 512, DFF = 2048;
constexpr int HYW = 512, HYC = 1536;
constexpr float EPS = 1e-6f;

enum { I_X = 0, I_P, I_LNMIX, I_WIN, I_WAF, I_BAF, I_WAB, I_BAB, I_GLANW, I_HCW, I_HCB, I_FW1, I_FB1, I_FFR1, I_FW2, I_FB2, I_FFR2,
       I_FW3, I_HBIAS, I_WOUT, I_LNFFN, I_WROUTER, I_WGATE, I_WUP, I_WDOWN, I_LNPLE, I_WPG, I_WPP, I_FNW, N_IN };

constexpr size_t AL(size_t x) { return (x + 255) & ~(size_t)255; }
constexpr int NA1 = 1792;
constexpr size_t OFF_WINA = 0;
constexpr size_t OFF_WINHY = OFF_WINA + AL((size_t)NA1 * DM * 2);
constexpr size_t OFF_WOUT = OFF_WINHY + AL((size_t)HYC * DM * 2);
constexpr size_t OFF_WGU = OFF_WOUT + AL((size_t)DM * DM * 2);
constexpr size_t OFF_WD = OFF_WGU + AL((size_t)NEXP * 2 * DFF * DM * 2);
constexpr size_t OFF_WG = OFF_WD + AL((size_t)NEXP * DM * DFF * 2);
constexpr size_t OFF_WP = OFF_WG + AL((size_t)DM * DM * 2);
constexpr size_t OFF_P16 = OFF_WP + AL((size_t)DM * 256 * 2);
constexpr size_t OFF_PROBS = OFF_P16 + AL((size_t)NTOK * 256 * 2);
constexpr size_t OFF_SELIDX = OFF_PROBS + AL((size_t)NB * NEXP * SEQ * 4);
constexpr size_t OFF_SELGATE = OFF_SELIDX + AL((size_t)NB * NEXP * CAP * 4);
constexpr size_t OFF_SLOTMAP = OFF_SELGATE + AL((size_t)NB * NEXP * CAP * 4);
constexpr size_t OFF_CTR = OFF_SLOTMAP + AL((size_t)NTOK * NEXP * 4);
constexpr size_t OFF_XBAR = OFF_CTR + 256;
constexpr size_t OFF_BIG = OFF_XBAR + AL(3456 * 4);
constexpr size_t OFF_QKVG = OFF_BIG;
constexpr size_t OFF_HY = OFF_QKVG + AL((size_t)NTOK * 1536 * 2);
constexpr size_t OFF_CODES = OFF_HY + AL((size_t)HYC * NTOK * 2);
constexpr size_t OFF_OF = OFF_CODES + AL((size_t)NTOK * 32 * 4);
constexpr size_t OFF_OB = OFF_OF + AL((size_t)NTOK * 512 * 2);
constexpr size_t OFF_GR = OFF_OB + AL((size_t)NTOK * 512 * 2);
constexpr size_t OFF_H = OFF_GR + AL((size_t)2 * HYW * 8192 * 2);
constexpr size_t OFF_Z2 = OFF_H + AL((size_t)NTOK * DM * 2);
constexpr size_t END_A = OFF_Z2 + AL((size_t)HYW * NTOK * 2);
constexpr size_t OFF_HID = OFF_BIG;
constexpr size_t OFF_Y = OFF_HID + AL((size_t)NB * NEXP * CAP * DFF * 2);
constexpr size_t END_B = OFF_Y + AL((size_t)NB * NEXP * CAP * DM * 2);
static_assert(OFF_H >= OFF_Y, "h2 (read by the up/gate GEMM) must not be overwritten by HID");
constexpr size_t OFF_H3 = OFF_BIG;
constexpr size_t OFF_PP = OFF_H3 + AL((size_t)NTOK * DM * 2);
constexpr size_t OFF_R3H = OFF_PP + AL((size_t)NTOK * DM * 2);
constexpr size_t OFF_RSTD3 = OFF_R3H + AL((size_t)NTOK * DM * 2);
constexpr size_t OFF_ROWSQ = OFF_RSTD3 + AL((size_t)NTOK * 4);
constexpr size_t END_C = OFF_ROWSQ + AL((size_t)NTOK * 4);
constexpr size_t WS_END = END_A > END_B ? (END_A > END_C ? END_A : END_C) : (END_B > END_C ? END_B : END_C);

constexpr int NTHREADS = 512;
constexpr int LDS_BYTES = 156 * 1024;
constexpr float HY_SCALE = 64.0f;
constexpr int FP8_WSHIFT = 5;


struct Args {
    const float* in[N_IN];
    float* out;
    unsigned char* ws;
    int ph_lo, ph_hi;
};

__device__ __forceinline__ float wave_sum(float v) {
#pragma unroll
    for (int o = 32; o >= 1; o >>= 1) v += __shfl_xor(v, o);
    return v;
}
__device__ __forceinline__ float sigmoidf_(float x) { return __builtin_amdgcn_rcpf(1.0f + __expf(-x)); }
__device__ __forceinline__ float siluf_(float x) { return x * __builtin_amdgcn_rcpf(1.0f + __expf(-x)); }
__device__ __forceinline__ unsigned pack_h2(float a, float b) {
    h16x2 v; v.x = (h16)a; v.y = (h16)b; return __builtin_bit_cast(unsigned, v);
}


__device__ __forceinline__ void sincos_f(float x, float& s, float& c) {
    const float kf = rintf(x * 0.6366197723675814f);
    float r = fmaf(kf, -1.5707963705062866f, x); r = fmaf(kf, 4.371139000186241e-8f, r);
    const float r2 = r * r;
    const float sp = r + r * r2 * (-1.6666667e-1f + r2 * (8.3333338e-3f + r2 * (-1.9841270e-4f + r2 * 2.7557319e-6f)));
    const float cp = 1.0f + r2 * (-0.5f + r2 * (4.1666668e-2f + r2 * (-1.3888889e-3f + r2 * (2.4801587e-5f - r2 * 2.7557319e-7f))));
    const int k = (int)kf & 3;
    s = (k == 0) ? sp : (k == 1) ? cp : (k == 2) ? -sp : -cp;
    c = (k == 0) ? cp : (k == 1) ? -sp : (k == 2) ? -cp : sp;
}
__device__ __forceinline__ float sin_f(float x) { float s, c; sincos_f(x, s, c); return s; }

__device__ __forceinline__ unsigned pack_fp8x4(float a, float b, float c, float d) {
    int r = 0; r = __builtin_amdgcn_cvt_pk_fp8_f32(a, b, r, false); r = __builtin_amdgcn_cvt_pk_fp8_f32(c, d, r, true); return (unsigned)r;
}

namespace g8 {
constexpr int BM = 256, BK = 64, HALF = 128, HTB = HALF * BK * 2, STAGE_BYTES = 8 * HTB;
__device__ __forceinline__ int lds_byte(int r, int c) { const int st = (r >> 4) * 2 + (c >> 5), rr = r & 15, cc = c & 31, ob = rr * 64 + cc * 2; return st * 1024 + (ob ^ (((ob >> 9) & 1) << 5)); }
__device__ __forceinline__ void stage_rc(int b, int& R, int& C) { const int st = b / 1024, sb = b % 1024, swz = sb ^ (((sb >> 9) & 1) << 5); R = (st >> 1) * 16 + swz / 64; C = (st & 1) * 32 + (swz % 64) / 2; }
__device__ __forceinline__ int perm32(int rho) { const int n = rho >> 4, i = rho & 15; return 8 * (i >> 2) + 4 * n + (i & 3); }

struct Unit { const char* B; int pm, pn, g; unsigned rowbase; int ord; };

template <class Epi, class Sched, bool FP8 = false>
__device__ __forceinline__ void gemm_phase(LAS unsigned char* lds, const char* A, const int K, const Sched& S, const Epi& E) {
    const int tid = threadIdx.x, wid = __builtin_amdgcn_readfirstlane(tid >> 6), lane = tid & 63, wr = wid >> 2, wc = wid & 3, fr = lane & 15, fq = lane >> 4;
    const int nt = K / BK;
    int Rr[2], Cc[2]; unsigned voffB[2];
#pragma unroll
    for (int i = 0; i < 2; ++i) { stage_rc(tid * 16 + i * 8192, Rr[i], Cc[i]); const int Rb = Epi::PERM ? ((Rr[i] & ~31) + perm32(Rr[i] & 31)) : Rr[i];
        voffB[i] = (unsigned)(Rb * K + Cc[i]) * 2u; }
    const size_t kstep = (size_t)(BK * 2);
    const size_t hstep = (size_t)HALF * K * 2;
    const unsigned ldsw = (unsigned)wid * 1024u;
    const int aoff = lds_byte(wr * 64 + fr, fq * 8), boff = lds_byte(wc * 32 + fr, fq * 8);
#define G8_SA(b, h) (((b) * 2 + (h)) * HTB)
#define G8_SB(b, h) ((4 + (b) * 2 + (h)) * HTB)
#define G8_STAGE(bufoff, gbase, v0, v1) do { \
        __builtin_amdgcn_global_load_lds((const unsigned*)((const char*)(gbase) + (v0)), (LAS unsigned*)(lds + (bufoff) + ldsw), 16, 0, 0); \
        __builtin_amdgcn_global_load_lds((const unsigned*)((const char*)(gbase) + (v1)), (LAS unsigned*)(lds + (bufoff) + ldsw + 8192), 16, 0, 0); } while (0)
#define G8_LDA(dst, b, h) do { _Pragma("unroll") for (int m = 0; m < 4; ++m) { \
        const i32x4 lo_ = *(const LAS i32x4*)(lds + G8_SA(b, h) + aoff + m * 2048), hi_ = *(const LAS i32x4*)(lds + G8_SA(b, h) + aoff + m * 2048 + 1024); \
        dst[m] = __builtin_shufflevector(lo_, hi_, 0, 1, 2, 3, 4, 5, 6, 7); } } while (0)
#define G8_LDB(dst, b, h) do { _Pragma("unroll") for (int n = 0; n < 2; ++n) { \
        const i32x4 lo_ = *(const LAS i32x4*)(lds + G8_SB(b, h) + boff + n * 2048), hi_ = *(const LAS i32x4*)(lds + G8_SB(b, h) + boff + n * 2048 + 1024); \
        dst[n] = __builtin_shufflevector(lo_, hi_, 0, 1, 2, 3, 4, 5, 6, 7); } } while (0)
#define G8_MMA(ai, bj, At, Bt) do { __builtin_amdgcn_s_setprio(1); \
        if constexpr (FP8) { _Pragma("unroll") for (int m = 0; m < 4; ++m) _Pragma("unroll") for (int n = 0; n < 2; ++n) \
            asm volatile("v_mfma_scale_f32_16x16x128_f8f6f4 %0, %1, %2, %0, %3, %3 op_sel_hi:[0,0,0]" : "+v"(acc[ai][bj][m][n]) : "v"(Bt[n]), "v"(At[m]), "v"(sc_one)); } \
        else { _Pragma("unroll") for (int m = 0; m < 4; ++m) _Pragma("unroll") for (int n = 0; n < 2; ++n) { \
            const i32x8 a_ = At[m], b_ = Bt[n]; \
            const h16x8 a0_ = __builtin_bit_cast(h16x8, __builtin_shufflevector(a_, a_, 0, 1, 2, 3)), a1_ = __builtin_bit_cast(h16x8, __builtin_shufflevector(a_, a_, 4, 5, 6, 7)); \
            const h16x8 b0_ = __builtin_bit_cast(h16x8, __builtin_shufflevector(b_, b_, 0, 1, 2, 3)), b1_ = __builtin_bit_cast(h16x8, __builtin_shufflevector(b_, b_, 4, 5, 6, 7)); \
            acc[ai][bj][m][n] = __builtin_amdgcn_mfma_f32_16x16x32_f16(b0_, a0_, acc[ai][bj][m][n], 0, 0, 0); \
            acc[ai][bj][m][n] = __builtin_amdgcn_mfma_f32_16x16x32_f16(b1_, a1_, acc[ai][bj][m][n], 0, 0, 0); } } \
        __builtin_amdgcn_s_setprio(0); } while (0)
#define G8_WAIT_V(n) asm volatile("s_waitcnt vmcnt(" #n ")" ::: "memory")
#define G8_WAIT_L(n) asm volatile("s_waitcnt lgkmcnt(" #n ")" ::: "memory")
#define G8_BAR __builtin_amdgcn_s_barrier()
#define G8_SCHED __builtin_amdgcn_sched_barrier(0)
    Unit cur, nxt; int ui = 0;
    if (!S.next(0, cur)) return;
    f32x4 acc[2][2][4][2];
#pragma unroll
    for (int a = 0; a < 2; ++a)
#pragma unroll
        for (int b = 0; b < 2; ++b)
#pragma unroll
            for (int m = 0; m < 4; ++m)
#pragma unroll
                for (int n = 0; n < 2; ++n) acc[a][b][m][n] = (f32x4){0.f, 0.f, 0.f, 0.f};
    i32x8 At[4], B0[2], B1[2];
    const int sc_one = 0x7f7f7f7f; (void)sc_one;
    unsigned va00, va01, va10, va11, vn00, vn01, vn10, vn11;
    va00 = (S.arow(cur, Rr[0]) * (unsigned)K + (unsigned)Cc[0]) * 2u; va01 = (S.arow(cur, Rr[1]) * (unsigned)K + (unsigned)Cc[1]) * 2u;
    va10 = (S.arow(cur, HALF + Rr[0]) * (unsigned)K + (unsigned)Cc[0]) * 2u; va11 = (S.arow(cur, HALF + Rr[1]) * (unsigned)K + (unsigned)Cc[1]) * 2u;
    vn00 = va00; vn01 = va01; vn10 = va10; vn11 = va11;
    const char* cB = cur.B;
    G8_STAGE(G8_SB(0, 0), cB, voffB[0], voffB[1]); G8_STAGE(G8_SA(0, 0), A, va00, va01); G8_STAGE(G8_SB(0, 1), cB + hstep, voffB[0], voffB[1]); G8_STAGE(G8_SA(0, 1), A, va10, va11);
    if (wr == 1) G8_BAR;
    G8_WAIT_V(4); G8_BAR;
    G8_STAGE(G8_SB(1, 0), cB + kstep, voffB[0], voffB[1]); G8_STAGE(G8_SA(1, 0), A + kstep, va00, va01); G8_STAGE(G8_SB(1, 1), cB + hstep + kstep, voffB[0], voffB[1]);
    G8_WAIT_V(6); G8_BAR;
    for (;;) {
        const bool has_next = S.next(ui + 1, nxt);
        const char* nB = has_next ? nxt.B : cB;
        if (has_next) {
            vn00 = (S.arow(nxt, Rr[0]) * (unsigned)K + (unsigned)Cc[0]) * 2u; vn01 = (S.arow(nxt, Rr[1]) * (unsigned)K + (unsigned)Cc[1]) * 2u;
            vn10 = (S.arow(nxt, HALF + Rr[0]) * (unsigned)K + (unsigned)Cc[0]) * 2u; vn11 = (S.arow(nxt, HALF + Rr[1]) * (unsigned)K + (unsigned)Cc[1]) * 2u;
        }
        for (int t = 0; t < nt; t += 2) {
            const bool last = (t == nt - 2);
            const char* a1 = A + (size_t)(t + 1) * kstep;
            const char* a2 = last ? A : A + (size_t)(t + 2) * kstep; const char* b2 = last ? nB : cB + (size_t)(t + 2) * kstep;
            const char* a3 = a2 + kstep; const char* b3 = b2 + kstep;
            const unsigned w00 = last ? vn00 : va00, w01 = last ? vn01 : va01, w10 = last ? vn10 : va10, w11 = last ? vn11 : va11;
            G8_LDB(B0, 0, 0); G8_SCHED; G8_LDA(At, 0, 0); G8_STAGE(G8_SA(1, 1), a1, va10, va11);
            G8_WAIT_L(8); G8_BAR; G8_WAIT_L(0); G8_MMA(0, 0, At, B0); G8_BAR; G8_SCHED;
            G8_LDB(B1, 0, 1); G8_STAGE(G8_SB(0, 0), b2, voffB[0], voffB[1]);
            G8_BAR; G8_WAIT_L(0); G8_MMA(0, 1, At, B1); G8_BAR;
            G8_LDA(At, 0, 1); G8_STAGE(G8_SA(0, 0), a2, w00, w01);
            G8_BAR; G8_WAIT_L(0); G8_MMA(1, 0, At, B0); G8_BAR; G8_SCHED;
            G8_STAGE(G8_SB(0, 1), b2 + hstep, voffB[0], voffB[1]);
            G8_WAIT_V(6); G8_BAR; G8_MMA(1, 1, At, B1); G8_BAR;
            G8_LDB(B0, 1, 0); G8_SCHED; G8_LDA(At, 1, 0); G8_STAGE(G8_SA(0, 1), a2, w10, w11);
            G8_WAIT_L(8); G8_BAR; G8_WAIT_L(0); G8_MMA(0, 0, At, B0); G8_BAR; G8_SCHED;
            G8_LDB(B1, 1, 1); G8_STAGE(G8_SB(1, 0), b3, voffB[0], voffB[1]);
            G8_BAR; G8_WAIT_L(0); G8_MMA(0, 1, At, B1); G8_BAR;
            G8_LDA(At, 1, 1); G8_STAGE(G8_SA(1, 0), a3, w00, w01);
            G8_BAR; G8_WAIT_L(0); G8_MMA(1, 0, At, B0); G8_BAR; G8_SCHED;
            G8_STAGE(G8_SB(1, 1), b3 + hstep, voffB[0], voffB[1]);
            G8_WAIT_V(6); G8_BAR; G8_MMA(1, 1, At, B1); G8_BAR;
        }
        if constexpr (FP8) asm volatile("s_nop 15\n\ts_nop 15" ::: "memory");
        E(acc, cur, wr, wc, fr, fq);
        if (!has_next) break;
#pragma unroll
        for (int a = 0; a < 2; ++a)
#pragma unroll
            for (int b = 0; b < 2; ++b)
#pragma unroll
                for (int m = 0; m < 4; ++m)
#pragma unroll
                    for (int n = 0; n < 2; ++n) acc[a][b][m][n] = (f32x4){0.f, 0.f, 0.f, 0.f};
        cur = nxt; cB = nB; va00 = vn00; va01 = vn01; va10 = vn10; va11 = vn11; ++ui;
    }
    G8_WAIT_V(0);
    if (wr == 0) G8_BAR;
    G8_BAR;
#undef G8_SA
#undef G8_SB
#undef G8_STAGE
#undef G8_LDA
#undef G8_LDB
#undef G8_MMA
#undef G8_WAIT_V
#undef G8_WAIT_L
#undef G8_BAR
#undef G8_SCHED
}

struct DenseSched {
    const char* Bt; int K, nM, nN, nwg, G, c;
    __device__ void init(const void* Bt_, int M, int N, int K_, int G_, int c_) { Bt = (const char*)Bt_; K = K_; nM = M / BM; nN = N / BM; nwg = nM * nN; G = G_; c = c_; }
    __device__ bool next(int i, Unit& u) const {
        const long L = (long)i * G + c; if (L >= nwg) return false;
        int wgid = (int)L; { const int q = nwg / 8, r = nwg % 8, xcd = wgid % 8, off = wgid / 8; wgid = (xcd < r ? xcd * (q + 1) : r * (q + 1) + (xcd - r) * q) + off; }
        const int nig = 8 * nN, gid = wgid / nig, fm = gid * 8, gsz = (nM - fm) < 8 ? (nM - fm) : 8;
        u.pm = fm + ((wgid % nig) % gsz); u.pn = (wgid % nig) / gsz; u.g = 0; u.rowbase = (unsigned)u.pm * BM; u.ord = 0;
        u.B = Bt + (size_t)u.pn * BM * K * 2; return true;
    }
    __device__ __forceinline__ unsigned arow(const Unit& u, int r) const { return u.rowbase + (unsigned)r; }
};
struct Moe1Sched {
    const char* W; const int* rowmap; int G, c; const LAS unsigned short* lrow;
    __device__ bool next(int i, Unit& u) const {
        const long L = (long)i * G + c; if (L >= NEXP * 512) return false;
        const int e = (int)(L / 512), w = (int)(L % 512), cc = w % 256, r = w / 256, xcd = cc % 8, j = cc / 8;
        const int mt = xcd * 4 + (j & 3), nt_ = r * 8 + (j >> 2), b = mt >> 1;
        u.pm = mt & 1; u.pn = nt_; u.g = b * NEXP + e; u.rowbase = (unsigned)u.g * CAP + (unsigned)u.pm * BM; u.ord = i;
        u.B = W + ((size_t)e * 2 * DFF + (size_t)nt_ * BM) * DM; return true;
    }
    __device__ __forceinline__ unsigned arow(const Unit& u, int r) const { return (unsigned)lrow[u.ord * BM + r]; }
    __device__ __forceinline__ void preload(LAS unsigned short* dst) const {
        Unit u;
        for (int i = 0; next(i, u); ++i) if (threadIdx.x < BM) dst[i * BM + threadIdx.x] = (unsigned short)rowmap[u.rowbase + threadIdx.x];
        __syncthreads();
    }
};
struct Moe2Sched {
    const char* W; int G, c;
    __device__ bool next(int i, Unit& u) const {
        const long L = (long)i * G + c; if (L >= NEXP * 128) return false;
        const int e = (int)(L / 128), w = (int)(L % 128), xcd = w % 8, j = w / 8;
        const int mt = xcd * 4 + (j & 3), nt_ = j >> 2, b = mt >> 1;
        u.pm = mt & 1; u.pn = nt_; u.g = b * NEXP + e; u.rowbase = (unsigned)u.g * CAP + (unsigned)u.pm * BM; u.ord = 0;
        u.B = W + ((size_t)e * DM + (size_t)nt_ * BM) * DFF; return true;
    }
    __device__ __forceinline__ unsigned arow(const Unit& u, int r) const { return u.rowbase + (unsigned)r; }
};

typedef const f32x4 (&AccRef)[2][2][4][2];
struct EpiQKVG {
    static constexpr bool PERM = true;
    h16* qkvg; float* codes;
    __device__ __forceinline__ void operator()(AccRef acc, const Unit& u, int wr, int wc, int fr, int fq) const {
        const int row0 = u.pm * BM + wr * 64 + fr;
        if (u.pn < 6) {
#pragma unroll
            for (int ai = 0; ai < 2; ++ai)
#pragma unroll
                for (int m = 0; m < 4; ++m) { h16* rowp = qkvg + (size_t)(row0 + ai * HALF + m * 16) * 1536 + u.pn * BM + wc * 32 + 8 * fq;
#pragma unroll
                    for (int bj = 0; bj < 2; ++bj) { const f32x4 v0 = acc[ai][bj][m][0], v1 = acc[ai][bj][m][1];
                        u32x4 w; w.x = pack_h2(v0[0], v0[1]); w.y = pack_h2(v0[2], v0[3]); w.z = pack_h2(v1[0], v1[1]); w.w = pack_h2(v1[2], v1[3]);
                        *(u32x4*)(rowp + bj * HALF) = w; } }
        } else if (wc == 0) {
#pragma unroll
            for (int ai = 0; ai < 2; ++ai)
#pragma unroll
                for (int m = 0; m < 4; ++m) { float* rowp = codes + (size_t)(row0 + ai * HALF + m * 16) * 32 + 8 * fq;
                    *(f32x4*)(rowp) = acc[ai][0][m][0]; *(f32x4*)(rowp + 4) = acc[ai][0][m][1]; }
        }
    }
};
struct EpiH16 {
    static constexpr bool PERM = true;
    h16* C; int ldc;
    __device__ __forceinline__ void operator()(AccRef acc, const Unit& u, int wr, int wc, int fr, int fq) const {
        const int row0 = u.pm * BM + wr * 64 + fr;
#pragma unroll
        for (int ai = 0; ai < 2; ++ai)
#pragma unroll
            for (int m = 0; m < 4; ++m) { h16* rowp = C + (size_t)(row0 + ai * HALF + m * 16) * ldc + u.pn * BM + wc * 32 + 8 * fq;
#pragma unroll
                for (int bj = 0; bj < 2; ++bj) { const f32x4 v0 = acc[ai][bj][m][0], v1 = acc[ai][bj][m][1];
                    u32x4 w; w.x = pack_h2(v0[0], v0[1]); w.y = pack_h2(v0[2], v0[3]); w.z = pack_h2(v1[0], v1[1]); w.w = pack_h2(v1[2], v1[3]);
                    *(u32x4*)(rowp + bj * HALF) = w; } }
    }
};
struct EpiResid {
    static constexpr bool PERM = true;
    const float* X; h16* R;
    __device__ __forceinline__ void operator()(AccRef acc, const Unit& u, int wr, int wc, int fr, int fq) const {
        const int row0 = u.pm * BM + wr * 64 + fr, col0 = u.pn * BM + wc * 32 + 8 * fq;
#pragma unroll
        for (int ai = 0; ai < 2; ++ai)
#pragma unroll
            for (int m = 0; m < 4; ++m) { const size_t off = (size_t)(row0 + ai * HALF + m * 16) * DM + col0;
#pragma unroll
                for (int bj = 0; bj < 2; ++bj) { const f32x4 x0 = *(const f32x4*)(X + off + bj * HALF), x1 = *(const f32x4*)(X + off + bj * HALF + 4);
                    const f32x4 v0 = x0 + acc[ai][bj][m][0], v1 = x1 + acc[ai][bj][m][1];
                    u32x4 w; w.x = pack_h2(v0[0], v0[1]); w.y = pack_h2(v0[2], v0[3]); w.z = pack_h2(v1[0], v1[1]); w.w = pack_h2(v1[2], v1[3]);
                    *(u32x4*)(R + off + bj * HALF) = w; } }
    }
};
struct EpiHid {
    static constexpr bool PERM = true;
    unsigned char* hid;
    __device__ __forceinline__ void operator()(AccRef acc, const Unit& u, int wr, int wc, int fr, int fq) const {
        const unsigned row0 = u.rowbase + wr * 64 + fr;
#pragma unroll
        for (int ai = 0; ai < 2; ++ai)
#pragma unroll
            for (int m = 0; m < 4; ++m) { unsigned char* rowp = hid + (size_t)(row0 + ai * HALF + m * 16) * DFF + u.pn * HALF + wc * 32 + 8 * fq;
                constexpr float ws_ = 1.0f / (float)(1 << FP8_WSHIFT);
                const f32x4 g0 = acc[ai][0][m][0] * ws_, g1 = acc[ai][0][m][1] * ws_, u0 = acc[ai][1][m][0] * ws_, u1 = acc[ai][1][m][1] * ws_;
                u32x2 w; w.x = pack_fp8x4(siluf_(g0[0]) * u0[0], siluf_(g0[1]) * u0[1], siluf_(g0[2]) * u0[2], siluf_(g0[3]) * u0[3]);
                w.y = pack_fp8x4(siluf_(g1[0]) * u1[0], siluf_(g1[1]) * u1[1], siluf_(g1[2]) * u1[2], siluf_(g1[3]) * u1[3]);
                *(u32x2*)rowp = w; }
    }
};
constexpr float Y_SCALE = 8.0f;
struct EpiDown {
    static constexpr bool PERM = true;
    unsigned char* Y; const float* selgate;
    __device__ __forceinline__ void operator()(AccRef acc, const Unit& u, int wr, int wc, int fr, int fq) const {
        const unsigned row0 = u.rowbase + wr * 64 + fr;
#pragma unroll
        for (int ai = 0; ai < 2; ++ai)
#pragma unroll
            for (int m = 0; m < 4; ++m) { const unsigned sr = row0 + ai * HALF + m * 16; const float gt = selgate[sr] * (Y_SCALE / (float)(1 << FP8_WSHIFT));
                unsigned char* rowp = Y + (size_t)sr * DM + u.pn * BM + wc * 32 + 8 * fq;
#pragma unroll
                for (int bj = 0; bj < 2; ++bj) { const f32x4 v0 = acc[ai][bj][m][0] * gt, v1 = acc[ai][bj][m][1] * gt;
                    u32x2 w; w.x = pack_fp8x4(v0[0], v0[1], v0[2], v0[3]); w.y = pack_fp8x4(v1[0], v1[1], v1[2], v1[3]);
                    *(u32x2*)(rowp + bj * HALF) = w; } }
    }
};
struct EpiPle {
    static constexpr bool PERM = true;
    const h16* H3; const float* rstd3; const float* lnw; const h16* PP; h16* R3H; float* rowsq;
    __device__ __forceinline__ void operator()(AccRef acc, const Unit& u, int wr, int wc, int fr, int fq) const {
        const int row0 = u.pm * BM + wr * 64 + fr, col0 = u.pn * BM + wc * 32 + 8 * fq;
        f32x4 winv[2][2];
#pragma unroll
        for (int bj = 0; bj < 2; ++bj)
#pragma unroll
            for (int n = 0; n < 2; ++n) { const f32x4 wv = *(const f32x4*)(lnw + col0 + bj * HALF + n * 4);
#pragma unroll
                for (int j = 0; j < 4; ++j) winv[bj][n][j] = __builtin_amdgcn_rcpf(wv[j]); }
#pragma unroll
        for (int ai = 0; ai < 2; ++ai)
#pragma unroll
            for (int m = 0; m < 4; ++m) { const int row = row0 + ai * HALF + m * 16; const size_t off = (size_t)row * DM + col0;
                const float inv = __builtin_amdgcn_rcpf(rstd3[row]); float sq = 0.f;
#pragma unroll
                for (int bj = 0; bj < 2; ++bj) { const size_t o2 = off + bj * HALF; const h16x8 hv = *(const h16x8*)(H3 + o2), pv = *(const h16x8*)(PP + o2);
                    float o[8];
#pragma unroll
                    for (int n = 0; n < 2; ++n)
#pragma unroll
                        for (int j = 0; j < 4; ++j) { const float v = (float)hv[4 * n + j] * inv * winv[bj][n][j] + sigmoidf_(acc[ai][bj][m][n][j]) * (float)pv[4 * n + j]; o[4 * n + j] = v; sq += v * v; }
                    u32x4 w; w.x = pack_h2(o[0], o[1]); w.y = pack_h2(o[2], o[3]); w.z = pack_h2(o[4], o[5]); w.w = pack_h2(o[6], o[7]); *(u32x4*)(R3H + o2) = w; }
                sq += __shfl_xor(sq, 16); sq += __shfl_xor(sq, 32);
                if (fq == 0) unsafeAtomicAdd(rowsq + row, sq); }
    }
};
}

template <class ColPtr>
__device__ __forceinline__ void cvt_transpose(LAS unsigned char* lds, h16* dst, int N, int K, int src_ld, ColPtr cp, int blk, int nblk) {
    const int tid = threadIdx.x, w = tid >> 6, l = tid & 63, nq = tid & 31, kp = tid >> 5;
    const int ktiles = K / 256, ntiles = (N / 128) * ktiles;
    f32x4 va[8], vb[8];
    auto fetch = [&](int t) {
        const int n0 = (t / ktiles) * 128, k0 = (t % ktiles) * 256;
        const float* sp = cp(n0 + (nq >> 3) * 32);
#pragma unroll
        for (int ps = 0; ps < 8; ++ps) {
            const int kk = 2 * (kp + 16 * ps);
            if (sp) { va[ps] = *(const f32x4*)(sp + (size_t)(k0 + kk) * src_ld + ((4 * nq) & 31)); vb[ps] = *(const f32x4*)(sp + (size_t)(k0 + kk + 1) * src_ld + ((4 * nq) & 31)); }
            else { va[ps] = (f32x4){0.f, 0.f, 0.f, 0.f}; vb[ps] = va[ps]; }
        }
    };
    if (blk < ntiles) fetch(blk);
    for (int t = blk; t < ntiles; t += nblk) {
        const int n0 = (t / ktiles) * 128, k0 = (t % ktiles) * 256;
        __syncthreads();
        const int sv = (nq & 15) << 1;
#pragma unroll
        for (int ps = 0; ps < 8; ++ps) { const int d = kp + 16 * ps;
#pragma unroll
            for (int j = 0; j < 4; ++j) *(LAS unsigned*)(lds + (4 * nq + j) * 512 + ((d ^ sv) << 2)) = pack_h2(va[ps][j], vb[ps][j]); }
        if (t + nblk < ntiles) fetch(t + nblk);
        __syncthreads();
#pragma unroll 4
        for (int r = 0; r < 16; ++r) { const int row = w * 16 + r, rv = ((row >> 2) & 15) << 1;
            const u32x2 x = *(const LAS u32x2*)(lds + row * 512 + (((2 * l) ^ rv) << 2));
            *(u32x2*)(dst + (size_t)(n0 + row) * K + k0 + 4 * l) = x; }
    }
}

template <class ColPtr>
__device__ __forceinline__ void cvt_transpose_fp8(LAS unsigned char* lds, unsigned char* dst, int N, int K, int src_ld, float scale, ColPtr cp, int blk, int nblk) {
    const int tid = threadIdx.x, w = tid >> 6, l = tid & 63, nq = tid & 31, kq = tid >> 5;
    const int ktiles = K / 256, ntiles = (N / 128) * ktiles;
    f32x4 v[4][4];
    auto fetch = [&](int t) {
        const int n0 = (t / ktiles) * 128, k0 = (t % ktiles) * 256;
        const float* sp = cp(n0 + (nq >> 3) * 32);
#pragma unroll
        for (int ps = 0; ps < 4; ++ps)
#pragma unroll
            for (int q = 0; q < 4; ++q) v[ps][q] = *(const f32x4*)(sp + (size_t)(k0 + 4 * (kq + 16 * ps) + q) * src_ld + ((4 * nq) & 31));
    };
    if (blk < ntiles) fetch(blk);
    for (int t = blk; t < ntiles; t += nblk) {
        const int n0 = (t / ktiles) * 128, k0 = (t % ktiles) * 256;
        __syncthreads();
        const int sv = (nq & 15) << 1;
#pragma unroll
        for (int ps = 0; ps < 4; ++ps) { const int d = kq + 16 * ps;
#pragma unroll
            for (int j = 0; j < 4; ++j) *(LAS unsigned*)(lds + (4 * nq + j) * 256 + ((d ^ sv) << 2)) = pack_fp8x4(v[ps][0][j] * scale, v[ps][1][j] * scale, v[ps][2][j] * scale, v[ps][3][j] * scale); }
        if (t + nblk < ntiles) fetch(t + nblk);
        __syncthreads();
#pragma unroll 4
        for (int r = 0; r < 16; ++r) { const int row = w * 16 + r, rv = ((row >> 2) & 15) << 1;
            const unsigned x = *(const LAS unsigned*)(lds + row * 256 + ((l ^ rv) << 2));
            *(unsigned*)(dst + (size_t)(n0 + row) * K + k0 + 4 * l) = x; }
    }
}

__device__ __forceinline__ void prep_fp8_weights(const Args& a, LAS unsigned char* lds, int blk, int nblk) {
    unsigned char* ws = a.ws;
    const int tid = threadIdx.x, w = tid >> 6, l = tid & 63, nq = tid & 31, kq = tid >> 5;
    constexpr int NT = 2048 + 1024;
    const float scale = (float)(1 << FP8_WSHIFT);
    struct Tile { const float* sp; int src_ld; unsigned char* dst; int K; };
    auto decode = [&](int gt) -> Tile {
        Tile t;
        if (gt < 2048) { const int e = gt >> 7, r = gt & 127, n0 = (r >> 2) * 128, k0 = (r & 3) * 256, nb = n0 + (nq >> 3) * 32;
            const int tile = nb >> 8, within = nb & 255, f = tile * 128 + (within & 127);
            t.sp = ((within >> 7) ? a.in[I_WUP] : a.in[I_WGATE]) + (size_t)e * DM * DFF + f + (size_t)k0 * DFF; t.src_ld = DFF; t.K = DM;
            t.dst = ws + OFF_WGU + (size_t)e * 2 * DFF * DM + (size_t)n0 * DM + k0; }
        else { const int g2 = gt - 2048, e = g2 >> 6, r = g2 & 63, n0 = (r >> 3) * 128, k0 = (r & 7) * 256, nb = n0 + (nq >> 3) * 32;
            t.sp = a.in[I_WDOWN] + (size_t)e * DFF * DM + nb + (size_t)k0 * DM; t.src_ld = DM; t.K = DFF;
            t.dst = ws + OFF_WD + (size_t)e * DM * DFF + (size_t)n0 * DFF + k0; }
        return t;
    };
    f32x4 v[4][4];
    auto fetch = [&](const Tile& t) {
#pragma unroll
        for (int ps = 0; ps < 4; ++ps)
#pragma unroll
            for (int q = 0; q < 4; ++q) v[ps][q] = *(const f32x4*)(t.sp + (size_t)(4 * (kq + 16 * ps) + q) * t.src_ld + ((4 * nq) & 31));
    };
    Tile cur;
    if (blk < NT) { cur = decode(blk); fetch(cur); }
    for (int gt = blk; gt < NT; gt += nblk) {
        __syncthreads();
        const int sv = (nq & 15) << 1;
#pragma unroll
        for (int ps = 0; ps < 4; ++ps) { const int d = kq + 16 * ps;
#pragma unroll
            for (int j = 0; j < 4; ++j) *(LAS unsigned*)(lds + (4 * nq + j) * 256 + ((d ^ sv) << 2)) = pack_fp8x4(v[ps][0][j] * scale, v[ps][1][j] * scale, v[ps][2][j] * scale, v[ps][3][j] * scale); }
        unsigned char* dst = cur.dst; const int K = cur.K;
        if (gt + nblk < NT) { cur = decode(gt + nblk); fetch(cur); }
        __syncthreads();
#pragma unroll 4
        for (int r = 0; r < 16; ++r) { const int row = w * 16 + r, rv = ((row >> 2) & 15) << 1;
            const unsigned x = *(const LAS unsigned*)(lds + row * 256 + ((l ^ rv) << 2));
            *(unsigned*)(dst + (size_t)row * K + 4 * l) = x; }
    }
}

__device__ __forceinline__ void phase_prep(const Args& a, LAS unsigned char* lds, int blk, int nblk) {
    unsigned char* ws = a.ws;
    const int tid = threadIdx.x;
    if (blk == 0) { if (tid < 64) ((unsigned*)(ws + OFF_CTR))[tid] = 0u;
        for (int i = tid; i < 3456; i += NTHREADS) ((unsigned*)(ws + OFF_XBAR))[i] = 0u; }
    auto rot = [&](int off) { return (blk - off + 4 * nblk) % nblk; };
    { const float* w = a.in[I_WIN]; cvt_transpose(lds, (h16*)(ws + OFF_WINA), NA1, DM, INCOLS, [=](int n0) { return n0 < 1568 ? w + n0 : (const float*)nullptr; }, rot(0), nblk); }
    { const float* w = a.in[I_WIN]; cvt_transpose(lds, (h16*)(ws + OFF_WINHY), HYC, DM, INCOLS, [=](int n0) { return w + 1568 + n0; }, rot(56), nblk); }
    { const float* w = a.in[I_WOUT]; cvt_transpose(lds, (h16*)(ws + OFF_WOUT), DM, DM, DM, [=](int n0) { return w + n0; }, rot(104), nblk); }
    { const float* w = a.in[I_WPG]; cvt_transpose(lds, (h16*)(ws + OFF_WG), DM, DM, DM, [=](int n0) { return w + n0; }, rot(136), nblk); }
    { const float* w = a.in[I_WPP]; cvt_transpose(lds, (h16*)(ws + OFF_WP), DM, 256, DM, [=](int n0) { return w + n0; }, rot(168), nblk); }
    prep_fp8_weights(a, lds, blk, nblk);
    { const f32x4* p = (const f32x4*)a.in[I_P]; u32x2* d = (u32x2*)(ws + OFF_P16); const size_t n4 = (size_t)NTOK * 256 / 4;
        for (size_t i = (size_t)blk * NTHREADS + tid; i < n4; i += (size_t)nblk * NTHREADS) { const f32x4 v = p[i]; u32x2 o; o.x = pack_h2(v[0], v[1]); o.y = pack_h2(v[2], v[3]); d[i] = o; } }
}

__device__ __forceinline__ void phase_rmsnorm_h16(const float* X, const float* w, h16* H, int blk, int nblk) {
    constexpr int RP = 4;
    const int lane = threadIdx.x & 63, gw = blk * 8 + (threadIdx.x >> 6), nw = nblk * 8;
    f32x4 wv[4];
#pragma unroll
    for (int j = 0; j < 4; ++j) wv[j] = *(const f32x4*)(w + j * 256 + lane * 4);
    for (int row0 = gw * RP; row0 < NTOK; row0 += nw * RP) {
        f32x4 v[RP][4];
#pragma unroll
        for (int r = 0; r < RP; ++r)
#pragma unroll
            for (int j = 0; j < 4; ++j) v[r][j] = *(const f32x4*)(X + (size_t)(row0 + r) * DM + j * 256 + lane * 4);
#pragma unroll
        for (int r = 0; r < RP; ++r) {
            float ss = 0.f;
#pragma unroll
            for (int j = 0; j < 4; ++j) ss += v[r][j][0] * v[r][j][0] + v[r][j][1] * v[r][j][1] + v[r][j][2] * v[r][j][2] + v[r][j][3] * v[r][j][3];
            ss = wave_sum(ss);
            const float rstd = rsqrtf(ss * (1.0f / DM) + EPS);
            h16* hp = H + (size_t)(row0 + r) * DM;
#pragma unroll
            for (int j = 0; j < 4; ++j) { u32x2 o; o.x = pack_h2(v[r][j][0] * rstd * wv[j][0], v[r][j][1] * rstd * wv[j][1]); o.y = pack_h2(v[r][j][2] * rstd * wv[j][2], v[r][j][3] * rstd * wv[j][3]);
                *(u32x2*)(hp + j * 256 + lane * 4) = o; }
        }
    }
}

__device__ __forceinline__ void phase_combine_norm(const h16* R, const unsigned char* Y, const int* slotmap, const float* w, h16* H, float* rstd3, float* rowsq, int blk, int nblk) {
    constexpr int RP = 2;
    const int lane = threadIdx.x & 63, gw = blk * 8 + (threadIdx.x >> 6), nw = nblk * 8;
    f32x4 wv[4];
#pragma unroll
    for (int j = 0; j < 4; ++j) wv[j] = *(const f32x4*)(w + j * 256 + lane * 4);
    for (int row0 = gw * RP; row0 < NTOK; row0 += nw * RP) {
        f32x4 v[RP][4]; int myslot[RP];
#pragma unroll
        for (int r = 0; r < RP; ++r) {
            myslot[r] = (lane < NEXP) ? slotmap[(size_t)(row0 + r) * NEXP + lane] : -1;
#pragma unroll
            for (int j = 0; j < 4; ++j) { const h16x4 hv = *(const h16x4*)(R + (size_t)(row0 + r) * DM + j * 256 + lane * 4); v[r][j] = (f32x4){(float)hv[0], (float)hv[1], (float)hv[2], (float)hv[3]}; }
        }
#pragma unroll
        for (int r = 0; r < RP; ++r) {
            unsigned long long mask = __ballot(myslot[r] >= 0);
            const int b = (row0 + r) / SEQ;
            while (mask) {
                const int e = __builtin_ctzll(mask); mask &= mask - 1;
                const int sl = __shfl(myslot[r], e);
                const unsigned char* yp = Y + ((size_t)(b * NEXP + e) * CAP + sl) * DM;
                unsigned y4[4];
#pragma unroll
                for (int j = 0; j < 4; ++j) y4[j] = *(const unsigned*)(yp + j * 256 + lane * 4);
#pragma unroll
                for (int j = 0; j < 4; ++j) { const f32x2 lo = __builtin_amdgcn_cvt_pk_f32_fp8((int)y4[j], false), hi = __builtin_amdgcn_cvt_pk_f32_fp8((int)y4[j], true);
                    v[r][j][0] += lo[0] * (1.0f / g8::Y_SCALE); v[r][j][1] += lo[1] * (1.0f / g8::Y_SCALE); v[r][j][2] += hi[0] * (1.0f / g8::Y_SCALE); v[r][j][3] += hi[1] * (1.0f / g8::Y_SCALE); }
            }
        }
#pragma unroll
        for (int r = 0; r < RP; ++r) {
            float ss = 0.f;
#pragma unroll
            for (int j = 0; j < 4; ++j) { ss += v[r][j][0] * v[r][j][0] + v[r][j][1] * v[r][j][1] + v[r][j][2] * v[r][j][2] + v[r][j][3] * v[r][j][3]; }
            ss = wave_sum(ss);
            const float rstd = rsqrtf(ss * (1.0f / DM) + EPS);
            if (lane == 0) { rstd3[row0 + r] = rstd; rowsq[row0 + r] = 0.f; }
            h16* hp = H + (size_t)(row0 + r) * DM;
#pragma unroll
            for (int j = 0; j < 4; ++j) { u32x2 o; o.x = pack_h2(v[r][j][0] * rstd * wv[j][0], v[r][j][1] * rstd * wv[j][1]); o.y = pack_h2(v[r][j][2] * rstd * wv[j][2], v[r][j][3] * rstd * wv[j][3]);
                *(u32x2*)(hp + j * 256 + lane * 4) = o; }
        }
    }
}

__device__ __forceinline__ void phase_final_norm(const h16* R3H, const float* rowsq, const float* w, float* out, int blk, int nblk) {
    constexpr int RP = 4;
    const int lane = threadIdx.x & 63, gw = blk * 8 + (threadIdx.x >> 6), nw = nblk * 8;
    f32x4 wv[4];
#pragma unroll
    for (int j = 0; j < 4; ++j) wv[j] = *(const f32x4*)(w + j * 256 + lane * 4);
    for (int row0 = gw * RP; row0 < NTOK; row0 += nw * RP) {
        h16x4 v[RP][4]; float sq[RP];
#pragma unroll
        for (int r = 0; r < RP; ++r) { sq[r] = rowsq[row0 + r];
#pragma unroll
            for (int j = 0; j < 4; ++j) v[r][j] = *(const h16x4*)(R3H + (size_t)(row0 + r) * DM + j * 256 + lane * 4); }
#pragma unroll
        for (int r = 0; r < RP; ++r) {
            const float rstd = rsqrtf(sq[r] * (1.0f / DM) + EPS);
#pragma unroll
            for (int j = 0; j < 4; ++j) { f32x4 o;
#pragma unroll
                for (int q = 0; q < 4; ++q) o[q] = (float)v[r][j][q] * rstd * wv[j][q];
                *(f32x4*)(out + (size_t)(row0 + r) * DM + j * 256 + lane * 4) = o; }
        }
    }
}

__device__ __forceinline__ void phase_router(const h16* R, const float* w, const float* wrouter, unsigned char* H8, float* probs, LAS unsigned char* lds, int blk, int nblk) {
    constexpr int RP = 2;
    LAS float* wrT = (LAS float*)lds;
    const int tid = threadIdx.x, lane = tid & 63, gw = blk * 8 + (tid >> 6), nw = nblk * 8;
    __syncthreads();
    { float tmp[32];
#pragma unroll
        for (int q = 0; q < 32; ++q) { const int i = tid + NTHREADS * q, e = i >> 10, k = i & 1023; tmp[q] = wrouter[k * NEXP + e]; }
#pragma unroll
        for (int q = 0; q < 32; ++q) wrT[tid + NTHREADS * q] = tmp[q]; }
    __syncthreads();
    f32x4 wv[4];
#pragma unroll
    for (int j = 0; j < 4; ++j) wv[j] = *(const f32x4*)(w + j * 256 + lane * 4);
    const bool b5 = lane & 32, b4 = lane & 16, b3 = lane & 8, b2 = lane & 4;
    const int mye = (b5 ? 8 : 0) + (b4 ? 4 : 0) + (b3 ? 2 : 0) + (b2 ? 1 : 0);
    for (int row0 = gw * RP; row0 < NTOK; row0 += nw * RP) {
        f32x4 v[RP][4];
#pragma unroll
        for (int r = 0; r < RP; ++r)
#pragma unroll
            for (int j = 0; j < 4; ++j) { const h16x4 hv = *(const h16x4*)(R + (size_t)(row0 + r) * DM + j * 256 + lane * 4); v[r][j] = (f32x4){(float)hv[0], (float)hv[1], (float)hv[2], (float)hv[3]}; }
#pragma unroll
        for (int r = 0; r < RP; ++r) {
            float ss = 0.f;
#pragma unroll
            for (int j = 0; j < 4; ++j) ss += v[r][j][0] * v[r][j][0] + v[r][j][1] * v[r][j][1] + v[r][j][2] * v[r][j][2] + v[r][j][3] * v[r][j][3];
            ss = wave_sum(ss);
            const float rstd = rsqrtf(ss * (1.0f / DM) + EPS);
            unsigned char* hp = H8 + (size_t)(row0 + r) * DM;
#pragma unroll
            for (int j = 0; j < 4; ++j) { v[r][j] = v[r][j] * rstd * wv[j]; *(unsigned*)(hp + j * 256 + lane * 4) = pack_fp8x4(v[r][j][0], v[r][j][1], v[r][j][2], v[r][j][3]); }
        }
        float s8a[RP][8];
#pragma unroll
        for (int i = 0; i < 8; ++i) { asm volatile("" ::: "memory");
            f32x4 wa4[4], wb4[4];
#pragma unroll
            for (int j = 0; j < 4; ++j) { wa4[j] = *(const LAS f32x4*)(wrT + i * DM + j * 256 + lane * 4); wb4[j] = *(const LAS f32x4*)(wrT + (i + 8) * DM + j * 256 + lane * 4); }
#pragma unroll
            for (int r = 0; r < RP; ++r) { float sa = 0.f, sb = 0.f;
#pragma unroll
                for (int j = 0; j < 4; ++j) { sa += v[r][j][0] * wa4[j][0] + v[r][j][1] * wa4[j][1] + v[r][j][2] * wa4[j][2] + v[r][j][3] * wa4[j][3];
                                              sb += v[r][j][0] * wb4[j][0] + v[r][j][1] * wb4[j][1] + v[r][j][2] * wb4[j][2] + v[r][j][3] * wb4[j][3]; }
                const float send = b5 ? sa : sb, keep = b5 ? sb : sa; s8a[r][i] = keep + __shfl_xor(send, 32); } }
#pragma unroll
        for (int r = 0; r < RP; ++r) {
            float s8[8], s4[4], s2[2], lg;
#pragma unroll
            for (int i = 0; i < 8; ++i) s8[i] = s8a[r][i];
#pragma unroll
            for (int i = 0; i < 4; ++i) { const float send = b4 ? s8[i] : s8[i + 4], keep = b4 ? s8[i + 4] : s8[i]; s4[i] = keep + __shfl_xor(send, 16); }
#pragma unroll
            for (int i = 0; i < 2; ++i) { const float send = b3 ? s4[i] : s4[i + 2], keep = b3 ? s4[i + 2] : s4[i]; s2[i] = keep + __shfl_xor(send, 8); }
            { const float send = b2 ? s2[0] : s2[1], keep = b2 ? s2[1] : s2[0]; lg = keep + __shfl_xor(send, 4); }
            lg += __shfl_xor(lg, 1); lg += __shfl_xor(lg, 2);
            float mx = lg;
#pragma unroll
            for (int o = 4; o <= 32; o <<= 1) mx = fmaxf(mx, __shfl_xor(mx, o));
            const float ex = expf(lg - mx); float den = ex;
#pragma unroll
            for (int o = 4; o <= 32; o <<= 1) den += __shfl_xor(den, o);
            if ((lane & 3) == 0) { const int row = row0 + r, b = row / SEQ, t = row % SEQ; probs[((size_t)b * NEXP + mye) * SEQ + t] = ex / den; }
        }
    }
}

__device__ __forceinline__ void phase_topk(const float* probs, int* selidx, float* selgate, int* slotmap, LAS unsigned char* lds, int blk, int nblk) {
    LAS int* hist = (LAS int*)lds;
    LAS int* red = hist + 256;
    const int tid = threadIdx.x, lane = tid & 63, wid = tid >> 6;
    for (int g = blk; g < NB * NEXP; g += nblk) {
        const float* pp = probs + (size_t)g * SEQ;
        unsigned key[8]; float pv[8];
        { const f32x4 a = *(const f32x4*)(pp + tid * 8), b = *(const f32x4*)(pp + tid * 8 + 4);
#pragma unroll
          for (int j = 0; j < 4; ++j) { pv[j] = a[j]; pv[4 + j] = b[j]; }
#pragma unroll
          for (int j = 0; j < 8; ++j) key[j] = __float_as_uint(pv[j]); }
        unsigned prefix = 0; int krem = CAP;
#pragma unroll 1
        for (int ps = 0; ps < 4; ++ps) {
            const int shift = ps == 0 ? 23 : ps == 1 ? 15 : ps == 2 ? 7 : 0, bits = ps == 3 ? 7 : 8;
            const unsigned mhi = ~((1u << (shift + bits)) - 1u), dmask = (1u << bits) - 1u;
            __syncthreads();
            if (tid < 256) hist[tid] = 0;
            __syncthreads();
#pragma unroll
            for (int j = 0; j < 8; ++j) if ((key[j] & mhi) == (prefix & mhi)) __hip_atomic_fetch_add(hist + ((key[j] >> shift) & dmask), 1, __ATOMIC_RELAXED, __HIP_MEMORY_SCOPE_WORKGROUP);
            __syncthreads();
            if (wid == 0) {
                int c[4], tot = 0;
#pragma unroll
                for (int q = 0; q < 4; ++q) { c[q] = hist[4 * lane + q]; tot += c[q]; }
                int S = tot;
#pragma unroll
                for (int o = 1; o < 64; o <<= 1) { const int t = __shfl_down(S, o); if (lane + o < 64) S += t; }
                const int above = S - tot;
                if (above < krem && krem <= S) {
                    int acc = above, dsel = 4 * lane, kn = krem; bool done = false;
#pragma unroll
                    for (int q = 3; q >= 0; --q) { if (!done && acc + c[q] >= krem) { dsel = 4 * lane + q; kn = krem - acc; done = true; } if (!done) acc += c[q]; }
                    red[0] = dsel; red[1] = kn;
                }
            }
            __syncthreads();
            prefix |= (unsigned)red[0] << shift; krem = red[1];
        }
        int cgt = 0, ceq = 0;
#pragma unroll
        for (int j = 0; j < 8; ++j) { cgt += (key[j] > prefix) ? 1 : 0; ceq += (key[j] == prefix) ? 1 : 0; }
        int sg = cgt, se = ceq;
#pragma unroll
        for (int o = 1; o < 64; o <<= 1) { const int a = __shfl_up(sg, o), b = __shfl_up(se, o); if (lane >= o) { sg += a; se += b; } }
        __syncthreads();
        if (lane == 63) { red[32 + wid] = sg; red[48 + wid] = se; }
        __syncthreads();
        int bg = 0, be = 0;
#pragma unroll
        for (int w = 0; w < 8; ++w) { const int x = red[32 + w], y = red[48 + w]; if (w < wid) { bg += x; be += y; } }
        int pg = bg + sg - cgt, pe = be + se - ceq;
        const int need = krem;
#pragma unroll
        for (int j = 0; j < 8; ++j) {
            const bool gt = key[j] > prefix, eq = key[j] == prefix;
            const bool take = gt || (eq && pe < need);
            const int slot = pg + (pe < need ? pe : need);
            if (take) { selidx[(size_t)g * CAP + slot] = (g / NEXP) * SEQ + tid * 8 + j; selgate[(size_t)g * CAP + slot] = pv[j]; }
            slotmap[((size_t)(g / NEXP) * SEQ + tid * 8 + j) * NEXP + (g % NEXP)] = take ? slot : -1;
            pg += gt ? 1 : 0; pe += eq ? 1 : 0;
        }
    }
}

struct __attribute__((packed, aligned(2))) H8U { h16 v[8]; };
__device__ __forceinline__ void phase_filters(const Args& a, h16* GR, LAS unsigned char* lds, int blk, int nblk) {
    constexpr int NP = 16;
    LAS float* z = (LAS float*)lds;
    LAS float* h1 = z + NP * 32;
    LAS float* h2 = h1 + NP * 64;
    const int tid = threadIdx.x;
    const float* w1 = a.in[I_FW1]; const float* b1 = a.in[I_FB1]; const float* fr1 = a.in[I_FFR1];
    const float* w2 = a.in[I_FW2]; const float* b2 = a.in[I_FB2]; const float* fr2 = a.in[I_FFR2];
    const float* w3 = a.in[I_FW3]; const float* hb = a.in[I_HBIAS];
    const float MIND = logf(1e-2f) / 1.5f, MAXD = logf(1e-2f) / 0.3f;
    for (int it = blk; it < SEQ / NP; it += nblk) {
        const int t0 = it * NP;
        __syncthreads();
        if (tid < NP * 17) { const int pos = tid / 17, i = tid % 17, t = t0 + pos; float v;
            if (i == 0) v = (float)t / (float)(SEQ - 1);
            else { const int bi = (i - 1) & 7; const float f = 1e-4f + (float)bi * ((7.0f - 1e-4f) / 7.0f); const float wp = 6.283185307179586f * (float)t / (float)SEQ; const float ang = f * wp;
                float sn, cs; sincos_f(ang, sn, cs); v = (i <= 8) ? cs : -sn; }
            z[pos * 32 + i] = v; }
        __syncthreads();
#pragma unroll
        for (int hf = 0; hf < NP / 8; ++hf) { const int pos = hf * 8 + (tid >> 6), j = tid & 63; float s = b1[j];
#pragma unroll
            for (int i = 0; i < 17; ++i) s += z[pos * 32 + i] * w1[i * 64 + j];
            h1[pos * 64 + j] = sin_f(fr1[j] * s); }
        __syncthreads();
#pragma unroll
        for (int hf = 0; hf < NP / 8; ++hf) { const int pos = hf * 8 + (tid >> 6), j = tid & 63; float s = b2[j];
#pragma unroll 16
            for (int i = 0; i < 64; ++i) s += h1[pos * 64 + i] * w2[i * 64 + j];
            h2[j * NP + pos] = sin_f(fr2[j] * s); }
        __syncthreads();
#pragma unroll 1
        for (int q = 0; q < 4; ++q) {
            const int col = q * 512 + tid; float acc[NP];
#pragma unroll
            for (int p = 0; p < NP; ++p) acc[p] = 0.f;
#pragma unroll 16
            for (int j = 0; j < 64; ++j) { const float wv = w3[j * 2048 + col];
#pragma unroll
                for (int p4 = 0; p4 < NP / 4; ++p4) { const f32x4 hv = *(const LAS f32x4*)(h2 + j * NP + p4 * 4);
#pragma unroll
                    for (int p = 0; p < 4; ++p) acc[p4 * 4 + p] += hv[p] * wv; } }
            const int o = col >> 10, dir = (col >> 9) & 1, c = col & 511;
            const float delta = fabsf(MIND + (float)c * ((MAXD - MIND) / 511.0f));
            h16* gp = GR + ((size_t)o * HYW + c) * 8192;
            float vals[NP];
#pragma unroll
            for (int p = 0; p < NP; ++p) { const int t = t0 + p; const float tl = (float)t / (float)(SEQ - 1); float v = acc[p] * expf(-tl * delta);
                if (dir == 0 && t == 0) v += hb[o * HYW + c];
                vals[p] = v * HY_SCALE; }
            if (dir == 0) {
                h16x8 lo, hi;
#pragma unroll
                for (int q = 0; q < 8; ++q) { lo[q] = (h16)vals[15 - q]; hi[q] = (h16)vals[7 - q]; }
                *(h16x8*)(gp + 4080 - t0) = lo; *(h16x8*)(gp + 4088 - t0) = hi;
            } else {
                H8U lo, hi;
#pragma unroll
                for (int q = 0; q < 8; ++q) { lo.v[q] = (h16)vals[q]; hi.v[q] = (h16)vals[8 + q]; }
                if (t0 == 0) {
#pragma unroll
                    for (int q = 1; q < 8; ++q) gp[4095 + q] = lo.v[q];
                    gp[8191] = (h16)0.f;
                } else *(H8U*)(gp + 4095 + t0) = lo;
                *(H8U*)(gp + 4095 + t0 + 8) = hi;
            }
        }
    }
}

constexpr int HY_ROW = 8192, HY_UIMG = 16 * HY_ROW, HY_RING = 24;
__device__ __forceinline__ int hy_uoff(int b, int s) { return b * HY_ROW + ((((s >> 3) ^ b) << 4) | ((s & 7) << 1)); }
#define HY_MFMA(acc_, a_, b_) asm volatile("v_mfma_f32_16x16x32_f16 %0, %1, %2, %0" : "+v"(acc_) : "v"(a_), "v"(b_))
__device__ __forceinline__ void phase_hyena(const h16* __restrict__ hy, h16* __restrict__ z2, const h16* __restrict__ gr, const float* __restrict__ cw, const float* __restrict__ cb, unsigned* __restrict__ queue0, LAS unsigned char* lds, int reps) {
    const int tid = threadIdx.x, w = __builtin_amdgcn_readfirstlane(tid >> 6), l = tid & 63, bcol = l & 15, kg = l >> 4;
    LAS unsigned char* uimg = lds; LAS unsigned char* ring = lds + HY_UIMG;
    LAS int* qslot = (LAS int*)(lds + HY_UIMG + HY_RING * 1024);
    const int lbase = 4095 - (l & 15) + 8 * (l >> 4);
#pragma unroll 1
    for (int rep = 0; rep < reps; ++rep) {
    unsigned* queue = queue0 + rep;
    for (;;) {
        __syncthreads();
        if (tid == 0) *qslot = (int)atomicAdd(queue, 1u);
        __syncthreads();
        const int c = *qslot;
        if (c >= HYW) break;
        { const float w0 = cw[c], w1 = cw[HYC + c], w2 = cw[2 * HYC + c], bb = cb[c]; const int t0 = tid * 8;
#pragma unroll 8
            for (int b = 0; b < NB; ++b) {
                const h16* src = hy + (size_t)c * NTOK + (size_t)b * SEQ;
                const h16x8 rv = *(const h16x8*)(src + t0);
                const float rm = (t0 > 0) ? (float)src[t0 - 1] : 0.f, rp = (t0 + 8 < SEQ) ? (float)src[t0 + 8] : 0.f;
                float r[10]; r[0] = rm; r[9] = rp;
#pragma unroll
                for (int j = 0; j < 8; ++j) r[1 + j] = (float)rv[j];
                h16x8 o;
#pragma unroll
                for (int j = 0; j < 8; ++j) o[j] = (h16)(bb + w0 * r[j] + w1 * r[j + 1] + w2 * r[j + 2]);
                *(LAS h16x8*)(uimg + b * HY_ROW + ((tid ^ b) << 4)) = o;
            } }
#pragma unroll 1
        for (int o = 0; o < 2; ++o) {
            const h16* grp = gr + ((size_t)o * HYW + c) * 8192;
            f32x4 acc[8][4];
#pragma unroll
            for (int i = 0; i < 8; ++i)
#pragma unroll
                for (int m = 0; m < 4; ++m) acc[i][m] = (f32x4){0.f, 0.f, 0.f, 0.f};
            { const int phi = -256 + w; if (phi >= -254) { const H8U v0 = *(const H8U*)(grp + lbase - 16 * phi); *(LAS h16x8*)(ring + ((phi + 264) % HY_RING) * 1024 + l * 16) = __builtin_bit_cast(h16x8, v0); } }
            h16x8 fragA = __builtin_bit_cast(h16x8, *(const H8U*)(grp + lbase - 16 * (-248 + w))), fragB = {};
            __syncthreads();
#define HY_STEP(st_, fcur_, fnext_) do { \
                const int d0 = -64 + 2 * (st_); \
                if ((st_) < 62) fnext_ = __builtin_bit_cast(h16x8, *(const H8U*)(grp + lbase - 16 * (4 * (d0 + 4) + w))); \
                const int sbase = (4 * d0 - 2 + 264) % HY_RING; \
                _Pragma("unroll") for (int dd = 0; dd < 2; ++dd) { \
                    const int delta = d0 + dd; \
                    if (delta >= -63) { \
                        h16x8 A6[6]; \
                        _Pragma("unroll") for (int q = 0; q < 6; ++q) { int sl = sbase + 4 * dd + q; sl = sl >= HY_RING ? sl - HY_RING : sl; A6[q] = *(const LAS h16x8*)(ring + sl * 1024 + l * 16); } \
                        _Pragma("unroll") for (int i = 0; i < 8; ++i) { \
                            const int s1 = w + 8 * i - delta; \
                            if ((unsigned)s1 < 64u) { \
                                const int ch = 8 * s1 + kg; \
                                const h16x8 B0 = *(const LAS h16x8*)(uimg + bcol * HY_ROW + ((ch ^ bcol) << 4)), B1 = *(const LAS h16x8*)(uimg + bcol * HY_ROW + (((ch + 4) ^ bcol) << 4)); \
                                __builtin_amdgcn_s_setprio(1); \
                                _Pragma("unroll") for (int m = 0; m < 4; ++m) { HY_MFMA(acc[i][m], A6[m + 2], B0); HY_MFMA(acc[i][m], A6[m], B1); } \
                                __builtin_amdgcn_s_setprio(0); \
                            } } } } \
                if ((st_) < 63) *(LAS h16x8*)(ring + ((4 * (d0 + 2) + w + 264) % HY_RING) * 1024 + l * 16) = fcur_; \
                asm volatile("s_waitcnt lgkmcnt(0)" ::: "memory"); __builtin_amdgcn_s_barrier(); asm volatile("" ::: "memory"); \
            } while (0)
#pragma unroll 1
            for (int st = 0; st < 64; st += 2) { HY_STEP(st, fragA, fragB); HY_STEP(st + 1, fragB, fragA); }
#undef HY_STEP
            asm volatile("s_nop 15\n\ts_nop 15" ::: "memory");
            const int ch = (o + 1) * HYW + c;
            const float w0 = cw[ch], w1 = cw[HYC + ch], w2 = cw[2 * HYC + ch], bb = cb[ch];
            int kg_e = kg, bcol_e = bcol; asm volatile("" : "+v"(kg_e), "+v"(bcol_e));
            const h16* xsrc = hy + (size_t)ch * NTOK + (size_t)bcol_e * SEQ;
#pragma unroll
            for (int ih = 0; ih < 4; ++ih) {
                h16x4 xv[2][4]; h16 xm[2][4], xp[2][4];
#pragma unroll
                for (int ii = 0; ii < 2; ++ii)
#pragma unroll
                    for (int m = 0; m < 4; ++m) {
                        const int t = 64 * (w + 8 * (2 * ih + ii)) + 16 * m + 4 * kg_e;
                        xv[ii][m] = *(const h16x4*)(xsrc + t);
                        xm[ii][m] = (t > 0) ? xsrc[t - 1] : (h16)0.f; xp[ii][m] = (t + 4 < SEQ) ? xsrc[t + 4] : (h16)0.f;
                    }
#pragma unroll
                for (int ii = 0; ii < 2; ++ii)
#pragma unroll
                    for (int m = 0; m < 4; ++m) {
                        const int i = 2 * ih + ii;
                        const int t = 64 * (w + 8 * i) + 16 * m + 4 * kg_e;
                        float r[6]; r[0] = (float)xm[ii][m]; r[5] = (float)xp[ii][m];
#pragma unroll
                        for (int jj = 0; jj < 4; ++jj) r[1 + jj] = (float)xv[ii][m][jj];
                        h16x4 zo;
#pragma unroll
                        for (int jj = 0; jj < 4; ++jj) zo[jj] = (h16)((bb + w0 * r[jj] + w1 * r[jj + 1] + w2 * r[jj + 2]) * acc[i][m][jj] * (1.0f / HY_SCALE));
                        if (o == 0) *(LAS h16x4*)(uimg + hy_uoff(bcol_e, t)) = zo;
                        else *(h16x4*)(z2 + (size_t)c * NTOK + (size_t)bcol_e * SEQ + t) = zo;
                    }
                asm volatile("" ::: "memory");
            }
        }
    }
}
}

__device__ __forceinline__ float wave_incl_scan(float x) {
#define DPP_ADD(ctrl, rmask, bctl) x += __builtin_bit_cast(float, __builtin_amdgcn_update_dpp(0, __builtin_bit_cast(int, x), ctrl, rmask, 0xf, bctl))
    DPP_ADD(0x111, 0xf, true);
    DPP_ADD(0x112, 0xf, true);
    DPP_ADD(0x114, 0xf, true);
    DPP_ADD(0x118, 0xf, true);
    DPP_ADD(0x142, 0xa, false);
    DPP_ADD(0x143, 0xc, false);
#undef DPP_ADD
    return x;
}

constexpr int GL_QD = 0, GL_KI = 8192, GL_KDT = 16384, GL_P = 24576, GL_VT = 32768, GL_EDL = 49152, GL_WA = 49408, GL_BA = 53504, GL_QS = 54272, GL_KS = 62464, GL_VS = 70656, GL_CS = 87040;
__device__ __forceinline__ int gsw(int row, int col) { return row * 128 + ((((col >> 3) ^ (row & 7)) << 4) | ((col & 7) << 1)); }
#define GLA_BAR() do { asm volatile("s_waitcnt lgkmcnt(0)" ::: "memory"); __builtin_amdgcn_s_barrier(); asm volatile("" ::: "memory"); } while (0)
__device__ __forceinline__ void phase_gla(const h16* __restrict__ qkvg, const float* __restrict__ codes, const float* __restrict__ waf, const float* __restrict__ baf,
                          const float* __restrict__ wab, const float* __restrict__ bab, h16* __restrict__ of, h16* __restrict__ ob, LAS unsigned char* lds, int first, int stride, int reps) {
    const int tid = threadIdx.x, w = __builtin_amdgcn_readfirstlane(tid >> 6), l = tid & 63, m16 = l & 15, kg = l >> 4;
    LAS float* EDL = (LAS float*)(lds + GL_EDL); LAS float* WA = (LAS float*)(lds + GL_WA); LAS float* BA = (LAS float*)(lds + GL_BA);
    for (int item = first; item < NB * 8 * reps; item += stride) {
        const int b = (item >> 3) % NB, h = (item >> 1) & 3, dir = item & 1;
        const float* wa = dir ? wab : waf; const float* ba = dir ? bab : baf; h16* O = dir ? ob : of;
        __syncthreads();
        for (int i = tid; i < 16 * 64; i += NTHREADS) WA[i] = wa[(i >> 6) * 256 + h * 64 + (i & 63)];
        if (tid < 64) BA[tid] = ba[h * 64 + tid];
        f32x4 S[4];
#pragma unroll
        for (int m = 0; m < 4; ++m) S[m] = (f32x4){0.f, 0.f, 0.f, 0.f};
        h16x8 pq, pk, pv0, pv1; f32x4 pc;
#define GLA_ROW(n_, c_) ((size_t)b * SEQ + (dir ? (SEQ - 1 - (64 * (n_) + (c_))) : (64 * (n_) + (c_))))
#define GLA_FETCH(n_) do { const size_t rq_ = GLA_ROW(n_, tid >> 3); pq = *(const h16x8*)(qkvg + rq_ * 1536 + h * 64 + (tid & 7) * 8); pk = *(const h16x8*)(qkvg + rq_ * 1536 + 256 + h * 64 + (tid & 7) * 8); \
            const size_t rv0_ = GLA_ROW(n_, tid >> 4), rv1_ = GLA_ROW(n_, 32 + (tid >> 4)); pv0 = *(const h16x8*)(qkvg + rv0_ * 1536 + 512 + h * 128 + (tid & 15) * 8); pv1 = *(const h16x8*)(qkvg + rv1_ * 1536 + 512 + h * 128 + (tid & 15) * 8); \
            if (tid < 256) pc = *(const f32x4*)(codes + GLA_ROW(n_, tid >> 2) * 32 + dir * 16 + (tid & 3) * 4); } while (0)
#define GLA_PARK() do { { const int t_ = tid >> 3, p_ = tid & 7; *(LAS h16x8*)(lds + GL_QS + t_ * 128 + ((p_ ^ (t_ & 7)) << 4)) = pq; *(LAS h16x8*)(lds + GL_KS + t_ * 128 + ((p_ ^ (t_ & 7)) << 4)) = pk; } \
            { const int t0_ = tid >> 4, t1_ = 32 + (tid >> 4), p_ = tid & 15; *(LAS h16x8*)(lds + GL_VS + t0_ * 256 + ((p_ ^ ((t0_ & 7) << 1)) << 4)) = pv0; *(LAS h16x8*)(lds + GL_VS + t1_ * 256 + ((p_ ^ ((t1_ & 7) << 1)) << 4)) = pv1; } \
            if (tid < 256) *(LAS f32x4*)(lds + GL_CS + (tid >> 2) * 80 + (tid & 3) * 16) = pc; } while (0)
        GLA_FETCH(0);
        GLA_PARK();
        GLA_FETCH(1);
#pragma unroll 1
        for (int n = 0; n < SEQ / 64; ++n) {
            GLA_BAR();
            {
                const h16x8 cq = *(const LAS h16x8*)(lds + GL_QS + l * 128 + ((w ^ (l & 7)) << 4)), ck = *(const LAS h16x8*)(lds + GL_KS + l * 128 + ((w ^ (l & 7)) << 4));
                const h16x8 cv0 = *(const LAS h16x8*)(lds + GL_VS + l * 256 + (((2 * w) ^ ((l & 7) << 1)) << 4)), cv1 = *(const LAS h16x8*)(lds + GL_VS + l * 256 + (((2 * w + 1) ^ ((l & 7) << 1)) << 4));
                f32x4 cc[4];
#pragma unroll
                for (int r = 0; r < 4; ++r) cc[r] = *(const LAS f32x4*)(lds + GL_CS + l * 80 + r * 16);
                float z[8];
                { const f32x4 b0 = *(const LAS f32x4*)(BA + 8 * w), b1 = *(const LAS f32x4*)(BA + 8 * w + 4);
#pragma unroll
                  for (int j = 0; j < 4; ++j) { z[j] = b0[j]; z[4 + j] = b1[j]; } }
#pragma unroll
                for (int r = 0; r < 16; ++r) { const float cr = cc[r >> 2][r & 3]; const f32x4 w0 = *(const LAS f32x4*)(WA + r * 64 + 8 * w), w1 = *(const LAS f32x4*)(WA + r * 64 + 8 * w + 4);
#pragma unroll
                    for (int j = 0; j < 4; ++j) { z[j] += cr * w0[j]; z[4 + j] += cr * w1[j]; } }
                h16x8 qd, ki, kd; float edl[8];
#pragma unroll
                for (int j = 0; j < 8; ++j) {
                    const float ls = fminf(z[j], 0.f) - __logf(1.0f + __expf(-fabsf(z[j])));
                    float bb = ls * (1.0f / 16.0f);
                    bb = wave_incl_scan(bb);
                    const float bl = __builtin_bit_cast(float, __builtin_amdgcn_readlane(__builtin_bit_cast(int, bb), 63));
                    const float E = __expf(bb), Ei = __builtin_amdgcn_rcpf(E), el = __expf(bl);
                    edl[j] = el;
                    qd[j] = (h16)((float)cq[j] * 0.125f * E); const float kiv = (float)ck[j] * Ei; ki[j] = (h16)kiv; kd[j] = (h16)(kiv * el);
                }
                *(LAS h16x8*)(lds + GL_QD + l * 128 + ((w ^ (l & 7)) << 4)) = qd;
                *(LAS h16x8*)(lds + GL_KI + l * 128 + ((w ^ (l & 7)) << 4)) = ki;
#pragma unroll
                for (int j = 0; j < 8; ++j) *(LAS h16*)(lds + GL_KDT + gsw(8 * w + j, l)) = kd[j];
#pragma unroll
                for (int j = 0; j < 8; ++j) { *(LAS h16*)(lds + GL_VT + gsw(16 * w + j, l)) = cv0[j]; *(LAS h16*)(lds + GL_VT + gsw(16 * w + 8 + j, l)) = cv1[j]; }
                if (l == 0) {
#pragma unroll
                    for (int j = 0; j < 8; ++j) EDL[8 * w + j] = edl[j]; }
            }
            GLA_BAR();
            {
                const int mi = w & 3;
                h16x8 Aq[2];
                Aq[0] = *(const LAS h16x8*)(lds + GL_QD + gsw(16 * mi + m16, 8 * kg)); Aq[1] = *(const LAS h16x8*)(lds + GL_QD + gsw(16 * mi + m16, 32 + 8 * kg));
#pragma unroll
                for (int q = 0; q < 2; ++q) {
                    const int nj = 2 * (w >> 2) + q;
                    if (nj <= mi) {
                        const h16x8 B0 = *(const LAS h16x8*)(lds + GL_KI + gsw(16 * nj + m16, 8 * kg)), B1 = *(const LAS h16x8*)(lds + GL_KI + gsw(16 * nj + m16, 32 + 8 * kg));
                        f32x4 p = (f32x4){0.f, 0.f, 0.f, 0.f};
                        p = __builtin_amdgcn_mfma_f32_16x16x32_f16(Aq[0], B0, p, 0, 0, 0);
                        p = __builtin_amdgcn_mfma_f32_16x16x32_f16(Aq[1], B1, p, 0, 0, 0);
#pragma unroll
                        for (int r = 0; r < 4; ++r) { const int c = 16 * mi + 4 * kg + r, cp = 16 * nj + m16; const bool keep = dir ? (cp < c) : (cp <= c);
                            *(LAS h16*)(lds + GL_P + gsw(c, cp)) = (h16)(keep ? p[r] : 0.f); }
                    } else if ((nj >> 1) == (mi >> 1)) {
#pragma unroll
                        for (int r = 0; r < 4; ++r) *(LAS h16*)(lds + GL_P + gsw(16 * mi + 4 * kg + r, 16 * nj + m16)) = (h16)0.f;
                    }
                }
            }
            GLA_BAR();
            {
                h16x8 Bv[2];
                Bv[0] = *(const LAS h16x8*)(lds + GL_VT + gsw(16 * w + m16, 8 * kg)); Bv[1] = *(const LAS h16x8*)(lds + GL_VT + gsw(16 * w + m16, 32 + 8 * kg));
                h16x8 Sf[2];
#pragma unroll
                for (int ks = 0; ks < 2; ++ks)
#pragma unroll
                    for (int j = 0; j < 4; ++j) { Sf[ks][j] = (h16)S[2 * ks][j]; Sf[ks][4 + j] = (h16)S[2 * ks + 1][j]; }
#pragma unroll
                for (int mi = 0; mi < 4; ++mi) {
                    f32x4 o = (f32x4){0.f, 0.f, 0.f, 0.f};
#pragma unroll
                    for (int ks = 0; ks < 2; ++ks) {
                        if (!(ks == 1 && mi < 2)) { const h16x8 Ap = *(const LAS h16x8*)(lds + GL_P + gsw(16 * mi + m16, 32 * ks + 8 * kg)); o = __builtin_amdgcn_mfma_f32_16x16x32_f16(Ap, Bv[ks], o, 0, 0, 0); }
                        const h16x4 a0 = *(const LAS h16x4*)(lds + GL_QD + gsw(16 * mi + m16, 32 * ks + 4 * kg)), a1 = *(const LAS h16x4*)(lds + GL_QD + gsw(16 * mi + m16, 32 * ks + 16 + 4 * kg));
                        h16x8 Aqs;
#pragma unroll
                        for (int j = 0; j < 4; ++j) { Aqs[j] = a0[j]; Aqs[4 + j] = a1[j]; }
                        o = __builtin_amdgcn_mfma_f32_16x16x32_f16(Aqs, Sf[ks], o, 0, 0, 0);
                    }
#pragma unroll
                    for (int r = 0; r < 4; ++r) { const int c = 16 * mi + 4 * kg + r; const int tok = dir ? (SEQ - 1 - (64 * n + c)) : (64 * n + c);
                        O[((size_t)b * SEQ + tok) * 512 + h * 128 + 16 * w + m16] = (h16)o[r]; }
                }
#pragma unroll
                for (int mt = 0; mt < 4; ++mt) {
                    const f32x4 e4 = *(const LAS f32x4*)(EDL + 16 * mt + 4 * kg);
                    S[mt] = S[mt] * e4;
#pragma unroll
                    for (int ks = 0; ks < 2; ++ks) { const h16x8 Ak = *(const LAS h16x8*)(lds + GL_KDT + gsw(16 * mt + m16, 32 * ks + 8 * kg)); S[mt] = __builtin_amdgcn_mfma_f32_16x16x32_f16(Ak, Bv[ks], S[mt], 0, 0, 0); }
                }
            }
            if (n + 1 < SEQ / 64) GLA_PARK();
            if (n + 2 < SEQ / 64) GLA_FETCH(n + 2);
        }
    }
}

__device__ __forceinline__ void phase_mixbuild(const h16* __restrict__ of, const h16* __restrict__ ob, const h16* __restrict__ qkvg, const float* __restrict__ nw, const h16* __restrict__ z2,
                               h16* __restrict__ mix, LAS unsigned char* lds, int blk, int nblk) {
    LAS h16* tileT = (LAS h16*)lds;
    const int tid = threadIdx.x;
    float nwv[8];
#pragma unroll
    for (int j = 0; j < 8; ++j) nwv[j] = nw[(tid & 15) * 8 + j];
    for (int sl = blk; sl < NTOK / 64; sl += nblk) {
        const int tok0 = sl * 64;
        h16x8 zv[8];
#pragma unroll
        for (int i = 0; i < 8; ++i) zv[i] = *(const h16x8*)(z2 + (size_t)tid * NTOK + tok0 + 8 * i);
#pragma unroll 2
        for (int i = 0; i < 8; ++i) {
            const int task = tid + NTHREADS * i, token = task >> 6, head = (task >> 4) & 3, part = task & 15;
            const size_t row = (size_t)tok0 + token;
            const h16x8 a = *(const h16x8*)(of + row * 512 + head * 128 + part * 8), b = *(const h16x8*)(ob + row * 512 + head * 128 + part * 8);
            const h16x8 g = *(const h16x8*)(qkvg + row * 1536 + 1024 + head * 128 + part * 8);
            float o[8], ss = 0.f;
#pragma unroll
            for (int j = 0; j < 8; ++j) { o[j] = (float)a[j] + (float)b[j]; ss += o[j] * o[j]; }
            ss += __shfl_xor(ss, 1); ss += __shfl_xor(ss, 2); ss += __shfl_xor(ss, 4); ss += __shfl_xor(ss, 8);
            const float rstd = rsqrtf(ss * (1.0f / 128.0f) + EPS);
            h16x8 r;
#pragma unroll
            for (int j = 0; j < 8; ++j) r[j] = (h16)(o[j] * rstd * nwv[j] * siluf_((float)g[j]));
            *(h16x8*)(mix + row * DM + head * 128 + part * 8) = r;
        }
        __syncthreads();
#pragma unroll
        for (int i = 0; i < 8; ++i)
#pragma unroll
            for (int j = 0; j < 8; ++j) tileT[(8 * i + j) * 520 + tid] = zv[i][j];
        __syncthreads();
#pragma unroll
        for (int i = 0; i < 8; ++i) { const int idx = tid + NTHREADS * i, token = idx >> 6, c8 = (idx & 63) * 8;
            *(h16x8*)(mix + (size_t)(tok0 + token) * DM + 512 + c8) = *(const LAS h16x8*)(tileT + token * 520 + c8); }
    }
}

#define XB_TMO      128
#define XB_XCNT(j)  (256  + 64 * (j))
#define XB_XSUB(j)  (1280 + 64 * (j))
#define XB_XGEN(j)  (2304 + 64 * (j))
#define XB_TOP      3328
#define XB_TOPGEN   3392
#define XCD_BAR_WORDS 3456
#define XB_SPIN_CAP (1u << 22)
__device__ __forceinline__ unsigned xb_ld(unsigned* p)              { return __hip_atomic_load(p, __ATOMIC_RELAXED, __HIP_MEMORY_SCOPE_AGENT); }
__device__ __forceinline__ unsigned xb_add(unsigned* p, unsigned v) { return __hip_atomic_fetch_add(p, v, __ATOMIC_RELAXED, __HIP_MEMORY_SCOPE_AGENT); }
__device__ __forceinline__ unsigned xb_xcc_id() { return (unsigned)__builtin_amdgcn_s_getreg((3 << 11) | 20) & 0xFu; }
#define XB_SPIN(cond, bar) do { unsigned _sp = 0; while (cond) { __builtin_amdgcn_s_sleep(1); \
    if ((++_sp & 255u) == 0u) { if (xb_ld(&(bar)[XB_TMO])) break; if (_sp > XB_SPIN_CAP) { atomicAdd(&(bar)[XB_TMO], 1u); break; } } } } while (0)
struct XcdBarrier { unsigned* bar; unsigned x; volatile LAS unsigned* st; };
__device__ __forceinline__ void xcd_barrier_post(unsigned* bar) {
    if (threadIdx.x == 0) (void)xb_add(&bar[XB_XCNT(xb_xcc_id())], 1u);
}
__device__ __forceinline__ void xcd_barrier_complete(unsigned* bar, unsigned x, unsigned& nloc, unsigned& nx) {
    const unsigned G = gridDim.x * gridDim.y * gridDim.z;
    unsigned sum, cnt, mine, sp = 0u;
    for (;;) {
        sum = 0u; cnt = 0u; mine = 0u;
#pragma unroll
        for (unsigned j = 0; j < 16; ++j) { const unsigned c = xb_ld(&bar[XB_XCNT(j)]); sum += c; cnt += (c > 0u) ? 1u : 0u; mine = (j == x) ? c : mine; }
        if (sum == G) break;
        __builtin_amdgcn_s_sleep(1);
        if ((++sp & 255u) == 0u) { if (xb_ld(&bar[XB_TMO])) break; if (sp > XB_SPIN_CAP) { atomicAdd(&bar[XB_TMO], 1u); break; } }
    }
    nloc = mine > 0u ? mine : 1u; nx = cnt > 0u ? cnt : 1u;
}
__device__ __forceinline__ void xcd_barrier(unsigned* bar_, volatile LAS unsigned* st_) {
    XcdBarrier b; b.bar = bar_; b.x = xb_xcc_id(); b.st = st_;
    asm volatile("s_waitcnt vmcnt(0)" ::: "memory");
    __syncthreads();
    if (threadIdx.x == 0) {
        unsigned* bar = b.bar;
        __builtin_amdgcn_s_waitcnt(0);
        unsigned nloc = b.st[0], nx = b.st[1];
        if (nloc == 0u) { xcd_barrier_complete(bar, b.x, nloc, nx); b.st[0] = nloc; b.st[1] = nx; }
        const unsigned old = xb_add(&bar[XB_XSUB(b.x)], 1u);
        const unsigned gen = old / nloc;
        if (old + 1u == (gen + 1u) * nloc) {
            __builtin_amdgcn_fence(__ATOMIC_RELEASE, "agent");
            asm volatile("s_waitcnt vmcnt(0)" ::: "memory");
            const unsigned og = xb_add(&bar[XB_TOP], 1u);
            const unsigned tg = og / nx;
            if (og + 1u == (tg + 1u) * nx) xb_add(&bar[XB_TOPGEN], 1u);
            else XB_SPIN(xb_ld(&bar[XB_TOPGEN]) == tg, bar);
            __builtin_amdgcn_fence(__ATOMIC_ACQUIRE, "agent");
            xb_add(&bar[XB_XGEN(b.x)], 1u);
            asm volatile("s_waitcnt vmcnt(0)" ::: "memory");
        } else {
            XB_SPIN(xb_ld(&bar[XB_XGEN(b.x)]) == gen, bar);
            __builtin_amdgcn_fence(__ATOMIC_ACQUIRE, "agent");
            asm volatile("s_waitcnt vmcnt(0)" ::: "memory");
        }
    }
    __syncthreads();
}

enum { PH_PREP = 0, PH_NORM1, PH_FILT, PH_G1A, PH_G1B, PH_GLA, PH_HYENA, PH_GLAMIX, PH_G2, PH_ROUTER, PH_TOPK, PH_MOE1, PH_MOE2, PH_NORM3, PH_G5, PH_G6, PH_FINAL, PH_COUNT };

template <bool COOP>
__global__ __launch_bounds__(NTHREADS, 2) void mega(Args a) {
    extern __shared__ __attribute__((aligned(16))) unsigned char shm[];
    LAS unsigned char* lds = (LAS unsigned char*)shm;
    const int blk = blockIdx.x, nblk = gridDim.x;
    unsigned char* ws = a.ws;
#ifndef PROBE_MASK
#define PROBE_MASK 0u
#endif
#define RUN(P, SYNC, ...) if (a.ph_lo <= (P) && (P) < a.ph_hi) { { __syncthreads(); const float pscale = 1.f; (void)pscale; __VA_ARGS__ } \
        if constexpr (((PROBE_MASK >> (P)) & 1u) != 0u && (P) != PH_GLA && (P) != PH_HYENA) { if (COOP) cg::this_grid().sync(); __syncthreads(); const float pscale = 0.f; (void)pscale; __VA_ARGS__ } \
        if (COOP && (SYNC) != 0 && (P) + 1 < a.ph_hi) { if ((SYNC) == 1) { cg::this_grid().sync(); xcd_barrier_post((unsigned*)(a.ws + OFF_XBAR)); } else xcd_barrier((unsigned*)(a.ws + OFF_XBAR), (volatile LAS unsigned*)(lds + LDS_BYTES - 16)); } }
    if (threadIdx.x < 4) ((volatile LAS unsigned*)(lds + LDS_BYTES - 16))[threadIdx.x] = 0u;
    __syncthreads();
    RUN(PH_PREP, 0, phase_prep(a, lds, blk, nblk);)
    RUN(PH_NORM1, 0, phase_rmsnorm_h16(a.in[I_X], a.in[I_LNMIX], (h16*)(ws + OFF_H), blk, nblk);)
    RUN(PH_FILT, 1, phase_filters(a, (h16*)(ws + OFF_GR), lds, blk, nblk);)
    RUN(PH_G1A, 0, { g8::DenseSched S; S.init(ws + OFF_WINA, NTOK, NA1, DM, nblk, blk); g8::EpiQKVG E{(h16*)(ws + OFF_QKVG), (float*)(ws + OFF_CODES)};
        g8::gemm_phase(lds, (const char*)(ws + OFF_H), DM, S, E); })
    RUN(PH_G1B, 2, { g8::DenseSched S; S.init(ws + OFF_H, HYC, NTOK, DM, nblk, blk); g8::EpiH16 E{(h16*)(ws + OFF_HY), NTOK};
        g8::gemm_phase(lds, (const char*)(ws + OFF_WINHY), DM, S, E); })
    RUN(PH_GLA, 0, { const int ng = nblk >= 2 * NB * 8 ? NB * 8 : nblk;
        if (blk >= nblk - ng) phase_gla((const h16*)(ws + OFF_QKVG), (const float*)(ws + OFF_CODES), a.in[I_WAF], a.in[I_BAF], a.in[I_WAB], a.in[I_BAB], (h16*)(ws + OFF_OF), (h16*)(ws + OFF_OB), lds, blk - (nblk - ng), ng, 1 + (int)((PROBE_MASK >> 5) & 1u)); })
    RUN(PH_HYENA, 2, phase_hyena((const h16*)(ws + OFF_HY), (h16*)(ws + OFF_Z2), (const h16*)(ws + OFF_GR), a.in[I_HCW], a.in[I_HCB], (unsigned*)(ws + OFF_CTR), lds, 1 + (int)((PROBE_MASK >> 6) & 1u));)
    RUN(PH_GLAMIX, 2, phase_mixbuild((const h16*)(ws + OFF_OF), (const h16*)(ws + OFF_OB), (const h16*)(ws + OFF_QKVG), a.in[I_GLANW], (const h16*)(ws + OFF_Z2), (h16*)(ws + OFF_H), lds, blk, nblk);)
    RUN(PH_G2, 2, { g8::DenseSched S; S.init(ws + OFF_WOUT, NTOK, DM, DM, nblk, blk); g8::EpiResid E{a.in[I_X], (h16*)a.out};
        g8::gemm_phase(lds, (const char*)(ws + OFF_H), DM, S, E); })
    RUN(PH_ROUTER, 2, phase_router((const h16*)a.out, a.in[I_LNFFN], a.in[I_WROUTER], ws + OFF_H, (float*)(ws + OFF_PROBS), lds, blk, nblk);)
    RUN(PH_TOPK, 2, phase_topk((const float*)(ws + OFF_PROBS), (int*)(ws + OFF_SELIDX), (float*)(ws + OFF_SELGATE), (int*)(ws + OFF_SLOTMAP), lds, blk, nblk);)
    RUN(PH_MOE1, 2, { LAS unsigned short* lrow = (LAS unsigned short*)(lds + g8::STAGE_BYTES); g8::Moe1Sched S{(const char*)(ws + OFF_WGU), (const int*)(ws + OFF_SELIDX), nblk, blk, lrow}; S.preload(lrow); g8::EpiHid E{ws + OFF_HID};
        g8::gemm_phase<g8::EpiHid, g8::Moe1Sched, true>(lds, (const char*)(ws + OFF_H), DM / 2, S, E); })
    RUN(PH_MOE2, 2, { g8::Moe2Sched S{(const char*)(ws + OFF_WD), nblk, blk}; g8::EpiDown E{ws + OFF_Y, (const float*)(ws + OFF_SELGATE)};
        g8::gemm_phase<g8::EpiDown, g8::Moe2Sched, true>(lds, (const char*)(ws + OFF_HID), DFF / 2, S, E); })
    RUN(PH_NORM3, 0, phase_combine_norm((const h16*)a.out, ws + OFF_Y, (const int*)(ws + OFF_SLOTMAP), a.in[I_LNPLE], (h16*)(ws + OFF_H3), (float*)(ws + OFF_RSTD3), (float*)(ws + OFF_ROWSQ), blk, nblk);)
    RUN(PH_G5, 2, { g8::DenseSched S; S.init(ws + OFF_WP, NTOK, DM, 256, nblk, blk); g8::EpiH16 E{(h16*)(ws + OFF_PP), DM};
        g8::gemm_phase(lds, (const char*)(ws + OFF_P16), 256, S, E); })
    RUN(PH_G6, 2, { g8::DenseSched S; S.init(ws + OFF_WG, NTOK, DM, DM, nblk, blk); g8::EpiPle E{(const h16*)(ws + OFF_H3), (const float*)(ws + OFF_RSTD3), a.in[I_LNPLE], (const h16*)(ws + OFF_PP), (h16*)(ws + OFF_R3H), (float*)(ws + OFF_ROWSQ)};
        g8::gemm_phase(lds, (const char*)(ws + OFF_H3), DM, S, E); })
    RUN(PH_FINAL, 0, phase_final_norm((const h16*)(ws + OFF_R3H), (const float*)(ws + OFF_ROWSQ), a.in[I_FNW], a.out, blk, nblk);)
}

extern "C" void kernel_launch(void* const* d_in, const int* in_sizes, int n_in, void* d_out, int out_size, void* d_ws, size_t ws_size, hipStream_t stream) {
    static int grid = 0;
    if (grid == 0) {
        if (n_in != N_IN || out_size != NTOK * DM || ws_size < WS_END) { fprintf(stderr, "kernel_launch: unexpected shapes (n_in %d, out %d, ws %zu, need %zu)\n", n_in, out_size, ws_size, (size_t)WS_END); grid = -1; return; }
        int dev = 0, cus = 0, per_cu = 0;
        (void)hipGetDevice(&dev); (void)hipDeviceGetAttribute(&cus, hipDeviceAttributeMultiprocessorCount, dev);
        (void)hipFuncSetAttribute((const void*)mega<true>, hipFuncAttributeMaxDynamicSharedMemorySize, LDS_BYTES);
        (void)hipOccupancyMaxActiveBlocksPerMultiprocessor(&per_cu, (const void*)mega<true>, NTHREADS, LDS_BYTES);
        if (per_cu < 1) { fprintf(stderr, "kernel_launch: occupancy query says %d blocks per CU\n", per_cu); per_cu = 1; }
        grid = cus * (per_cu > 1 ? 1 : per_cu);
        (void)hipGetLastError();
    }
    if (grid < 0) return;
    Args a{};
    for (int i = 0; i < N_IN; ++i) a.in[i] = (const float*)d_in[i];
    a.out = (float*)d_out; a.ws = (unsigned char*)d_ws;
    a.ph_lo = 0; a.ph_hi = PH_COUNT;
    void* args[] = {&a};
    hipError_t e = hipLaunchCooperativeKernel((const void*)mega<true>, dim3(grid), dim3(NTHREADS), args, LDS_BYTES, stream);
    if (e != hipSuccess) fprintf(stderr, "kernel_launch: cooperative launch failed: %s (grid %d)\n", hipGetErrorString(e), grid);
}
```

```cpp
#include <hip/hip_runtime.h>
#include <hip/hip_cooperative_groups.h>
#include <cstdio>
#include <cstdint>
#include <cstddef>

namespace cg = cooperative_groups;

#define LAS __attribute__((address_space(3)))
typedef _Float16 h16;
typedef _Float16 h16x8 __attribute__((ext_vector_type(8)));
typedef _Float16 h16x4 __attribute__((ext_vector_type(4)));
typedef _Float16 h16x2 __attribute__((ext_vector_type(2)));
typedef float f32x4 __attribute__((ext_vector_type(4)));
typedef float f32x2 __attribute__((ext_vector_type(2)));
typedef unsigned u32x4 __attribute__((ext_vector_type(4)));
typedef unsigned u32x2 __attribute__((ext_vector_type(2)));
typedef int i32x8 __attribute__((ext_vector_type(8)));
typedef int i32x4 __attribute__((ext_vector_type(4)));

constexpr int NB = 16, SEQ = 4096, DM = 1024, NTOK = NB * SEQ;
constexpr int INCOLS = 3104;
constexpr int NEXP = 16, CAP = 512, DFF = 2048;
constexpr int HYW = 512, HYC = 1536;
constexpr float EPS = 1e-6f;

enum { I_X = 0, I_P, I_LNMIX, I_WIN, I_WAF, I_BAF, I_WAB, I_BAB, I_GLANW, I_HCW, I_HCB, I_FW1, I_FB1, I_FFR1, I_FW2, I_FB2, I_FFR2,
       I_FW3, I_HBIAS, I_WOUT, I_LNFFN, I_WROUTER, I_WGATE, I_WUP, I_WDOWN, I_LNPLE, I_WPG, I_WPP, I_FNW, N_IN };

constexpr size_t AL(size_t x) { return (x + 255) & ~(size_t)255; }
constexpr int NA1 = 1792;
constexpr size_t OFF_WINA = 0;
constexpr size_t OFF_WINHY = OFF_WINA + AL((size_t)NA1 * DM * 2);
constexpr size_t OFF_WOUT = OFF_WINHY + AL((size_t)HYC * DM * 2);
constexpr size_t OFF_WGU = OFF_WOUT + AL((size_t)DM * DM * 2);
constexpr size_t OFF_WD = OFF_WGU + AL((size_t)NEXP * 2 * DFF * DM * 2);
constexpr size_t OFF_WG = OFF_WD + AL((size_t)NEXP * DM * DFF * 2);
constexpr size_t OFF_WP = OFF_WG + AL((size_t)DM * DM * 2);
constexpr size_t OFF_P16 = OFF_WP + AL((size_t)DM * 256 * 2);
constexpr size_t OFF_PROBS = OFF_P16 + AL((size_t)NTOK * 256 * 2);
constexpr size_t OFF_SELIDX = OFF_PROBS + AL((size_t)NB * NEXP * SEQ * 4);
constexpr size_t OFF_SELGATE = OFF_SELIDX + AL((size_t)NB * NEXP * CAP * 4);
constexpr size_t OFF_SLOTMAP = OFF_SELGATE + AL((size_t)NB * NEXP * CAP * 4);
constexpr size_t OFF_CTR = OFF_SLOTMAP + AL((size_t)NTOK * NEXP * 4);
constexpr size_t OFF_XBAR = OFF_CTR + 256;
constexpr size_t OFF_BIG = OFF_XBAR + AL(3456 * 4);
constexpr size_t OFF_QKVG = OFF_BIG;
constexpr size_t OFF_HY = OFF_QKVG + AL((size_t)NTOK * 1536 * 2);
constexpr size_t OFF_CODES = OFF_HY + AL((size_t)HYC * NTOK * 2);
constexpr size_t OFF_OF = OFF_CODES + AL((size_t)NTOK * 32 * 4);
constexpr size_t OFF_OB = OFF_OF + AL((size_t)NTOK * 512 * 2);
constexpr size_t OFF_GR = OFF_OB + AL((size_t)NTOK * 512 * 2);
constexpr size_t OFF_H = OFF_GR + AL((size_t)2 * HYW * 8192 * 2);
constexpr size_t OFF_Z2 = OFF_H + AL((size_t)NTOK * DM * 2);
constexpr size_t END_A = OFF_Z2 + AL((size_t)HYW * NTOK * 2);
constexpr size_t OFF_HID = OFF_BIG;
constexpr size_t OFF_Y = OFF_HID + AL((size_t)NB * NEXP * CAP * DFF * 2);
constexpr size_t END_B = OFF_Y + AL((size_t)NB * NEXP * CAP * DM * 2);
static_assert(OFF_H >= OFF_Y, "h2 (read by the up/gate GEMM) must not be overwritten by HID");
constexpr size_t OFF_H3 = OFF_BIG;
constexpr size_t OFF_PP = OFF_H3 + AL((size_t)NTOK * DM * 2);
constexpr size_t OFF_R3H = OFF_PP + AL((size_t)NTOK * DM * 2);
constexpr size_t OFF_RSTD3 = OFF_R3H + AL((size_t)NTOK * DM * 2);
constexpr size_t OFF_ROWSQ = OFF_RSTD3 + AL((size_t)NTOK * 4);
constexpr size_t END_C = OFF_ROWSQ + AL((size_t)NTOK * 4);
constexpr size_t WS_END = END_A > END_B ? (END_A > END_C ? END_A : END_C) : (END_B > END_C ? END_B : END_C);

constexpr int NTHREADS = 512;
constexpr int LDS_BYTES = 156 * 1024;
constexpr float HY_SCALE = 64.0f;
constexpr int FP8_WSHIFT = 5;


struct Args {
    const float* in[N_IN];
    float* out;
    unsigned char* ws;
    int ph_lo, ph_hi;
};

__device__ __forceinline__ float wave_sum(float v) {
#pragma unroll
    for (int o = 32; o >= 1; o >>= 1) v += __shfl_xor(v, o);
    return v;
}
__device__ __forceinline__ float sigmoidf_(float x) { return __builtin_amdgcn_rcpf(1.0f + __expf(-x)); }
__device__ __forceinline__ float siluf_(float x) { return x * __builtin_amdgcn_rcpf(1.0f + __expf(-x)); }
__device__ __forceinline__ unsigned pack_h2(float a, float b) {
    h16x2 v; v.x = (h16)a; v.y = (h16)b; return __builtin_bit_cast(unsigned, v);
}


__device__ __forceinline__ void sincos_f(float x, float& s, float& c) {
    const float kf = rintf(x * 0.6366197723675814f);
    float r = fmaf(kf, -1.5707963705062866f, x); r = fmaf(kf, 4.371139000186241e-8f, r);
    const float r2 = r * r;
    const float sp = r + r * r2 * (-1.6666667e-1f + r2 * (8.3333338e-3f + r2 * (-1.9841270e-4f + r2 * 2.7557319e-6f)));
    const float cp = 1.0f + r2 * (-0.5f + r2 * (4.1666668e-2f + r2 * (-1.3888889e-3f + r2 * (2.4801587e-5f - r2 * 2.7557319e-7f))));
    const int k = (int)kf & 3;
    s = (k == 0) ? sp : (k == 1) ? cp : (k == 2) ? -sp : -cp;
    c = (k == 0) ? cp : (k == 1) ? -sp : (k == 2) ? -cp : sp;
}
__device__ __forceinline__ float sin_f(float x) { float s, c; sincos_f(x, s, c); return s; }

__device__ __forceinline__ unsigned pack_fp8x4(float a, float b, float c, float d) {
    int r = 0; r = __builtin_amdgcn_cvt_pk_fp8_f32(a, b, r, false); r = __builtin_amdgcn_cvt_pk_fp8_f32(c, d, r, true); return (unsigned)r;
}

namespace g8 {
constexpr int BM = 256, BK = 64, HALF = 128, HTB = HALF * BK * 2, STAGE_BYTES = 8 * HTB;
__device__ __forceinline__ int lds_byte(int r, int c) { const int st = (r >> 4) * 2 + (c >> 5), rr = r & 15, cc = c & 31, ob = rr * 64 + cc * 2; return st * 1024 + (ob ^ (((ob >> 9) & 1) << 5)); }
__device__ __forceinline__ void stage_rc(int b, int& R, int& C) { const int st = b / 1024, sb = b % 1024, swz = sb ^ (((sb >> 9) & 1) << 5); R = (st >> 1) * 16 + swz / 64; C = (st & 1) * 32 + (swz % 64) / 2; }
__device__ __forceinline__ int perm32(int rho) { const int n = rho >> 4, i = rho & 15; return 8 * (i >> 2) + 4 * n + (i & 3); }

struct Unit { const char* B; int pm, pn, g; unsigned rowbase; int ord; };

template <class Epi, class Sched, bool FP8 = false>
__device__ __forceinline__ void gemm_phase(LAS unsigned char* lds, const char* A, const int K, const Sched& S, const Epi& E) {
    const int tid = threadIdx.x, wid = __builtin_amdgcn_readfirstlane(tid >> 6), lane = tid & 63, wr = wid >> 2, wc = wid & 3, fr = lane & 15, fq = lane >> 4;
    const int nt = K / BK;
    int Rr[2], Cc[2]; unsigned voffB[2];
#pragma unroll
    for (int i = 0; i < 2; ++i) { stage_rc(tid * 16 + i * 8192, Rr[i], Cc[i]); const int Rb = Epi::PERM ? ((Rr[i] & ~31) + perm32(Rr[i] & 31)) : Rr[i];
        voffB[i] = (unsigned)(Rb * K + Cc[i]) * 2u; }
    const size_t kstep = (size_t)(BK * 2);
    const size_t hstep = (size_t)HALF * K * 2;
    const unsigned ldsw = (unsigned)wid * 1024u;
    const int aoff = lds_byte(wr * 64 + fr, fq * 8), boff = lds_byte(wc * 32 + fr, fq * 8);
#define G8_SA(b, h) (((b) * 2 + (h)) * HTB)
#define G8_SB(b, h) ((4 + (b) * 2 + (h)) * HTB)
#define G8_STAGE(bufoff, gbase, v0, v1) do { \
        __builtin_amdgcn_global_load_lds((const unsigned*)((const char*)(gbase) + (v0)), (LAS unsigned*)(lds + (bufoff) + ldsw), 16, 0, 0); \
        __builtin_amdgcn_global_load_lds((const unsigned*)((const char*)(gbase) + (v1)), (LAS unsigned*)(lds + (bufoff) + ldsw + 8192), 16, 0, 0); } while (0)
#define G8_LDA(dst, b, h) do { _Pragma("unroll") for (int m = 0; m < 4; ++m) { \
        const i32x4 lo_ = *(const LAS i32x4*)(lds + G8_SA(b, h) + aoff + m * 2048), hi_ = *(const LAS i32x4*)(lds + G8_SA(b, h) + aoff + m * 2048 + 1024); \
        dst[m] = __builtin_shufflevector(lo_, hi_, 0, 1, 2, 3, 4, 5, 6, 7); } } while (0)
#define G8_LDB(dst, b, h) do { _Pragma("unroll") for (int n = 0; n < 2; ++n) { \
        const i32x4 lo_ = *(const LAS i32x4*)(lds + G8_SB(b, h) + boff + n * 2048), hi_ = *(const LAS i32x4*)(lds + G8_SB(b, h) + boff + n * 2048 + 1024); \
        dst[n] = __builtin_shufflevector(lo_, hi_, 0, 1, 2, 3, 4, 5, 6, 7); } } while (0)
#define G8_MMA(ai, bj, At, Bt) do { __builtin_amdgcn_s_setprio(1); \
        if constexpr (FP8) { _Pragma("unroll") for (int m = 0; m < 4; ++m) _Pragma("unroll") for (int n = 0; n < 2; ++n) \
            asm volatile("v_mfma_scale_f32_16x16x128_f8f6f4 %0, %1, %2, %0, %3, %3 op_sel_hi:[0,0,0]" : "+v"(acc[ai][bj][m][n]) : "v"(Bt[n]), "v"(At[m]), "v"(sc_one)); } \
        else { _Pragma("unroll") for (int m = 0; m < 4; ++m) _Pragma("unroll") for (int n = 0; n < 2; ++n) { \
            const i32x8 a_ = At[m], b_ = Bt[n]; \
            const h16x8 a0_ = __builtin_bit_cast(h16x8, __builtin_shufflevector(a_, a_, 0, 1, 2, 3)), a1_ = __builtin_bit_cast(h16x8, __builtin_shufflevector(a_, a_, 4, 5, 6, 7)); \
            const h16x8 b0_ = __builtin_bit_cast(h16x8, __builtin_shufflevector(b_, b_, 0, 1, 2, 3)), b1_ = __builtin_bit_cast(h16x8, __builtin_shufflevector(b_, b_, 4, 5, 6, 7)); \
            acc[ai][bj][m][n] = __builtin_amdgcn_mfma_f32_16x16x32_f16(b0_, a0_, acc[ai][bj][m][n], 0, 0, 0); \
            acc[ai][bj][m][n] = __builtin_amdgcn_mfma_f32_16x16x32_f16(b1_, a1_, acc[ai][bj][m][n], 0, 0, 0); } } \
        __builtin_amdgcn_s_setprio(0); } while (0)
#define G8_WAIT_V(n) asm volatile("s_waitcnt vmcnt(" #n ")" ::: "memory")
#define G8_WAIT_L(n) asm volatile("s_waitcnt lgkmcnt(" #n ")" ::: "memory")
#define G8_BAR __builtin_amdgcn_s_barrier()
#define G8_SCHED __builtin_amdgcn_sched_barrier(0)
    Unit cur, nxt; int ui = 0;
    if (!S.next(0, cur)) return;
    f32x4 acc[2][2][4][2];
#pragma unroll
    for (int a = 0; a < 2; ++a)
#pragma unroll
        for (int b = 0; b < 2; ++b)
#pragma unroll
            for (int m = 0; m < 4; ++m)
#pragma unroll
                for (int n = 0; n < 2; ++n) acc[a][b][m][n] = (f32x4){0.f, 0.f, 0.f, 0.f};
    i32x8 At[4], B0[2], B1[2];
    const int sc_one = 0x7f7f7f7f; (void)sc_one;
    unsigned va00, va01, va10, va11, vn00, vn01, vn10, vn11;
    va00 = (S.arow(cur, Rr[0]) * (unsigned)K + (unsigned)Cc[0]) * 2u; va01 = (S.arow(cur, Rr[1]) * (unsigned)K + (unsigned)Cc[1]) * 2u;
    va10 = (S.arow(cur, HALF + Rr[0]) * (unsigned)K + (unsigned)Cc[0]) * 2u; va11 = (S.arow(cur, HALF + Rr[1]) * (unsigned)K + (unsigned)Cc[1]) * 2u;
    vn00 = va00; vn01 = va01; vn10 = va10; vn11 = va11;
    const char* cB = cur.B;
    G8_STAGE(G8_SB(0, 0), cB, voffB[0], voffB[1]); G8_STAGE(G8_SA(0, 0), A, va00, va01); G8_STAGE(G8_SB(0, 1), cB + hstep, voffB[0], voffB[1]); G8_STAGE(G8_SA(0, 1), A, va10, va11);
    if (wr == 1) G8_BAR;
    G8_WAIT_V(4); G8_BAR;
    G8_STAGE(G8_SB(1, 0), cB + kstep, voffB[0], voffB[1]); G8_STAGE(G8_SA(1, 0), A + kstep, va00, va01); G8_STAGE(G8_SB(1, 1), cB + hstep + kstep, voffB[0], voffB[1]);
    G8_WAIT_V(6); G8_BAR;
    for (;;) {
        const bool has_next = S.next(ui + 1, nxt);
        const char* nB = has_next ? nxt.B : cB;
        if (has_next) {
            vn00 = (S.arow(nxt, Rr[0]) * (unsigned)K + (unsigned)Cc[0]) * 2u; vn01 = (S.arow(nxt, Rr[1]) * (unsigned)K + (unsigned)Cc[1]) * 2u;
            vn10 = (S.arow(nxt, HALF + Rr[0]) * (unsigned)K + (unsigned)Cc[0]) * 2u; vn11 = (S.arow(nxt, HALF + Rr[1]) * (unsigned)K + (unsigned)Cc[1]) * 2u;
        }
        for (int t = 0; t < nt; t += 2) {
            const bool last = (t == nt - 2);
            const char* a1 = A + (size_t)(t + 1) * kstep;
            const char* a2 = last ? A : A + (size_t)(t + 2) * kstep; const char* b2 = last ? nB : cB + (size_t)(t + 2) * kstep;
            const char* a3 = a2 + kstep; const char* b3 = b2 + kstep;
            const unsigned w00 = last ? vn00 : va00, w01 = last ? vn01 : va01, w10 = last ? vn10 : va10, w11 = last ? vn11 : va11;
            G8_LDB(B0, 0, 0); G8_SCHED; G8_LDA(At, 0, 0); G8_STAGE(G8_SA(1, 1), a1, va10, va11);
            G8_WAIT_L(8); G8_BAR; G8_WAIT_L(0); G8_MMA(0, 0, At, B0); G8_BAR; G8_SCHED;
            G8_LDB(B1, 0, 1); G8_STAGE(G8_SB(0, 0), b2, voffB[0], voffB[1]);
            G8_BAR; G8_WAIT_L(0); G8_MMA(0, 1, At, B1); G8_BAR;
            G8_LDA(At, 0, 1); G8_STAGE(G8_SA(0, 0), a2, w00, w01);
            G8_BAR; G8_WAIT_L(0); G8_MMA(1, 0, At, B0); G8_BAR; G8_SCHED;
            G8_STAGE(G8_SB(0, 1), b2 + hstep, voffB[0], voffB[1]);
            G8_WAIT_V(6); G8_BAR; G8_MMA(1, 1, At, B1); G8_BAR;
            G8_LDB(B0, 1, 0); G8_SCHED; G8_LDA(At, 1, 0); G8_STAGE(G8_SA(0, 1), a2, w10, w11);
            G8_WAIT_L(8); G8_BAR; G8_WAIT_L(0); G8_MMA(0, 0, At, B0); G8_BAR; G8_SCHED;
            G8_LDB(B1, 1, 1); G8_STAGE(G8_SB(1, 0), b3, voffB[0], voffB[1]);
            G8_BAR; G8_WAIT_L(0); G8_MMA(0, 1, At, B1); G8_BAR;
            G8_LDA(At, 1, 1); G8_STAGE(G8_SA(1, 0), a3, w00, w01);
            G8_BAR; G8_WAIT_L(0); G8_MMA(1, 0, At, B0); G8_BAR; G8_SCHED;
            G8_STAGE(G8_SB(1, 1), b3 + hstep, voffB[0], voffB[1]);
            G8_WAIT_V(6); G8_BAR; G8_MMA(1, 1, At, B1); G8_BAR;
        }
        if constexpr (FP8) asm volatile("s_nop 15\n\ts_nop 15" ::: "memory");
        E(acc, cur, wr, wc, fr, fq);
        if (!has_next) break;
#pragma unroll
        for (int a = 0; a < 2; ++a)
#pragma unroll
            for (int b = 0; b < 2; ++b)
#pragma unroll
                for (int m = 0; m < 4; ++m)
#pragma unroll
                    for (int n = 0; n < 2; ++n) acc[a][b][m][n] = (f32x4){0.f, 0.f, 0.f, 0.f};
        cur = nxt; cB = nB; va00 = vn00; va01 = vn01; va10 = vn10; va11 = vn11; ++ui;
    }
    G8_WAIT_V(0);
    if (wr == 0) G8_BAR;
    G8_BAR;
#undef G8_SA
#undef G8_SB
#undef G8_STAGE
#undef G8_LDA
#undef G8_LDB
#undef G8_MMA
#undef G8_WAIT_V
#undef G8_WAIT_L
#undef G8_BAR
#undef G8_SCHED
}

struct DenseSched {
    const char* Bt; int K, nM, nN, nwg, G, c;
    __device__ void init(const void* Bt_, int M, int N, int K_, int G_, int c_) { Bt = (const char*)Bt_; K = K_; nM = M / BM; nN = N / BM; nwg = nM * nN; G = G_; c = c_; }
    __device__ bool next(int i, Unit& u) const {
        const long L = (long)i * G + c; if (L >= nwg) return false;
        int wgid = (int)L; { const int q = nwg / 8, r = nwg % 8, xcd = wgid % 8, off = wgid / 8; wgid = (xcd < r ? xcd * (q + 1) : r * (q + 1) + (xcd - r) * q) + off; }
        const int nig = 8 * nN, gid = wgid / nig, fm = gid * 8, gsz = (nM - fm) < 8 ? (nM - fm) : 8;
        u.pm = fm + ((wgid % nig) % gsz); u.pn = (wgid % nig) / gsz; u.g = 0; u.rowbase = (unsigned)u.pm * BM; u.ord = 0;
        u.B = Bt + (size_t)u.pn * BM * K * 2; return true;
    }
    __device__ __forceinline__ unsigned arow(const Unit& u, int r) const { return u.rowbase + (unsigned)r; }
};
struct Moe1Sched {
    const char* W; const int* rowmap; int G, c; const LAS unsigned short* lrow;
    __device__ bool next(int i, Unit& u) const {
        const long L = (long)i * G + c; if (L >= NEXP * 512) return false;
        const int e = (int)(L / 512), w = (int)(L % 512), cc = w % 256, r = w / 256, xcd = cc % 8, j = cc / 8;
        const int mt = xcd * 4 + (j & 3), nt_ = r * 8 + (j >> 2), b = mt >> 1;
        u.pm = mt & 1; u.pn = nt_; u.g = b * NEXP + e; u.rowbase = (unsigned)u.g * CAP + (unsigned)u.pm * BM; u.ord = i;
        u.B = W + ((size_t)e * 2 * DFF + (size_t)nt_ * BM) * DM; return true;
    }
    __device__ __forceinline__ unsigned arow(const Unit& u, int r) const { return (unsigned)lrow[u.ord * BM + r]; }
    __device__ __forceinline__ void preload(LAS unsigned short* dst) const {
        Unit u;
        for (int i = 0; next(i, u); ++i) if (threadIdx.x < BM) dst[i * BM + threadIdx.x] = (unsigned short)rowmap[u.rowbase + threadIdx.x];
        __syncthreads();
    }
};
struct Moe2Sched {
    const char* W; int G, c;
    __device__ bool next(int i, Unit& u) const {
        const long L = (long)i * G + c; if (L >= NEXP * 128) return false;
        const int e = (int)(L / 128), w = (int)(L % 128), xcd = w % 8, j = w / 8;
        const int mt = xcd * 4 + (j & 3), nt_ = j >> 2, b = mt >> 1;
        u.pm = mt & 1; u.pn = nt_; u.g = b * NEXP + e; u.rowbase = (unsigned)u.g * CAP + (unsigned)u.pm * BM; u.ord = 0;
        u.B = W + ((size_t)e * DM + (size_t)nt_ * BM) * DFF; return true;
    }
    __device__ __forceinline__ unsigned arow(const Unit& u, int r) const { return u.rowbase + (unsigned)r; }
};

typedef const f32x4 (&AccRef)[2][2][4][2];
struct EpiQKVG {
    static constexpr bool PERM = true;
    h16* qkvg; float* codes;
    __device__ __forceinline__ void operator()(AccRef acc, const Unit& u, int wr, int wc, int fr, int fq) const {
        const int row0 = u.pm * BM + wr * 64 + fr;
        if (u.pn < 6) {
#pragma unroll
            for (int ai = 0; ai < 2; ++ai)
#pragma unroll
                for (int m = 0; m < 4; ++m) { h16* rowp = qkvg + (size_t)(row0 + ai * HALF + m * 16) * 1536 + u.pn * BM + wc * 32 + 8 * fq;
#pragma unroll
                    for (int bj = 0; bj < 2; ++bj) { const f32x4 v0 = acc[ai][bj][m][0], v1 = acc[ai][bj][m][1];
                        u32x4 w; w.x = pack_h2(v0[0], v0[1]); w.y = pack_h2(v0[2], v0[3]); w.z = pack_h2(v1[0], v1[1]); w.w = pack_h2(v1[2], v1[3]);
                        *(u32x4*)(rowp + bj * HALF) = w; } }
        } else if (wc == 0) {
#pragma unroll
            for (int ai = 0; ai < 2; ++ai)
#pragma unroll
                for (int m = 0; m < 4; ++m) { float* rowp = codes + (size_t)(row0 + ai * HALF + m * 16) * 32 + 8 * fq;
                    *(f32x4*)(rowp) = acc[ai][0][m][0]; *(f32x4*)(rowp + 4) = acc[ai][0][m][1]; }
        }
    }
};
struct EpiH16 {
    static constexpr bool PERM = true;
    h16* C; int ldc;
    __device__ __forceinline__ void operator()(AccRef acc, const Unit& u, int wr, int wc, int fr, int fq) const {
        const int row0 = u.pm * BM + wr * 64 + fr;
#pragma unroll
        for (int ai = 0; ai < 2; ++ai)
#pragma unroll
            for (int m = 0; m < 4; ++m) { h16* rowp = C + (size_t)(row0 + ai * HALF + m * 16) * ldc + u.pn * BM + wc * 32 + 8 * fq;
#pragma unroll
                for (int bj = 0; bj < 2; ++bj) { const f32x4 v0 = acc[ai][bj][m][0], v1 = acc[ai][bj][m][1];
                    u32x4 w; w.x = pack_h2(v0[0], v0[1]); w.y = pack_h2(v0[2], v0[3]); w.z = pack_h2(v1[0], v1[1]); w.w = pack_h2(v1[2], v1[3]);
                    *(u32x4*)(rowp + bj * HALF) = w; } }
    }
};
struct EpiResid {
    static constexpr bool PERM = true;
    const float* X; h16* R;
    __device__ __forceinline__ void operator()(AccRef acc, const Unit& u, int wr, int wc, int fr, int fq) const {
        const int row0 = u.pm * BM + wr * 64 + fr, col0 = u.pn * BM + wc * 32 + 8 * fq;
#pragma unroll
        for (int ai = 0; ai < 2; ++ai)
#pragma unroll
            for (int m = 0; m < 4; ++m) { const size_t off = (size_t)(row0 + ai * HALF + m * 16) * DM + col0;
#pragma unroll
                for (int bj = 0; bj < 2; ++bj) { const f32x4 x0 = *(const f32x4*)(X + off + bj * HALF), x1 = *(const f32x4*)(X + off + bj * HALF + 4);
                    const f32x4 v0 = x0 + acc[ai][bj][m][0], v1 = x1 + acc[ai][bj][m][1];
                    u32x4 w; w.x = pack_h2(v0[0], v0[1]); w.y = pack_h2(v0[2], v0[3]); w.z = pack_h2(v1[0], v1[1]); w.w = pack_h2(v1[2], v1[3]);
                    *(u32x4*)(R + off + bj * HALF) = w; } }
    }
};
struct EpiHid {
    static constexpr bool PERM = true;
    unsigned char* hid;
    __device__ __forceinline__ void operator()(AccRef acc, const Unit& u, int wr, int wc, int fr, int fq) const {
        const unsigned row0 = u.rowbase + wr * 64 + fr;
#pragma unroll
        for (int ai = 0; ai < 2; ++ai)
#pragma unroll
            for (int m = 0; m < 4; ++m) { unsigned char* rowp = hid + (size_t)(row0 + ai * HALF + m * 16) * DFF + u.pn * HALF + wc * 32 + 8 * fq;
                constexpr float ws_ = 1.0f / (float)(1 << FP8_WSHIFT);
                const f32x4 g0 = acc[ai][0][m][0] * ws_, g1 = acc[ai][0][m][1] * ws_, u0 = acc[ai][1][m][0] * ws_, u1 = acc[ai][1][m][1] * ws_;
                u32x2 w; w.x = pack_fp8x4(siluf_(g0[0]) * u0[0], siluf_(g0[1]) * u0[1], siluf_(g0[2]) * u0[2], siluf_(g0[3]) * u0[3]);
                w.y = pack_fp8x4(siluf_(g1[0]) * u1[0], siluf_(g1[1]) * u1[1], siluf_(g1[2]) * u1[2], siluf_(g1[3]) * u1[3]);
                *(u32x2*)rowp = w; }
    }
};
constexpr float Y_SCALE = 8.0f;
struct EpiDown {
    static constexpr bool PERM = true;
    unsigned char* Y; const float* selgate;
    __device__ __forceinline__ void operator()(AccRef acc, const Unit& u, int wr, int wc, int fr, int fq) const {
        const unsigned row0 = u.rowbase + wr * 64 + fr;
#pragma unroll
        for (int ai = 0; ai < 2; ++ai)
#pragma unroll
            for (int m = 0; m < 4; ++m) { const unsigned sr = row0 + ai * HALF + m * 16; const float gt = selgate[sr] * (Y_SCALE / (float)(1 << FP8_WSHIFT));
                unsigned char* rowp = Y + (size_t)sr * DM + u.pn * BM + wc * 32 + 8 * fq;
#pragma unroll
                for (int bj = 0; bj < 2; ++bj) { const f32x4 v0 = acc[ai][bj][m][0] * gt, v1 = acc[ai][bj][m][1] * gt;
                    u32x2 w; w.x = pack_fp8x4(v0[0], v0[1], v0[2], v0[3]); w.y = pack_fp8x4(v1[0], v1[1], v1[2], v1[3]);
                    *(u32x2*)(rowp + bj * HALF) = w; } }
    }
};
struct EpiPle {
    static constexpr bool PERM = true;
    const h16* H3; const float* rstd3; const float* lnw; const h16* PP; h16* R3H; float* rowsq;
    __device__ __forceinline__ void operator()(AccRef acc, const Unit& u, int wr, int wc, int fr, int fq) const {
        const int row0 = u.pm * BM + wr * 64 + fr, col0 = u.pn * BM + wc * 32 + 8 * fq;
        f32x4 winv[2][2];
#pragma unroll
        for (int bj = 0; bj < 2; ++bj)
#pragma unroll
            for (int n = 0; n < 2; ++n) { const f32x4 wv = *(const f32x4*)(lnw + col0 + bj * HALF + n * 4);
#pragma unroll
                for (int j = 0; j < 4; ++j) winv[bj][n][j] = __builtin_amdgcn_rcpf(wv[j]); }
#pragma unroll
        for (int ai = 0; ai < 2; ++ai)
#pragma unroll
            for (int m = 0; m < 4; ++m) { const int row = row0 + ai * HALF + m * 16; const size_t off = (size_t)row * DM + col0;
                const float inv = __builtin_amdgcn_rcpf(rstd3[row]); float sq = 0.f;
#pragma unroll
                for (int bj = 0; bj < 2; ++bj) { const size_t o2 = off + bj * HALF; const h16x8 hv = *(const h16x8*)(H3 + o2), pv = *(const h16x8*)(PP + o2);
                    float o[8];
#pragma unroll
                    for (int n = 0; n < 2; ++n)
#pragma unroll
                        for (int j = 0; j < 4; ++j) { const float v = (float)hv[4 * n + j] * inv * winv[bj][n][j] + sigmoidf_(acc[ai][bj][m][n][j]) * (float)pv[4 * n + j]; o[4 * n + j] = v; sq += v * v; }
                    u32x4 w; w.x = pack_h2(o[0], o[1]); w.y = pack_h2(o[2], o[3]); w.z = pack_h2(o[4], o[5]); w.w = pack_h2(o[6], o[7]); *(u32x4*)(R3H + o2) = w; }
                sq += __shfl_xor(sq, 16); sq += __shfl_xor(sq, 32);
                if (fq == 0) unsafeAtomicAdd(rowsq + row, sq); }
    }
};
}

template <class ColPtr>
__device__ __forceinline__ void cvt_transpose(LAS unsigned char* lds, h16* dst, int N, int K, int src_ld, ColPtr cp, int blk, int nblk) {
    const int tid = threadIdx.x, w = tid >> 6, l = tid & 63, nq = tid & 31, kp = tid >> 5;
    const int ktiles = K / 256, ntiles = (N / 128) * ktiles;
    f32x4 va[8], vb[8];
    auto fetch = [&](int t) {
        const int n0 = (t / ktiles) * 128, k0 = (t % ktiles) * 256;
        const float* sp = cp(n0 + (nq >> 3) * 32);
#pragma unroll
        for (int ps = 0; ps < 8; ++ps) {
            const int kk = 2 * (kp + 16 * ps);
            if (sp) { va[ps] = *(const f32x4*)(sp + (size_t)(k0 + kk) * src_ld + ((4 * nq) & 31)); vb[ps] = *(const f32x4*)(sp + (size_t)(k0 + kk + 1) * src_ld + ((4 * nq) & 31)); }
            else { va[ps] = (f32x4){0.f, 0.f, 0.f, 0.f}; vb[ps] = va[ps]; }
        }
    };
    if (blk < ntiles) fetch(blk);
    for (int t = blk; t < ntiles; t += nblk) {
        const int n0 = (t / ktiles) * 128, k0 = (t % ktiles) * 256;
        __syncthreads();
        const int sv = (nq & 15) << 1;
#pragma unroll
        for (int ps = 0; ps < 8; ++ps) { const int d = kp + 16 * ps;
#pragma unroll
            for (int j = 0; j < 4; ++j) *(LAS unsigned*)(lds + (4 * nq + j) * 512 + ((d ^ sv) << 2)) = pack_h2(va[ps][j], vb[ps][j]); }
        if (t + nblk < ntiles) fetch(t + nblk);
        __syncthreads();
#pragma unroll 4
        for (int r = 0; r < 16; ++r) { const int row = w * 16 + r, rv = ((row >> 2) & 15) << 1;
            const u32x2 x = *(const LAS u32x2*)(lds + row * 512 + (((2 * l) ^ rv) << 2));
            *(u32x2*)(dst + (size_t)(n0 + row) * K + k0 + 4 * l) = x; }
    }
}

template <class ColPtr>
__device__ __forceinline__ void cvt_transpose_fp8(LAS unsigned char* lds, unsigned char* dst, int N, int K, int src_ld, float scale, ColPtr cp, int blk, int nblk) {
    const int tid = threadIdx.x, w = tid >> 6, l = tid & 63, nq = tid & 31, kq = tid >> 5;
    const int ktiles = K / 256, ntiles = (N / 128) * ktiles;
    f32x4 v[4][4];
    auto fetch = [&](int t) {
        const int n0 = (t / ktiles) * 128, k0 = (t % ktiles) * 256;
        const float* sp = cp(n0 + (nq >> 3) * 32);
#pragma unroll
        for (int ps = 0; ps < 4; ++ps)
#pragma unroll
            for (int q = 0; q < 4; ++q) v[ps][q] = *(const f32x4*)(sp + (size_t)(k0 + 4 * (kq + 16 * ps) + q) * src_ld + ((4 * nq) & 31));
    };
    if (blk < ntiles) fetch(blk);
    for (int t = blk; t < ntiles; t += nblk) {
        const int n0 = (t / ktiles) * 128, k0 = (t % ktiles) * 256;
        __syncthreads();
        const int sv = (nq & 15) << 1;
#pragma unroll
        for (int ps = 0; ps < 4; ++ps) { const int d = kq + 16 * ps;
#pragma unroll
            for (int j = 0; j < 4; ++j) *(LAS unsigned*)(lds + (4 * nq + j) * 256 + ((d ^ sv) << 2)) = pack_fp8x4(v[ps][0][j] * scale, v[ps][1][j] * scale, v[ps][2][j] * scale, v[ps][3][j] * scale); }
        if (t + nblk < ntiles) fetch(t + nblk);
        __syncthreads();
#pragma unroll 4
        for (int r = 0; r < 16; ++r) { const int row = w * 16 + r, rv = ((row >> 2) & 15) << 1;
            const unsigned x = *(const LAS unsigned*)(lds + row * 256 + ((l ^ rv) << 2));
            *(unsigned*)(dst + (size_t)(n0 + row) * K + k0 + 4 * l) = x; }
    }
}

__device__ __forceinline__ void prep_fp8_weights(const Args& a, LAS unsigned char* lds, int blk, int nblk) {
    unsigned char* ws = a.ws;
    const int tid = threadIdx.x, w = tid >> 6, l = tid & 63, nq = tid & 31, kq = tid >> 5;
    constexpr int NT = 2048 + 1024;
    const float scale = (float)(1 << FP8_WSHIFT);
    struct Tile { const float* sp; int src_ld; unsigned char* dst; int K; };
    auto decode = [&](int gt) -> Tile {
        Tile t;
        if (gt < 2048) { const int e = gt >> 7, r = gt & 127, n0 = (r >> 2) * 128, k0 = (r & 3) * 256, nb = n0 + (nq >> 3) * 32;
            const int tile = nb >> 8, within = nb & 255, f = tile * 128 + (within & 127);
            t.sp = ((within >> 7) ? a.in[I_WUP] : a.in[I_WGATE]) + (size_t)e * DM * DFF + f + (size_t)k0 * DFF; t.src_ld = DFF; t.K = DM;
            t.dst = ws + OFF_WGU + (size_t)e * 2 * DFF * DM + (size_t)n0 * DM + k0; }
        else { const int g2 = gt - 2048, e = g2 >> 6, r = g2 & 63, n0 = (r >> 3) * 128, k0 = (r & 7) * 256, nb = n0 + (nq >> 3) * 32;
            t.sp = a.in[I_WDOWN] + (size_t)e * DFF * DM + nb + (size_t)k0 * DM; t.src_ld = DM; t.K = DFF;
            t.dst = ws + OFF_WD + (size_t)e * DM * DFF + (size_t)n0 * DFF + k0; }
        return t;
    };
    f32x4 v[4][4];
    auto fetch = [&](const Tile& t) {
#pragma unroll
        for (int ps = 0; ps < 4; ++ps)
#pragma unroll
            for (int q = 0; q < 4; ++q) v[ps][q] = *(const f32x4*)(t.sp + (size_t)(4 * (kq + 16 * ps) + q) * t.src_ld + ((4 * nq) & 31));
    };
    Tile cur;
    if (blk < NT) { cur = decode(blk); fetch(cur); }
    for (int gt = blk; gt < NT; gt += nblk) {
        __syncthreads();
        const int sv = (nq & 15) << 1;
#pragma unroll
        for (int ps = 0; ps < 4; ++ps) { const int d = kq + 16 * ps;
#pragma unroll
            for (int j = 0; j < 4; ++j) *(LAS unsigned*)(lds + (4 * nq + j) * 256 + ((d ^ sv) << 2)) = pack_fp8x4(v[ps][0][j] * scale, v[ps][1][j] * scale, v[ps][2][j] * scale, v[ps][3][j] * scale); }
        unsigned char* dst = cur.dst; const int K = cur.K;
        if (gt + nblk < NT) { cur = decode(gt + nblk); fetch(cur); }
        __syncthreads();
#pragma unroll 4
        for (int r = 0; r < 16; ++r) { const int row = w * 16 + r, rv = ((row >> 2) & 15) << 1;
            const unsigned x = *(const LAS unsigned*)(lds + row * 256 + ((l ^ rv) << 2));
            *(unsigned*)(dst + (size_t)row * K + 4 * l) = x; }
    }
}

__device__ __forceinline__ void phase_prep(const Args& a, LAS unsigned char* lds, int blk, int nblk) {
    unsigned char* ws = a.ws;
    const int tid = threadIdx.x;
    if (blk == 0) { if (tid < 64) ((unsigned*)(ws + OFF_CTR))[tid] = 0u;
        for (int i = tid; i < 3456; i += NTHREADS) ((unsigned*)(ws + OFF_XBAR))[i] = 0u; }
    auto rot = [&](int off) { return (blk - off + 4 * nblk) % nblk; };
    { const float* w = a.in[I_WIN]; cvt_transpose(lds, (h16*)(ws + OFF_WINA), NA1, DM, INCOLS, [=](int n0) { return n0 < 1568 ? w + n0 : (const float*)nullptr; }, rot(0), nblk); }
    { const float* w = a.in[I_WIN]; cvt_transpose(lds, (h16*)(ws + OFF_WINHY), HYC, DM, INCOLS, [=](int n0) { return w + 1568 + n0; }, rot(56), nblk); }
    { const float* w = a.in[I_WOUT]; cvt_transpose(lds, (h16*)(ws + OFF_WOUT), DM, DM, DM, [=](int n0) { return w + n0; }, rot(104), nblk); }
    { const float* w = a.in[I_WPG]; cvt_transpose(lds, (h16*)(ws + OFF_WG), DM, DM, DM, [=](int n0) { return w + n0; }, rot(136), nblk); }
    { const float* w = a.in[I_WPP]; cvt_transpose(lds, (h16*)(ws + OFF_WP), DM, 256, DM, [=](int n0) { return w + n0; }, rot(168), nblk); }
    prep_fp8_weights(a, lds, blk, nblk);
    { const f32x4* p = (const f32x4*)a.in[I_P]; u32x2* d = (u32x2*)(ws + OFF_P16); const size_t n4 = (size_t)NTOK * 256 / 4;
        for (size_t i = (size_t)blk * NTHREADS + tid; i < n4; i += (size_t)nblk * NTHREADS) { const f32x4 v = p[i]; u32x2 o; o.x = pack_h2(v[0], v[1]); o.y = pack_h2(v[2], v[3]); d[i] = o; } }
}

__device__ __forceinline__ void phase_rmsnorm_h16(const float* X, const float* w, h16* H, int blk, int nblk) {
    constexpr int RP = 4;
    const int lane = threadIdx.x & 63, gw = blk * 8 + (threadIdx.x >> 6), nw = nblk * 8;
    f32x4 wv[4];
#pragma unroll
    for (int j = 0; j < 4; ++j) wv[j] = *(const f32x4*)(w + j * 256 + lane * 4);
    for (int row0 = gw * RP; row0 < NTOK; row0 += nw * RP) {
        f32x4 v[RP][4];
#pragma unroll
        for (int r = 0; r < RP; ++r)
#pragma unroll
            for (int j = 0; j < 4; ++j) v[r][j] = *(const f32x4*)(X + (size_t)(row0 + r) * DM + j * 256 + lane * 4);
#pragma unroll
        for (int r = 0; r < RP; ++r) {
            float ss = 0.f;
#pragma unroll
            for (int j = 0; j < 4; ++j) ss += v[r][j][0] * v[r][j][0] + v[r][j][1] * v[r][j][1] + v[r][j][2] * v[r][j][2] + v[r][j][3] * v[r][j][3];
            ss = wave_sum(ss);
            const float rstd = rsqrtf(ss * (1.0f / DM) + EPS);
            h16* hp = H + (size_t)(row0 + r) * DM;
#pragma unroll
            for (int j = 0; j < 4; ++j) { u32x2 o; o.x = pack_h2(v[r][j][0] * rstd * wv[j][0], v[r][j][1] * rstd * wv[j][1]); o.y = pack_h2(v[r][j][2] * rstd * wv[j][2], v[r][j][3] * rstd * wv[j][3]);
                *(u32x2*)(hp + j * 256 + lane * 4) = o; }
        }
    }
}

__device__ __forceinline__ void phase_combine_norm(const h16* R, const unsigned char* Y, const int* slotmap, const float* w, h16* H, float* rstd3, float* rowsq, int blk, int nblk) {
    constexpr int RP = 2;
    const int lane = threadIdx.x & 63, gw = blk * 8 + (threadIdx.x >> 6), nw = nblk * 8;
    f32x4 wv[4];
#pragma unroll
    for (int j = 0; j < 4; ++j) wv[j] = *(const f32x4*)(w + j * 256 + lane * 4);
    for (int row0 = gw * RP; row0 < NTOK; row0 += nw * RP) {
        f32x4 v[RP][4]; int myslot[RP];
#pragma unroll
        for (int r = 0; r < RP; ++r) {
            myslot[r] = (lane < NEXP) ? slotmap[(size_t)(row0 + r) * NEXP + lane] : -1;
#pragma unroll
            for (int j = 0; j < 4; ++j) { const h16x4 hv = *(const h16x4*)(R + (size_t)(row0 + r) * DM + j * 256 + lane * 4); v[r][j] = (f32x4){(float)hv[0], (float)hv[1], (float)hv[2], (float)hv[3]}; }
        }
#pragma unroll
        for (int r = 0; r < RP; ++r) {
            unsigned long long mask = __ballot(myslot[r] >= 0);
            const int b = (row0 + r) / SEQ;
            while (mask) {
                const int e = __builtin_ctzll(mask); mask &= mask - 1;
                const int sl = __shfl(myslot[r], e);
                const unsigned char* yp = Y + ((size_t)(b * NEXP + e) * CAP + sl) * DM;
                unsigned y4[4];
#pragma unroll
                for (int j = 0; j < 4; ++j) y4[j] = *(const unsigned*)(yp + j * 256 + lane * 4);
#pragma unroll
                for (int j = 0; j < 4; ++j) { const f32x2 lo = __builtin_amdgcn_cvt_pk_f32_fp8((int)y4[j], false), hi = __builtin_amdgcn_cvt_pk_f32_fp8((int)y4[j], true);
                    v[r][j][0] += lo[0] * (1.0f / g8::Y_SCALE); v[r][j][1] += lo[1] * (1.0f / g8::Y_SCALE); v[r][j][2] += hi[0] * (1.0f / g8::Y_SCALE); v[r][j][3] += hi[1] * (1.0f / g8::Y_SCALE); }
            }
        }
#pragma unroll
        for (int r = 0; r < RP; ++r) {
            float ss = 0.f;
#pragma unroll
            for (int j = 0; j < 4; ++j) { ss += v[r][j][0] * v[r][j][0] + v[r][j][1] * v[r][j][1] + v[r][j][2] * v[r][j][2] + v[r][j][3] * v[r][j][3]; }
            ss = wave_sum(ss);
            const float rstd = rsqrtf(ss * (1.0f / DM) + EPS);
            if (lane == 0) { rstd3[row0 + r] = rstd; rowsq[row0 + r] = 0.f; }
            h16* hp = H + (size_t)(row0 + r) * DM;
#pragma unroll
            for (int j = 0; j < 4; ++j) { u32x2 o; o.x = pack_h2(v[r][j][0] * rstd * wv[j][0], v[r][j][1] * rstd * wv[j][1]); o.y = pack_h2(v[r][j][2] * rstd * wv[j][2], v[r][j][3] * rstd * wv[j][3]);
                *(u32x2*)(hp + j * 256 + lane * 4) = o; }
        }
    }
}

__device__ __forceinline__ void phase_final_norm(const h16* R3H, const float* rowsq, const float* w, float* out, int blk, int nblk) {
    constexpr int RP = 4;
    const int lane = threadIdx.x & 63, gw = blk * 8 + (threadIdx.x >> 6), nw = nblk * 8;
    f32x4 wv[4];
#pragma unroll
    for (int j = 0; j < 4; ++j) wv[j] = *(const f32x4*)(w + j * 256 + lane * 4);
    for (int row0 = gw * RP; row0 < NTOK; row0 += nw * RP) {
        h16x4 v[RP][4]; float sq[RP];
#pragma unroll
        for (int r = 0; r < RP; ++r) { sq[r] = rowsq[row0 + r];
#pragma unroll
            for (int j = 0; j < 4; ++j) v[r][j] = *(const h16x4*)(R3H + (size_t)(row0 + r) * DM + j * 256 + lane * 4); }
#pragma unroll
        for (int r = 0; r < RP; ++r) {
            const float rstd = rsqrtf(sq[r] * (1.0f / DM) + EPS);
#pragma unroll
            for (int j = 0; j < 4; ++j) { f32x4 o;
#pragma unroll
                for (int q = 0; q < 4; ++q) o[q] = (float)v[r][j][q] * rstd * wv[j][q];
                *(f32x4*)(out + (size_t)(row0 + r) * DM + j * 256 + lane * 4) = o; }
        }
    }
}

__device__ __forceinline__ void phase_router(const h16* R, const float* w, const float* wrouter, unsigned char* H8, float* probs, LAS unsigned char* lds, int blk, int nblk) {
    constexpr int RP = 2;
    LAS float* wrT = (LAS float*)lds;
    const int tid = threadIdx.x, lane = tid & 63, gw = blk * 8 + (tid >> 6), nw = nblk * 8;
    __syncthreads();
    { float tmp[32];
#pragma unroll
        for (int q = 0; q < 32; ++q) { const int i = tid + NTHREADS * q, e = i >> 10, k = i & 1023; tmp[q] = wrouter[k * NEXP + e]; }
#pragma unroll
        for (int q = 0; q < 32; ++q) wrT[tid + NTHREADS * q] = tmp[q]; }
    __syncthreads();
    f32x4 wv[4];
#pragma unroll
    for (int j = 0; j < 4; ++j) wv[j] = *(const f32x4*)(w + j * 256 + lane * 4);
    const bool b5 = lane & 32, b4 = lane & 16, b3 = lane & 8, b2 = lane & 4;
    const int mye = (b5 ? 8 : 0) + (b4 ? 4 : 0) + (b3 ? 2 : 0) + (b2 ? 1 : 0);
    for (int row0 = gw * RP; row0 < NTOK; row0 += nw * RP) {
        f32x4 v[RP][4];
#pragma unroll
        for (int r = 0; r < RP; ++r)
#pragma unroll
            for (int j = 0; j < 4; ++j) { const h16x4 hv = *(const h16x4*)(R + (size_t)(row0 + r) * DM + j * 256 + lane * 4); v[r][j] = (f32x4){(float)hv[0], (float)hv[1], (float)hv[2], (float)hv[3]}; }
#pragma unroll
        for (int r = 0; r < RP; ++r) {
            float ss = 0.f;
#pragma unroll
            for (int j = 0; j < 4; ++j) ss += v[r][j][0] * v[r][j][0] + v[r][j][1] * v[r][j][1] + v[r][j][2] * v[r][j][2] + v[r][j][3] * v[r][j][3];
            ss = wave_sum(ss);
            const float rstd = rsqrtf(ss * (1.0f / DM) + EPS);
            unsigned char* hp = H8 + (size_t)(row0 + r) * DM;
#pragma unroll
            for (int j = 0; j < 4; ++j) { v[r][j] = v[r][j] * rstd * wv[j]; *(unsigned*)(hp + j * 256 + lane * 4) = pack_fp8x4(v[r][j][0], v[r][j][1], v[r][j][2], v[r][j][3]); }
        }
        float s8a[RP][8];
#pragma unroll
        for (int i = 0; i < 8; ++i) { asm volatile("" ::: "memory");
            f32x4 wa4[4], wb4[4];
#pragma unroll
            for (int j = 0; j < 4; ++j) { wa4[j] = *(const LAS f32x4*)(wrT + i * DM + j * 256 + lane * 4); wb4[j] = *(const LAS f32x4*)(wrT + (i + 8) * DM + j * 256 + lane * 4); }
#pragma unroll
            for (int r = 0; r < RP; ++r) { float sa = 0.f, sb = 0.f;
#pragma unroll
                for (int j = 0; j < 4; ++j) { sa += v[r][j][0] * wa4[j][0] + v[r][j][1] * wa4[j][1] + v[r][j][2] * wa4[j][2] + v[r][j][3] * wa4[j][3];
                                              sb += v[r][j][0] * wb4[j][0] + v[r][j][1] * wb4[j][1] + v[r][j][2] * wb4[j][2] + v[r][j][3] * wb4[j][3]; }
                const float send = b5 ? sa : sb, keep = b5 ? sb : sa; s8a[r][i] = keep + __shfl_xor(send, 32); } }
#pragma unroll
        for (int r = 0; r < RP; ++r) {
            float s8[8], s4[4], s2[2], lg;
#pragma unroll
            for (int i = 0; i < 8; ++i) s8[i] = s8a[r][i];
#pragma unroll
            for (int i = 0; i < 4; ++i) { const float send = b4 ? s8[i] : s8[i + 4], keep = b4 ? s8[i + 4] : s8[i]; s4[i] = keep + __shfl_xor(send, 16); }
#pragma unroll
            for (int i = 0; i < 2; ++i) { const float send = b3 ? s4[i] : s4[i + 2], keep = b3 ? s4[i + 2] : s4[i]; s2[i] = keep + __shfl_xor(send, 8); }
            { const float send = b2 ? s2[0] : s2[1], keep = b2 ? s2[1] : s2[0]; lg = keep + __shfl_xor(send, 4); }
            lg += __shfl_xor(lg, 1); lg += __shfl_xor(lg, 2);
            float mx = lg;
#pragma unroll
            for (int o = 4; o <= 32; o <<= 1) mx = fmaxf(mx, __shfl_xor(mx, o));
            const float ex = expf(lg - mx); float den = ex;
#pragma unroll
            for (int o = 4; o <= 32; o <<= 1) den += __shfl_xor(den, o);
            if ((lane & 3) == 0) { const int row = row0 + r, b = row / SEQ, t = row % SEQ; probs[((size_t)b * NEXP + mye) * SEQ + t] = ex / den; }
        }
    }
}

__device__ __forceinline__ void phase_topk(const float* probs, int* selidx, float* selgate, int* slotmap, LAS unsigned char* lds, int blk, int nblk) {
    LAS int* hist = (LAS int*)lds;
    LAS int* red = hist + 256;
    const int tid = threadIdx.x, lane = tid & 63, wid = tid >> 6;
    for (int g = blk; g < NB * NEXP; g += nblk) {
        const float* pp = probs + (size_t)g * SEQ;
        unsigned key[8]; float pv[8];
        { const f32x4 a = *(const f32x4*)(pp + tid * 8), b = *(const f32x4*)(pp + tid * 8 + 4);
#pragma unroll
          for (int j = 0; j < 4; ++j) { pv[j] = a[j]; pv[4 + j] = b[j]; }
#pragma unroll
          for (int j = 0; j < 8; ++j) key[j] = __float_as_uint(pv[j]); }
        unsigned prefix = 0; int krem = CAP;
#pragma unroll 1
        for (int ps = 0; ps < 4; ++ps) {
            const int shift = ps == 0 ? 23 : ps == 1 ? 15 : ps == 2 ? 7 : 0, bits = ps == 3 ? 7 : 8;
            const unsigned mhi = ~((1u << (shift + bits)) - 1u), dmask = (1u << bits) - 1u;
            __syncthreads();
            if (tid < 256) hist[tid] = 0;
            __syncthreads();
#pragma unroll
            for (int j = 0; j < 8; ++j) if ((key[j] & mhi) == (prefix & mhi)) __hip_atomic_fetch_add(hist + ((key[j] >> shift) & dmask), 1, __ATOMIC_RELAXED, __HIP_MEMORY_SCOPE_WORKGROUP);
            __syncthreads();
            if (wid == 0) {
                int c[4], tot = 0;
#pragma unroll
                for (int q = 0; q < 4; ++q) { c[q] = hist[4 * lane + q]; tot += c[q]; }
                int S = tot;
#pragma unroll
                for (int o = 1; o < 64; o <<= 1) { const int t = __shfl_down(S, o); if (lane + o < 64) S += t; }
                const int above = S - tot;
                if (above < krem && krem <= S) {
                    int acc = above, dsel = 4 * lane, kn = krem; bool done = false;
#pragma unroll
                    for (int q = 3; q >= 0; --q) { if (!done && acc + c[q] >= krem) { dsel = 4 * lane + q; kn = krem - acc; done = true; } if (!done) acc += c[q]; }
                    red[0] = dsel; red[1] = kn;
                }
            }
            __syncthreads();
            prefix |= (unsigned)red[0] << shift; krem = red[1];
        }
        int cgt = 0, ceq = 0;
#pragma unroll
        for (int j = 0; j < 8; ++j) { cgt += (key[j] > prefix) ? 1 : 0; ceq += (key[j] == prefix) ? 1 : 0; }
        int sg = cgt, se = ceq;
#pragma unroll
        for (int o = 1; o < 64; o <<= 1) { const int a = __shfl_up(sg, o), b = __shfl_up(se, o); if (lane >= o) { sg += a; se += b; } }
        __syncthreads();
        if (lane == 63) { red[32 + wid] = sg; red[48 + wid] = se; }
        __syncthreads();
        int bg = 0, be = 0;
#pragma unroll
        for (int w = 0; w < 8; ++w) { const int x = red[32 + w], y = red[48 + w]; if (w < wid) { bg += x; be += y; } }
        int pg = bg + sg - cgt, pe = be + se - ceq;
        const int need = krem;
#pragma unroll
        for (int j = 0; j < 8; ++j) {
            const bool gt = key[j] > prefix, eq = key[j] == prefix;
            const bool take = gt || (eq && pe < need);
            const int slot = pg + (pe < need ? pe : need);
            if (take) { selidx[(size_t)g * CAP + slot] = (g / NEXP) * SEQ + tid * 8 + j; selgate[(size_t)g * CAP + slot] = pv[j]; }
            slotmap[((size_t)(g / NEXP) * SEQ + tid * 8 + j) * NEXP + (g % NEXP)] = take ? slot : -1;
            pg += gt ? 1 : 0; pe += eq ? 1 : 0;
        }
    }
}

struct __attribute__((packed, aligned(2))) H8U { h16 v[8]; };
__device__ __forceinline__ void phase_filters(const Args& a, h16* GR, LAS unsigned char* lds, int blk, int nblk) {
    constexpr int NP = 16;
    LAS float* z = (LAS float*)lds;
    LAS float* h1 = z + NP * 32;
    LAS float* h2 = h1 + NP * 64;
    const int tid = threadIdx.x;
    const float* w1 = a.in[I_FW1]; const float* b1 = a.in[I_FB1]; const float* fr1 = a.in[I_FFR1];
    const float* w2 = a.in[I_FW2]; const float* b2 = a.in[I_FB2]; const float* fr2 = a.in[I_FFR2];
    const float* w3 = a.in[I_FW3]; const float* hb = a.in[I_HBIAS];
    const float MIND = logf(1e-2f) / 1.5f, MAXD = logf(1e-2f) / 0.3f;
    for (int it = blk; it < SEQ / NP; it += nblk) {
        const int t0 = it * NP;
        __syncthreads();
        if (tid < NP * 17) { const int pos = tid / 17, i = tid % 17, t = t0 + pos; float v;
            if (i == 0) v = (float)t / (float)(SEQ - 1);
            else { const int bi = (i - 1) & 7; const float f = 1e-4f + (float)bi * ((7.0f - 1e-4f) / 7.0f); const float wp = 6.283185307179586f * (float)t / (float)SEQ; const float ang = f * wp;
                float sn, cs; sincos_f(ang, sn, cs); v = (i <= 8) ? cs : -sn; }
            z[pos * 32 + i] = v; }
        __syncthreads();
#pragma unroll
        for (int hf = 0; hf < NP / 8; ++hf) { const int pos = hf * 8 + (tid >> 6), j = tid & 63; float s = b1[j];
#pragma unroll
            for (int i = 0; i < 17; ++i) s += z[pos * 32 + i] * w1[i * 64 + j];
            h1[pos * 64 + j] = sin_f(fr1[j] * s); }
        __syncthreads();
#pragma unroll
        for (int hf = 0; hf < NP / 8; ++hf) { const int pos = hf * 8 + (tid >> 6), j = tid & 63; float s = b2[j];
#pragma unroll 16
            for (int i = 0; i < 64; ++i) s += h1[pos * 64 + i] * w2[i * 64 + j];
            h2[j * NP + pos] = sin_f(fr2[j] * s); }
        __syncthreads();
        {
            const int w = tid >> 6, l = tid & 63, n16 = l & 15, kg = l >> 4;
            h16x8 Af[2];
#pragma unroll
            for (int ks = 0; ks < 2; ++ks)
#pragma unroll
                for (int jj = 0; jj < 8; ++jj) Af[ks][jj] = (h16)h2[(32 * ks + 8 * kg + jj) * NP + n16];
#pragma unroll 2
            for (int ti = 0; ti < 16; ++ti) {
                const int col = (w * 16 + ti) * 16 + n16;
                float wv[2][8];
#pragma unroll
                for (int ks = 0; ks < 2; ++ks)
#pragma unroll
                    for (int jj = 0; jj < 8; ++jj) wv[ks][jj] = w3[(32 * ks + 8 * kg + jj) * 2048 + col];
                f32x4 acc = (f32x4){0.f, 0.f, 0.f, 0.f};
#pragma unroll
                for (int ks = 0; ks < 2; ++ks) { h16x8 Bf;
#pragma unroll
                    for (int jj = 0; jj < 8; ++jj) Bf[jj] = (h16)wv[ks][jj];
                    acc = __builtin_amdgcn_mfma_f32_16x16x32_f16(Af[ks], Bf, acc, 0, 0, 0); }
                const int o = col >> 10, dir = (col >> 9) & 1, c = col & 511;
                const float delta = fabsf(MIND + (float)c * ((MAXD - MIND) / 511.0f));
                h16* gp = GR + ((size_t)o * HYW + c) * 8192;
                h16 hv[4];
#pragma unroll
                for (int r = 0; r < 4; ++r) { const int t = t0 + 4 * kg + r; const float tl = (float)t * (1.0f / (float)(SEQ - 1)); float v = acc[r] * __expf(-tl * delta);
                    if (dir == 0 && t == 0) v += hb[o * HYW + c];
                    hv[r] = (h16)(v * HY_SCALE); }
                if (dir == 0) { h16x4 st; st[0] = hv[3]; st[1] = hv[2]; st[2] = hv[1]; st[3] = hv[0]; *(h16x4*)(gp + 4092 - t0 - 4 * kg) = st; }
                else {
#pragma unroll
                    for (int r = 0; r < 4; ++r) { const int t = t0 + 4 * kg + r; if (t >= 1) gp[4095 + t] = hv[r]; else gp[8191] = (h16)0.f; }
                }
            }
        }
    }
}

constexpr int HY_ROW = 8192, HY_UIMG = 16 * HY_ROW, HY_RING = 24;
__device__ __forceinline__ int hy_uoff(int b, int s) { return b * HY_ROW + ((((s >> 3) ^ b) << 4) | ((s & 7) << 1)); }
#define HY_MFMA(acc_, a_, b_) asm volatile("v_mfma_f32_16x16x32_f16 %0, %1, %2, %0" : "+v"(acc_) : "v"(a_), "v"(b_))
__device__ __forceinline__ void phase_hyena(const h16* __restrict__ hy, h16* __restrict__ z2, const h16* __restrict__ gr, const float* __restrict__ cw, const float* __restrict__ cb, unsigned* __restrict__ queue0, LAS unsigned char* lds, int reps) {
    const int tid = threadIdx.x, w = __builtin_amdgcn_readfirstlane(tid >> 6), l = tid & 63, bcol = l & 15, kg = l >> 4;
    LAS unsigned char* uimg = lds; LAS unsigned char* ring = lds + HY_UIMG;
    LAS int* qslot = (LAS int*)(lds + HY_UIMG + HY_RING * 1024);
    const int lbase = 4095 - (l & 15) + 8 * (l >> 4);
#pragma unroll 1
    for (int rep = 0; rep < reps; ++rep) {
    unsigned* queue = queue0 + rep;
    for (;;) {
        __syncthreads();
        if (tid == 0) *qslot = (int)atomicAdd(queue, 1u);
        __syncthreads();
        const int c = *qslot;
        if (c >= HYW) break;
        { const float w0 = cw[c], w1 = cw[HYC + c], w2 = cw[2 * HYC + c], bb = cb[c]; const int t0 = tid * 8;
#pragma unroll 8
            for (int b = 0; b < NB; ++b) {
                const h16* src = hy + (size_t)c * NTOK + (size_t)b * SEQ;
                const h16x8 rv = *(const h16x8*)(src + t0);
                const float rm = (t0 > 0) ? (float)src[t0 - 1] : 0.f, rp = (t0 + 8 < SEQ) ? (float)src[t0 + 8] : 0.f;
                float r[10]; r[0] = rm; r[9] = rp;
#pragma unroll
                for (int j = 0; j < 8; ++j) r[1 + j] = (float)rv[j];
                h16x8 o;
#pragma unroll
                for (int j = 0; j < 8; ++j) o[j] = (h16)(bb + w0 * r[j] + w1 * r[j + 1] + w2 * r[j + 2]);
                *(LAS h16x8*)(uimg + b * HY_ROW + ((tid ^ b) << 4)) = o;
            } }
#pragma unroll 1
        for (int o = 0; o < 2; ++o) {
            const h16* grp = gr + ((size_t)o * HYW + c) * 8192;
            f32x4 acc[8][4];
#pragma unroll
            for (int i = 0; i < 8; ++i)
#pragma unroll
                for (int m = 0; m < 4; ++m) acc[i][m] = (f32x4){0.f, 0.f, 0.f, 0.f};
            { const int phi = -256 + w; if (phi >= -254) { const H8U v0 = *(const H8U*)(grp + lbase - 16 * phi); *(LAS h16x8*)(ring + ((phi + 264) % HY_RING) * 1024 + l * 16) = __builtin_bit_cast(h16x8, v0); } }
            h16x8 fragA = __builtin_bit_cast(h16x8, *(const H8U*)(grp + lbase - 16 * (-248 + w))), fragB = {};
            __syncthreads();
#define HY_STEP(st_, fcur_, fnext_) do { \
                const int d0 = -64 + 2 * (st_); \
                if ((st_) < 62) fnext_ = __builtin_bit_cast(h16x8, *(const H8U*)(grp + lbase - 16 * (4 * (d0 + 4) + w))); \
                const int sbase = (4 * d0 - 2 + 264) % HY_RING; \
                _Pragma("unroll") for (int dd = 0; dd < 2; ++dd) { \
                    const int delta = d0 + dd; \
                    if (delta >= -63) { \
                        h16x8 A6[6]; \
                        _Pragma("unroll") for (int q = 0; q < 6; ++q) { int sl = sbase + 4 * dd + q; sl = sl >= HY_RING ? sl - HY_RING : sl; A6[q] = *(const LAS h16x8*)(ring + sl * 1024 + l * 16); } \
                        _Pragma("unroll") for (int i = 0; i < 8; ++i) { \
                            const int s1 = w + 8 * i - delta; \
                            if ((unsigned)s1 < 64u) { \
                                const int ch = 8 * s1 + kg; \
                                const h16x8 B0 = *(const LAS h16x8*)(uimg + bcol * HY_ROW + ((ch ^ bcol) << 4)), B1 = *(const LAS h16x8*)(uimg + bcol * HY_ROW + (((ch + 4) ^ bcol) << 4)); \
                                __builtin_amdgcn_s_setprio(1); \
                                _Pragma("unroll") for (int m = 0; m < 4; ++m) { HY_MFMA(acc[i][m], A6[m + 2], B0); HY_MFMA(acc[i][m], A6[m], B1); } \
                                __builtin_amdgcn_s_setprio(0); \
                            } } } } \
                if ((st_) < 63) *(LAS h16x8*)(ring + ((4 * (d0 + 2) + w + 264) % HY_RING) * 1024 + l * 16) = fcur_; \
                asm volatile("s_waitcnt lgkmcnt(0)" ::: "memory"); __builtin_amdgcn_s_barrier(); asm volatile("" ::: "memory"); \
            } while (0)
#pragma unroll 1
            for (int st = 0; st < 64; st += 2) { HY_STEP(st, fragA, fragB); HY_STEP(st + 1, fragB, fragA); }
#undef HY_STEP
            asm volatile("s_nop 15\n\ts_nop 15" ::: "memory");
            const int ch = (o + 1) * HYW + c;
            const float w0 = cw[ch], w1 = cw[HYC + ch], w2 = cw[2 * HYC + ch], bb = cb[ch];
            int kg_e = kg, bcol_e = bcol; asm volatile("" : "+v"(kg_e), "+v"(bcol_e));
            const h16* xsrc = hy + (size_t)ch * NTOK + (size_t)bcol_e * SEQ;
#pragma unroll
            for (int ih = 0; ih < 4; ++ih) {
                h16x4 xv[2][4]; h16 xm[2][4], xp[2][4];
#pragma unroll
                for (int ii = 0; ii < 2; ++ii)
#pragma unroll
                    for (int m = 0; m < 4; ++m) {
                        const int t = 64 * (w + 8 * (2 * ih + ii)) + 16 * m + 4 * kg_e;
                        xv[ii][m] = *(const h16x4*)(xsrc + t);
                        xm[ii][m] = (t > 0) ? xsrc[t - 1] : (h16)0.f; xp[ii][m] = (t + 4 < SEQ) ? xsrc[t + 4] : (h16)0.f;
                    }
#pragma unroll
                for (int ii = 0; ii < 2; ++ii)
#pragma unroll
                    for (int m = 0; m < 4; ++m) {
                        const int i = 2 * ih + ii;
                        const int t = 64 * (w + 8 * i) + 16 * m + 4 * kg_e;
                        float r[6]; r[0] = (float)xm[ii][m]; r[5] = (float)xp[ii][m];
#pragma unroll
                        for (int jj = 0; jj < 4; ++jj) r[1 + jj] = (float)xv[ii][m][jj];
                        h16x4 zo;
#pragma unroll
                        for (int jj = 0; jj < 4; ++jj) zo[jj] = (h16)((bb + w0 * r[jj] + w1 * r[jj + 1] + w2 * r[jj + 2]) * acc[i][m][jj] * (1.0f / HY_SCALE));
                        if (o == 0) *(LAS h16x4*)(uimg + hy_uoff(bcol_e, t)) = zo;
                        else *(h16x4*)(z2 + (size_t)c * NTOK + (size_t)bcol_e * SEQ + t) = zo;
                    }
                asm volatile("" ::: "memory");
            }
        }
    }
}
}

__device__ __forceinline__ float wave_incl_scan(float x) {
#define DPP_ADD(ctrl, rmask, bctl) x += __builtin_bit_cast(float, __builtin_amdgcn_update_dpp(0, __builtin_bit_cast(int, x), ctrl, rmask, 0xf, bctl))
    DPP_ADD(0x111, 0xf, true);
    DPP_ADD(0x112, 0xf, true);
    DPP_ADD(0x114, 0xf, true);
    DPP_ADD(0x118, 0xf, true);
    DPP_ADD(0x142, 0xa, false);
    DPP_ADD(0x143, 0xc, false);
#undef DPP_ADD
    return x;
}

constexpr int GL_QD = 0, GL_KI = 8192, GL_KDT = 16384, GL_P = 24576, GL_VT = 32768, GL_EDL = 49152, GL_WA = 49408, GL_BA = 53504, GL_QS = 54272, GL_KS = 62464, GL_VS = 70656, GL_CS = 87040;
__device__ __forceinline__ int gsw(int row, int col) { return row * 128 + ((((col >> 3) ^ (row & 7)) << 4) | ((col & 7) << 1)); }
#define GLA_BAR() do { asm volatile("s_waitcnt lgkmcnt(0)" ::: "memory"); __builtin_amdgcn_s_barrier(); asm volatile("" ::: "memory"); } while (0)
__device__ __forceinline__ void phase_gla(const h16* __restrict__ qkvg, const float* __restrict__ codes, const float* __restrict__ waf, const float* __restrict__ baf,
                          const float* __restrict__ wab, const float* __restrict__ bab, h16* __restrict__ of, h16* __restrict__ ob, LAS unsigned char* lds, int first, int stride, int reps) {
    const int tid = threadIdx.x, w = __builtin_amdgcn_readfirstlane(tid >> 6), l = tid & 63, m16 = l & 15, kg = l >> 4;
    LAS float* EDL = (LAS float*)(lds + GL_EDL); LAS float* WA = (LAS float*)(lds + GL_WA); LAS float* BA = (LAS float*)(lds + GL_BA);
    for (int item = first; item < NB * 8 * reps; item += stride) {
        const int b = (item >> 3) % NB, h = (item >> 1) & 3, dir = item & 1;
        const float* wa = dir ? wab : waf; const float* ba = dir ? bab : baf; h16* O = dir ? ob : of;
        __syncthreads();
        for (int i = tid; i < 16 * 64; i += NTHREADS) WA[i] = wa[(i >> 6) * 256 + h * 64 + (i & 63)];
        if (tid < 64) BA[tid] = ba[h * 64 + tid];
        f32x4 S[4];
#pragma unroll
        for (int m = 0; m < 4; ++m) S[m] = (f32x4){0.f, 0.f, 0.f, 0.f};
        h16x8 pq, pk, pv0, pv1; f32x4 pc;
#define GLA_ROW(n_, c_) ((size_t)b * SEQ + (dir ? (SEQ - 1 - (64 * (n_) + (c_))) : (64 * (n_) + (c_))))
#define GLA_FETCH(n_) do { const size_t rq_ = GLA_ROW(n_, tid >> 3); pq = *(const h16x8*)(qkvg + rq_ * 1536 + h * 64 + (tid & 7) * 8); pk = *(const h16x8*)(qkvg + rq_ * 1536 + 256 + h * 64 + (tid & 7) * 8); \
            const size_t rv0_ = GLA_ROW(n_, tid >> 4), rv1_ = GLA_ROW(n_, 32 + (tid >> 4)); pv0 = *(const h16x8*)(qkvg + rv0_ * 1536 + 512 + h * 128 + (tid & 15) * 8); pv1 = *(const h16x8*)(qkvg + rv1_ * 1536 + 512 + h * 128 + (tid & 15) * 8); \
            if (tid < 256) pc = *(const f32x4*)(codes + GLA_ROW(n_, tid >> 2) * 32 + dir * 16 + (tid & 3) * 4); } while (0)
#define GLA_PARK() do { { const int t_ = tid >> 3, p_ = tid & 7; *(LAS h16x8*)(lds + GL_QS + t_ * 128 + ((p_ ^ (t_ & 7)) << 4)) = pq; *(LAS h16x8*)(lds + GL_KS + t_ * 128 + ((p_ ^ (t_ & 7)) << 4)) = pk; } \
            { const int t0_ = tid >> 4, t1_ = 32 + (tid >> 4), p_ = tid & 15; *(LAS h16x8*)(lds + GL_VS + t0_ * 256 + ((p_ ^ ((t0_ & 7) << 1)) << 4)) = pv0; *(LAS h16x8*)(lds + GL_VS + t1_ * 256 + ((p_ ^ ((t1_ & 7) << 1)) << 4)) = pv1; } \
            if (tid < 256) *(LAS f32x4*)(lds + GL_CS + (tid >> 2) * 80 + (tid & 3) * 16) = pc; } while (0)
        GLA_FETCH(0);
        GLA_PARK();
        GLA_FETCH(1);
#pragma unroll 1
        for (int n = 0; n < SEQ / 64; ++n) {
            GLA_BAR();
            {
                const h16x8 cq = *(const LAS h16x8*)(lds + GL_QS + l * 128 + ((w ^ (l & 7)) << 4)), ck = *(const LAS h16x8*)(lds + GL_KS + l * 128 + ((w ^ (l & 7)) << 4));
                const h16x8 cv0 = *(const LAS h16x8*)(lds + GL_VS + l * 256 + (((2 * w) ^ ((l & 7) << 1)) << 4)), cv1 = *(const LAS h16x8*)(lds + GL_VS + l * 256 + (((2 * w + 1) ^ ((l & 7) << 1)) << 4));
                f32x4 cc[4];
#pragma unroll
                for (int r = 0; r < 4; ++r) cc[r] = *(const LAS f32x4*)(lds + GL_CS + l * 80 + r * 16);
                float z[8];
                { const f32x4 b0 = *(const LAS f32x4*)(BA + 8 * w), b1 = *(const LAS f32x4*)(BA + 8 * w + 4);
#pragma unroll
                  for (int j = 0; j < 4; ++j) { z[j] = b0[j]; z[4 + j] = b1[j]; } }
#pragma unroll
                for (int r = 0; r < 16; ++r) { const float cr = cc[r >> 2][r & 3]; const f32x4 w0 = *(const LAS f32x4*)(WA + r * 64 + 8 * w), w1 = *(const LAS f32x4*)(WA + r * 64 + 8 * w + 4);
#pragma unroll
                    for (int j = 0; j < 4; ++j) { z[j] += cr * w0[j]; z[4 + j] += cr * w1[j]; } }
                h16x8 qd, ki, kd; float edl[8];
#pragma unroll
                for (int j = 0; j < 8; ++j) {
                    const float ls = fminf(z[j], 0.f) - __logf(1.0f + __expf(-fabsf(z[j])));
                    float bb = ls * (1.0f / 16.0f);
                    bb = wave_incl_scan(bb);
                    const float bl = __builtin_bit_cast(float, __builtin_amdgcn_readlane(__builtin_bit_cast(int, bb), 63));
                    const float E = __expf(bb), Ei = __builtin_amdgcn_rcpf(E), el = __expf(bl);
                    edl[j] = el;
                    qd[j] = (h16)((float)cq[j] * 0.125f * E); const float kiv = (float)ck[j] * Ei; ki[j] = (h16)kiv; kd[j] = (h16)(kiv * el);
                }
                *(LAS h16x8*)(lds + GL_QD + l * 128 + ((w ^ (l & 7)) << 4)) = qd;
                *(LAS h16x8*)(lds + GL_KI + l * 128 + ((w ^ (l & 7)) << 4)) = ki;
#pragma unroll
                for (int j = 0; j < 8; ++j) *(LAS h16*)(lds + GL_KDT + gsw(8 * w + j, l)) = kd[j];
#pragma unroll
                for (int j = 0; j < 8; ++j) { *(LAS h16*)(lds + GL_VT + gsw(16 * w + j, l)) = cv0[j]; *(LAS h16*)(lds + GL_VT + gsw(16 * w + 8 + j, l)) = cv1[j]; }
                if (l == 0) {
#pragma unroll
                    for (int j = 0; j < 8; ++j) EDL[8 * w + j] = edl[j]; }
            }
            GLA_BAR();
            {
                const int mi = w & 3;
                h16x8 Aq[2];
                Aq[0] = *(const LAS h16x8*)(lds + GL_QD + gsw(16 * mi + m16, 8 * kg)); Aq[1] = *(const LAS h16x8*)(lds + GL_QD + gsw(16 * mi + m16, 32 + 8 * kg));
#pragma unroll
                for (int q = 0; q < 2; ++q) {
                    const int nj = 2 * (w >> 2) + q;
                    if (nj <= mi) {
                        const h16x8 B0 = *(const LAS h16x8*)(lds + GL_KI + gsw(16 * nj + m16, 8 * kg)), B1 = *(const LAS h16x8*)(lds + GL_KI + gsw(16 * nj + m16, 32 + 8 * kg));
                        f32x4 p = (f32x4){0.f, 0.f, 0.f, 0.f};
                        p = __builtin_amdgcn_mfma_f32_16x16x32_f16(Aq[0], B0, p, 0, 0, 0);
                        p = __builtin_amdgcn_mfma_f32_16x16x32_f16(Aq[1], B1, p, 0, 0, 0);
#pragma unroll
                        for (int r = 0; r < 4; ++r) { const int c = 16 * mi + 4 * kg + r, cp = 16 * nj + m16; const bool keep = dir ? (cp < c) : (cp <= c);
                            *(LAS h16*)(lds + GL_P + gsw(c, cp)) = (h16)(keep ? p[r] : 0.f); }
                    } else if ((nj >> 1) == (mi >> 1)) {
#pragma unroll
                        for (int r = 0; r < 4; ++r) *(LAS h16*)(lds + GL_P + gsw(16 * mi + 4 * kg + r, 16 * nj + m16)) = (h16)0.f;
                    }
                }
            }
            GLA_BAR();
            {
                h16x8 Bv[2];
                Bv[0] = *(const LAS h16x8*)(lds + GL_VT + gsw(16 * w + m16, 8 * kg)); Bv[1] = *(const LAS h16x8*)(lds + GL_VT + gsw(16 * w + m16, 32 + 8 * kg));
                h16x8 Sf[2];
#pragma unroll
                for (int ks = 0; ks < 2; ++ks)
#pragma unroll
                    for (int j = 0; j < 4; ++j) { Sf[ks][j] = (h16)S[2 * ks][j]; Sf[ks][4 + j] = (h16)S[2 * ks + 1][j]; }
#pragma unroll
                for (int mi = 0; mi < 4; ++mi) {
                    f32x4 o = (f32x4){0.f, 0.f, 0.f, 0.f};
#pragma unroll
                    for (int ks = 0; ks < 2; ++ks) {
                        if (!(ks == 1 && mi < 2)) { const h16x8 Ap = *(const LAS h16x8*)(lds + GL_P + gsw(16 * mi + m16, 32 * ks + 8 * kg)); o = __builtin_amdgcn_mfma_f32_16x16x32_f16(Ap, Bv[ks], o, 0, 0, 0); }
                        const h16x4 a0 = *(const LAS h16x4*)(lds + GL_QD + gsw(16 * mi + m16, 32 * ks + 4 * kg)), a1 = *(const LAS h16x4*)(lds + GL_QD + gsw(16 * mi + m16, 32 * ks + 16 + 4 * kg));
                        h16x8 Aqs;
#pragma unroll
                        for (int j = 0; j < 4; ++j) { Aqs[j] = a0[j]; Aqs[4 + j] = a1[j]; }
                        o = __builtin_amdgcn_mfma_f32_16x16x32_f16(Aqs, Sf[ks], o, 0, 0, 0);
                    }
#pragma unroll
                    for (int r = 0; r < 4; ++r) { const int c = 16 * mi + 4 * kg + r; const int tok = dir ? (SEQ - 1 - (64 * n + c)) : (64 * n + c);
                        O[((size_t)b * SEQ + tok) * 512 + h * 128 + 16 * w + m16] = (h16)o[r]; }
                }
#pragma unroll
                for (int mt = 0; mt < 4; ++mt) {
                    const f32x4 e4 = *(const LAS f32x4*)(EDL + 16 * mt + 4 * kg);
                    S[mt] = S[mt] * e4;
#pragma unroll
                    for (int ks = 0; ks < 2; ++ks) { const h16x8 Ak = *(const LAS h16x8*)(lds + GL_KDT + gsw(16 * mt + m16, 32 * ks + 8 * kg)); S[mt] = __builtin_amdgcn_mfma_f32_16x16x32_f16(Ak, Bv[ks], S[mt], 0, 0, 0); }
                }
            }
            if (n + 1 < SEQ / 64) GLA_PARK();
            if (n + 2 < SEQ / 64) GLA_FETCH(n + 2);
        }
    }
}

__device__ __forceinline__ void phase_mixbuild(const h16* __restrict__ of, const h16* __restrict__ ob, const h16* __restrict__ qkvg, const float* __restrict__ nw, const h16* __restrict__ z2,
                               h16* __restrict__ mix, LAS unsigned char* lds, int blk, int nblk) {
    LAS h16* tileT = (LAS h16*)lds;
    const int tid = threadIdx.x;
    float nwv[8];
#pragma unroll
    for (int j = 0; j < 8; ++j) nwv[j] = nw[(tid & 15) * 8 + j];
    for (int sl = blk; sl < NTOK / 64; sl += nblk) {
        const int tok0 = sl * 64;
        h16x8 zv[8];
#pragma unroll
        for (int i = 0; i < 8; ++i) zv[i] = *(const h16x8*)(z2 + (size_t)tid * NTOK + tok0 + 8 * i);
#pragma unroll 2
        for (int i = 0; i < 8; ++i) {
            const int task = tid + NTHREADS * i, token = task >> 6, head = (task >> 4) & 3, part = task & 15;
            const size_t row = (size_t)tok0 + token;
            const h16x8 a = *(const h16x8*)(of + row * 512 + head * 128 + part * 8), b = *(const h16x8*)(ob + row * 512 + head * 128 + part * 8);
            const h16x8 g = *(const h16x8*)(qkvg + row * 1536 + 1024 + head * 128 + part * 8);
            float o[8], ss = 0.f;
#pragma unroll
            for (int j = 0; j < 8; ++j) { o[j] = (float)a[j] + (float)b[j]; ss += o[j] * o[j]; }
            ss += __shfl_xor(ss, 1); ss += __shfl_xor(ss, 2); ss += __shfl_xor(ss, 4); ss += __shfl_xor(ss, 8);
            const float rstd = rsqrtf(ss * (1.0f / 128.0f) + EPS);
            h16x8 r;
#pragma unroll
            for (int j = 0; j < 8; ++j) r[j] = (h16)(o[j] * rstd * nwv[j] * siluf_((float)g[j]));
            *(h16x8*)(mix + row * DM + head * 128 + part * 8) = r;
        }
        __syncthreads();
#pragma unroll
        for (int i = 0; i < 8; ++i)
#pragma unroll
            for (int j = 0; j < 8; ++j) tileT[(8 * i + j) * 520 + tid] = zv[i][j];
        __syncthreads();
#pragma unroll
        for (int i = 0; i < 8; ++i) { const int idx = tid + NTHREADS * i, token = idx >> 6, c8 = (idx & 63) * 8;
            *(h16x8*)(mix + (size_t)(tok0 + token) * DM + 512 + c8) = *(const LAS h16x8*)(tileT + token * 520 + c8); }
    }
}

#define XB_TMO      128
#define XB_XCNT(j)  (256  + 64 * (j))
#define XB_XSUB(j)  (1280 + 64 * (j))
#define XB_XGEN(j)  (2304 + 64 * (j))
#define XB_TOP      3328
#define XB_TOPGEN   3392
#define XCD_BAR_WORDS 3456
#define XB_SPIN_CAP (1u << 22)
__device__ __forceinline__ unsigned xb_ld(unsigned* p)              { return __hip_atomic_load(p, __ATOMIC_RELAXED, __HIP_MEMORY_SCOPE_AGENT); }
__device__ __forceinline__ unsigned xb_add(unsigned* p, unsigned v) { return __hip_atomic_fetch_add(p, v, __ATOMIC_RELAXED, __HIP_MEMORY_SCOPE_AGENT); }
__device__ __forceinline__ unsigned xb_xcc_id() { return (unsigned)__builtin_amdgcn_s_getreg((3 << 11) | 20) & 0xFu; }
#define XB_SPIN(cond, bar) do { unsigned _sp = 0; while (cond) { __builtin_amdgcn_s_sleep(1); \
    if ((++_sp & 255u) == 0u) { if (xb_ld(&(bar)[XB_TMO])) break; if (_sp > XB_SPIN_CAP) { atomicAdd(&(bar)[XB_TMO], 1u); break; } } } } while (0)
struct XcdBarrier { unsigned* bar; unsigned x; volatile LAS unsigned* st; };
__device__ __forceinline__ void xcd_barrier_post(unsigned* bar) {
    if (threadIdx.x == 0) (void)xb_add(&bar[XB_XCNT(xb_xcc_id())], 1u);
}
__device__ __forceinline__ void xcd_barrier_complete(unsigned* bar, unsigned x, unsigned& nloc, unsigned& nx) {
    const unsigned G = gridDim.x * gridDim.y * gridDim.z;
    unsigned sum, cnt, mine, sp = 0u;
    for (;;) {
        sum = 0u; cnt = 0u; mine = 0u;
#pragma unroll
        for (unsigned j = 0; j < 16; ++j) { const unsigned c = xb_ld(&bar[XB_XCNT(j)]); sum += c; cnt += (c > 0u) ? 1u : 0u; mine = (j == x) ? c : mine; }
        if (sum == G) break;
        __builtin_amdgcn_s_sleep(1);
        if ((++sp & 255u) == 0u) { if (xb_ld(&bar[XB_TMO])) break; if (sp > XB_SPIN_CAP) { atomicAdd(&bar[XB_TMO], 1u); break; } }
    }
    nloc = mine > 0u ? mine : 1u; nx = cnt > 0u ? cnt : 1u;
}
__device__ __forceinline__ void xcd_barrier(unsigned* bar_, volatile LAS unsigned* st_) {
    XcdBarrier b; b.bar = bar_; b.x = xb_xcc_id(); b.st = st_;
    asm volatile("s_waitcnt vmcnt(0)" ::: "memory");
    __syncthreads();
    if (threadIdx.x == 0) {
        unsigned* bar = b.bar;
        __builtin_amdgcn_s_waitcnt(0);
        unsigned nloc = b.st[0], nx = b.st[1];
        if (nloc == 0u) { xcd_barrier_complete(bar, b.x, nloc, nx); b.st[0] = nloc; b.st[1] = nx; }
        const unsigned old = xb_add(&bar[XB_XSUB(b.x)], 1u);
        const unsigned gen = old / nloc;
        if (old + 1u == (gen + 1u) * nloc) {
            __builtin_amdgcn_fence(__ATOMIC_RELEASE, "agent");
            asm volatile("s_waitcnt vmcnt(0)" ::: "memory");
            const unsigned og = xb_add(&bar[XB_TOP], 1u);
            const unsigned tg = og / nx;
            if (og + 1u == (tg + 1u) * nx) xb_add(&bar[XB_TOPGEN], 1u);
            else XB_SPIN(xb_ld(&bar[XB_TOPGEN]) == tg, bar);
            __builtin_amdgcn_fence(__ATOMIC_ACQUIRE, "agent");
            xb_add(&bar[XB_XGEN(b.x)], 1u);
            asm volatile("s_waitcnt vmcnt(0)" ::: "memory");
        } else {
            XB_SPIN(xb_ld(&bar[XB_XGEN(b.x)]) == gen, bar);
            __builtin_amdgcn_fence(__ATOMIC_ACQUIRE, "agent");
            asm volatile("s_waitcnt vmcnt(0)" ::: "memory");
        }
    }
    __syncthreads();
}

enum { PH_PREP = 0, PH_NORM1, PH_FILT, PH_G1A, PH_G1B, PH_GLA, PH_HYENA, PH_GLAMIX, PH_G2, PH_ROUTER, PH_TOPK, PH_MOE1, PH_MOE2, PH_NORM3, PH_G5, PH_G6, PH_FINAL, PH_COUNT };

template <bool COOP>
__global__ __launch_bounds__(NTHREADS, 2) void mega(Args a) {
    extern __shared__ __attribute__((aligned(16))) unsigned char shm[];
    LAS unsigned char* lds = (LAS unsigned char*)shm;
    const int blk = blockIdx.x, nblk = gridDim.x;
    unsigned char* ws = a.ws;
#ifndef PROBE_MASK
#define PROBE_MASK 0u
#endif
#define RUN(P, SYNC, ...) if (a.ph_lo <= (P) && (P) < a.ph_hi) { { __syncthreads(); const float pscale = 1.f; (void)pscale; __VA_ARGS__ } \
        if constexpr (((PROBE_MASK >> (P)) & 1u) != 0u && (P) != PH_GLA && (P) != PH_HYENA) { if (COOP) cg::this_grid().sync(); __syncthreads(); const float pscale = 0.f; (void)pscale; __VA_ARGS__ } \
        if (COOP && (SYNC) != 0 && (P) + 1 < a.ph_hi) { if ((SYNC) == 1) { cg::this_grid().sync(); xcd_barrier_post((unsigned*)(a.ws + OFF_XBAR)); } else xcd_barrier((unsigned*)(a.ws + OFF_XBAR), (volatile LAS unsigned*)(lds + LDS_BYTES - 16)); } }
    if (threadIdx.x < 4) ((volatile LAS unsigned*)(lds + LDS_BYTES - 16))[threadIdx.x] = 0u;
    __syncthreads();
    RUN(PH_PREP, 0, phase_prep(a, lds, blk, nblk);)
    RUN(PH_NORM1, 0, phase_rmsnorm_h16(a.in[I_X], a.in[I_LNMIX], (h16*)(ws + OFF_H), blk, nblk);)
    RUN(PH_FILT, 1, phase_filters(a, (h16*)(ws + OFF_GR), lds, blk, nblk);)
    RUN(PH_G1A, 0, { g8::DenseSched S; S.init(ws + OFF_WINA, NTOK, NA1, DM, nblk, blk); g8::EpiQKVG E{(h16*)(ws + OFF_QKVG), (float*)(ws + OFF_CODES)};
        g8::gemm_phase(lds, (const char*)(ws + OFF_H), DM, S, E); })
    RUN(PH_G1B, 2, { g8::DenseSched S; S.init(ws + OFF_H, HYC, NTOK, DM, nblk, blk); g8::EpiH16 E{(h16*)(ws + OFF_HY), NTOK};
        g8::gemm_phase(lds, (const char*)(ws + OFF_WINHY), DM, S, E); })
    RUN(PH_GLA, 0, { const int ng = nblk >= 2 * NB * 8 ? NB * 8 : nblk;
        if (blk >= nblk - ng) phase_gla((const h16*)(ws + OFF_QKVG), (const float*)(ws + OFF_CODES), a.in[I_WAF], a.in[I_BAF], a.in[I_WAB], a.in[I_BAB], (h16*)(ws + OFF_OF), (h16*)(ws + OFF_OB), lds, blk - (nblk - ng), ng, 1 + (int)((PROBE_MASK >> 5) & 1u)); })
    RUN(PH_HYENA, 2, phase_hyena((const h16*)(ws + OFF_HY), (h16*)(ws + OFF_Z2), (const h16*)(ws + OFF_GR), a.in[I_HCW], a.in[I_HCB], (unsigned*)(ws + OFF_CTR), lds, 1 + (int)((PROBE_MASK >> 6) & 1u));)
    RUN(PH_GLAMIX, 2, phase_mixbuild((const h16*)(ws + OFF_OF), (const h16*)(ws + OFF_OB), (const h16*)(ws + OFF_QKVG), a.in[I_GLANW], (const h16*)(ws + OFF_Z2), (h16*)(ws + OFF_H), lds, blk, nblk);)
    RUN(PH_G2, 2, { g8::DenseSched S; S.init(ws + OFF_WOUT, NTOK, DM, DM, nblk, blk); g8::EpiResid E{a.in[I_X], (h16*)a.out};
        g8::gemm_phase(lds, (const char*)(ws + OFF_H), DM, S, E); })
    RUN(PH_ROUTER, 2, phase_router((const h16*)a.out, a.in[I_LNFFN], a.in[I_WROUTER], ws + OFF_H, (float*)(ws + OFF_PROBS), lds, blk, nblk);)
    RUN(PH_TOPK, 2, phase_topk((const float*)(ws + OFF_PROBS), (int*)(ws + OFF_SELIDX), (float*)(ws + OFF_SELGATE), (int*)(ws + OFF_SLOTMAP), lds, blk, nblk);)
    RUN(PH_MOE1, 2, { LAS unsigned short* lrow = (LAS unsigned short*)(lds + g8::STAGE_BYTES); g8::Moe1Sched S{(const char*)(ws + OFF_WGU), (const int*)(ws + OFF_SELIDX), nblk, blk, lrow}; S.preload(lrow); g8::EpiHid E{ws + OFF_HID};
        g8::gemm_phase<g8::EpiHid, g8::Moe1Sched, true>(lds, (const char*)(ws + OFF_H), DM / 2, S, E); })
    RUN(PH_MOE2, 2, { g8::Moe2Sched S{(const char*)(ws + OFF_WD), nblk, blk}; g8::EpiDown E{ws + OFF_Y, (const float*)(ws + OFF_SELGATE)};
        g8::gemm_phase<g8::EpiDown, g8::Moe2Sched, true>(lds, (const char*)(ws + OFF_HID), DFF / 2, S, E); })
    RUN(PH_NORM3, 0, phase_combine_norm((const h16*)a.out, ws + OFF_Y, (const int*)(ws + OFF_SLOTMAP), a.in[I_LNPLE], (h16*)(ws + OFF_H3), (float*)(ws + OFF_RSTD3), (float*)(ws + OFF_ROWSQ), blk, nblk);)
    RUN(PH_G5, 2, { g8::DenseSched S; S.init(ws + OFF_WP, NTOK, DM, 256, nblk, blk); g8::EpiH16 E{(h16*)(ws + OFF_PP), DM};
        g8::gemm_phase(lds, (const char*)(ws + OFF_P16), 256, S, E); })
    RUN(PH_G6, 2, { g8::DenseSched S; S.init(ws + OFF_WG, NTOK, DM, DM, nblk, blk); g8::EpiPle E{(const h16*)(ws + OFF_H3), (const float*)(ws + OFF_RSTD3), a.in[I_LNPLE], (const h16*)(ws + OFF_PP), (h16*)(ws + OFF_R3H), (float*)(ws + OFF_ROWSQ)};
        g8::gemm_phase(lds, (const char*)(ws + OFF_H3), DM, S, E); })
    RUN(PH_FINAL, 0, phase_final_norm((const h16*)(ws + OFF_R3H), (const float*)(ws + OFF_ROWSQ), a.in[I_FNW], a.out, blk, nblk);)
}

extern "C" void kernel_launch(void* const* d_in, const int* in_sizes, int n_in, void* d_out, int out_size, void* d_ws, size_t ws_size, hipStream_t stream) {
    static int grid = 0;
    if (grid == 0) {
        if (n_in != N_IN || out_size != NTOK * DM || ws_size < WS_END) { fprintf(stderr, "kernel_launch: unexpected shapes (n_in %d, out %d, ws %zu, need %zu)\n", n_in, out_size, ws_size, (size_t)WS_END); grid = -1; return; }
        int dev = 0, cus = 0, per_cu = 0;
        (void)hipGetDevice(&dev); (void)hipDeviceGetAttribute(&cus, hipDeviceAttributeMultiprocessorCount, dev);
        (void)hipFuncSetAttribute((const void*)mega<true>, hipFuncAttributeMaxDynamicSharedMemorySize, LDS_BYTES);
        (void)hipOccupancyMaxActiveBlocksPerMultiprocessor(&per_cu, (const void*)mega<true>, NTHREADS, LDS_BYTES);
        if (per_cu < 1) { fprintf(stderr, "kernel_launch: occupancy query says %d blocks per CU\n", per_cu); per_cu = 1; }
        grid = cus * (per_cu > 1 ? 1 : per_cu);
        (void)hipGetLastError();
    }
    if (grid < 0) return;
    Args a{};
    for (int i = 0; i < N_IN; ++i) a.in[i] = (const float*)d_in[i];
    a.out = (float*)d_out; a.ws = (unsigned char*)d_ws;
    a.ph_lo = 0; a.ph_hi = PH_COUNT;
    void* args[] = {&a};
    hipError_t e = hipLaunchCooperativeKernel((const void*)mega<true>, dim3(grid), dim3(NTHREADS), args, LDS_BYTES, stream);
    if (e != hipSuccess) fprintf(stderr, "kernel_launch: cooperative launch failed: %s (grid %d)\n", hipGetErrorString(e), grid);
}
```

```cpp
#include <hip/hip_runtime.h>
#include <hip/hip_cooperative_groups.h>
#include <cstdio>
#include <cstdint>
#include <cstddef>

namespace cg = cooperative_groups;

#define LAS __attribute__((address_space(3)))
typedef _Float16 h16;
typedef _Float16 h16x8 __attribute__((ext_vector_type(8)));
typedef _Float16 h16x4 __attribute__((ext_vector_type(4)));
typedef _Float16 h16x2 __attribute__((ext_vector_type(2)));
typedef float f32x4 __attribute__((ext_vector_type(4)));
typedef float f32x2 __attribute__((ext_vector_type(2)));
typedef unsigned u32x4 __attribute__((ext_vector_type(4)));
typedef unsigned u32x2 __attribute__((ext_vector_type(2)));
typedef int i32x8 __attribute__((ext_vector_type(8)));
typedef int i32x4 __attribute__((ext_vector_type(4)));

constexpr int NB = 16, SEQ = 4096, DM = 1024, NTOK = NB * SEQ;
constexpr int INCOLS = 3104;
constexpr int NEXP = 16, CAP = 512, DFF = 2048;
constexpr int HYW = 512, HYC = 1536;
constexpr float EPS = 1e-6f;

enum { I_X = 0, I_P, I_LNMIX, I_WIN, I_WAF, I_BAF, I_WAB, I_BAB, I_GLANW, I_HCW, I_HCB, I_FW1, I_FB1, I_FFR1, I_FW2, I_FB2, I_FFR2,
       I_FW3, I_HBIAS, I_WOUT, I_LNFFN, I_WROUTER, I_WGATE, I_WUP, I_WDOWN, I_LNPLE, I_WPG, I_WPP, I_FNW, N_IN };

constexpr size_t AL(size_t x) { return (x + 255) & ~(size_t)255; }
constexpr int NA1 = 1792;
constexpr size_t OFF_WINA = 0;
constexpr size_t OFF_WINHY = OFF_WINA + AL((size_t)NA1 * DM * 2);
constexpr size_t OFF_WOUT = OFF_WINHY + AL((size_t)HYC * DM * 2);
constexpr size_t OFF_WGU = OFF_WOUT + AL((size_t)DM * DM * 2);
constexpr size_t OFF_WD = OFF_WGU + AL((size_t)NEXP * 2 * DFF * DM * 2);
constexpr size_t OFF_WG = OFF_WD + AL((size_t)NEXP * DM * DFF * 2);
constexpr size_t OFF_WP = OFF_WG + AL((size_t)DM * DM * 2);
constexpr size_t OFF_P16 = OFF_WP + AL((size_t)DM * 256 * 2);
constexpr size_t OFF_PROBS = OFF_P16 + AL((size_t)NTOK * 256 * 2);
constexpr size_t OFF_SELIDX = OFF_PROBS + AL((size_t)NB * NEXP * SEQ * 4);
constexpr size_t OFF_SELGATE = OFF_SELIDX + AL((size_t)NB * NEXP * CAP * 4);
constexpr size_t OFF_SLOTMAP = OFF_SELGATE + AL((size_t)NB * NEXP * CAP * 4);
constexpr size_t OFF_CTR = OFF_SLOTMAP + AL((size_t)NTOK * NEXP * 4);
constexpr size_t OFF_XBAR = OFF_CTR + 256;
constexpr size_t OFF_BIG = OFF_XBAR + AL(3456 * 4);
constexpr size_t OFF_QKVG = OFF_BIG;
constexpr size_t OFF_HY = OFF_QKVG + AL((size_t)NTOK * 1536 * 2);
constexpr size_t OFF_CODES = OFF_HY + AL((size_t)HYC * NTOK * 2);
constexpr size_t OFF_OF = OFF_CODES + AL((size_t)NTOK * 32 * 4);
constexpr size_t OFF_OB = OFF_OF + AL((size_t)NTOK * 512 * 2);
constexpr size_t OFF_GR = OFF_OB + AL((size_t)NTOK * 512 * 2);
constexpr size_t OFF_H = OFF_GR + AL((size_t)2 * HYW * 8192 * 2);
constexpr size_t OFF_Z2 = OFF_H + AL((size_t)NTOK * DM * 2);
constexpr size_t END_A = OFF_Z2 + AL((size_t)HYW * NTOK * 2);
constexpr size_t OFF_HID = OFF_BIG;
constexpr size_t OFF_Y = OFF_HID + AL((size_t)NB * NEXP * CAP * DFF * 2);
constexpr size_t END_B = OFF_Y + AL((size_t)NB * NEXP * CAP * DM * 2);
static_assert(OFF_H >= OFF_Y, "h2 (read by the up/gate GEMM) must not be overwritten by HID");
constexpr size_t OFF_H3 = OFF_BIG;
constexpr size_t OFF_PP = OFF_H3 + AL((size_t)NTOK * DM * 2);
constexpr size_t OFF_R3H = OFF_PP + AL((size_t)NTOK * DM * 2);
constexpr size_t OFF_RSTD3 = OFF_R3H + AL((size_t)NTOK * DM * 2);
constexpr size_t OFF_ROWSQ = OFF_RSTD3 + AL((size_t)NTOK * 4);
constexpr size_t END_C = OFF_ROWSQ + AL((size_t)NTOK * 4);
constexpr size_t WS_END = END_A > END_B ? (END_A > END_C ? END_A : END_C) : (END_B > END_C ? END_B : END_C);

constexpr int NTHREADS = 512;
constexpr int LDS_BYTES = 156 * 1024;
constexpr float HY_SCALE = 64.0f;
constexpr int FP8_WSHIFT = 5;


struct Args {
    const float* in[N_IN];
    float* out;
    unsigned char* ws;
    int ph_lo, ph_hi;
};

__device__ __forceinline__ float wave_sum(float v) {
#pragma unroll
    for (int o = 32; o >= 1; o >>= 1) v += __shfl_xor(v, o);
    return v;
}
__device__ __forceinline__ float sigmoidf_(float x) { return __builtin_amdgcn_rcpf(1.0f + __expf(-x)); }
__device__ __forceinline__ float siluf_(float x) { return x * __builtin_amdgcn_rcpf(1.0f + __expf(-x)); }
__device__ __forceinline__ unsigned pack_h2(float a, float b) {
    h16x2 v; v.x = (h16)a; v.y = (h16)b; return __builtin_bit_cast(unsigned, v);
}


__device__ __forceinline__ void sincos_f(float x, float& s, float& c) {
    const float kf = rintf(x * 0.6366197723675814f);
    float r = fmaf(kf, -1.5707963705062866f, x); r = fmaf(kf, 4.371139000186241e-8f, r);
    const float r2 = r * r;
    const float sp = r + r * r2 * (-1.6666667e-1f + r2 * (8.3333338e-3f + r2 * (-1.9841270e-4f + r2 * 2.7557319e-6f)));
    const float cp = 1.0f + r2 * (-0.5f + r2 * (4.1666668e-2f + r2 * (-1.3888889e-3f + r2 * (2.4801587e-5f - r2 * 2.7557319e-7f))));
    const int k = (int)kf & 3;
    s = (k == 0) ? sp : (k == 1) ? cp : (k == 2) ? -sp : -cp;
    c = (k == 0) ? cp : (k == 1) ? -sp : (k == 2) ? -cp : sp;
}
__device__ __forceinline__ float sin_f(float x) { float s, c; sincos_f(x, s, c); return s; }

__device__ __forceinline__ unsigned pack_fp8x4(float a, float b, float c, float d) {
    int r = 0; r = __builtin_amdgcn_cvt_pk_fp8_f32(a, b, r, false); r = __builtin_amdgcn_cvt_pk_fp8_f32(c, d, r, true); return (unsigned)r;
}

namespace g8 {
constexpr int BM = 256, BK = 64, HALF = 128, HTB = HALF * BK * 2, STAGE_BYTES = 8 * HTB;
__device__ __forceinline__ int lds_byte(int r, int c) { const int st = (r >> 4) * 2 + (c >> 5), rr = r & 15, cc = c & 31, ob = rr * 64 + cc * 2; return st * 1024 + (ob ^ (((ob >> 9) & 1) << 5)); }
__device__ __forceinline__ void stage_rc(int b, int& R, int& C) { const int st = b / 1024, sb = b % 1024, swz = sb ^ (((sb >> 9) & 1) << 5); R = (st >> 1) * 16 + swz / 64; C = (st & 1) * 32 + (swz % 64) / 2; }
__device__ __forceinline__ int perm32(int rho) { const int n = rho >> 4, i = rho & 15; return 8 * (i >> 2) + 4 * n + (i & 3); }

struct Unit { const char* B; int pm, pn, g; unsigned rowbase; int ord; };

template <class Epi, class Sched, bool FP8 = false>
__device__ __forceinline__ void gemm_phase(LAS unsigned char* lds, const char* A, const int K, const Sched& S, const Epi& E) {
    const int tid = threadIdx.x, wid = __builtin_amdgcn_readfirstlane(tid >> 6), lane = tid & 63, wr = wid >> 2, wc = wid & 3, fr = lane & 15, fq = lane >> 4;
    const int nt = K / BK;
    int Rr[2], Cc[2]; unsigned voffB[2];
#pragma unroll
    for (int i = 0; i < 2; ++i) { stage_rc(tid * 16 + i * 8192, Rr[i], Cc[i]); const int Rb = Epi::PERM ? ((Rr[i] & ~31) + perm32(Rr[i] & 31)) : Rr[i];
        voffB[i] = (unsigned)(Rb * K + Cc[i]) * 2u; }
    const size_t kstep = (size_t)(BK * 2);
    const size_t hstep = (size_t)HALF * K * 2;
    const unsigned ldsw = (unsigned)wid * 1024u;
    const int aoff = lds_byte(wr * 64 + fr, fq * 8), boff = lds_byte(wc * 32 + fr, fq * 8);
#define G8_SA(b, h) (((b) * 2 + (h)) * HTB)
#define G8_SB(b, h) ((4 + (b) * 2 + (h)) * HTB)
#define G8_STAGE(bufoff, gbase, v0, v1) do { \
        __builtin_amdgcn_global_load_lds((const unsigned*)((const char*)(gbase) + (v0)), (LAS unsigned*)(lds + (bufoff) + ldsw), 16, 0, 0); \
        __builtin_amdgcn_global_load_lds((const unsigned*)((const char*)(gbase) + (v1)), (LAS unsigned*)(lds + (bufoff) + ldsw + 8192), 16, 0, 0); } while (0)
#define G8_LDA(dst, b, h) do { _Pragma("unroll") for (int m = 0; m < 4; ++m) { \
        const i32x4 lo_ = *(const LAS i32x4*)(lds + G8_SA(b, h) + aoff + m * 2048), hi_ = *(const LAS i32x4*)(lds + G8_SA(b, h) + aoff + m * 2048 + 1024); \
        dst[m] = __builtin_shufflevector(lo_, hi_, 0, 1, 2, 3, 4, 5, 6, 7); } } while (0)
#define G8_LDB(dst, b, h) do { _Pragma("unroll") for (int n = 0; n < 2; ++n) { \
        const i32x4 lo_ = *(const LAS i32x4*)(lds + G8_SB(b, h) + boff + n * 2048), hi_ = *(const LAS i32x4*)(lds + G8_SB(b, h) + boff + n * 2048 + 1024); \
        dst[n] = __builtin_shufflevector(lo_, hi_, 0, 1, 2, 3, 4, 5, 6, 7); } } while (0)
#define G8_MMA(ai, bj, At, Bt) do { __builtin_amdgcn_s_setprio(1); \
        if constexpr (FP8) { _Pragma("unroll") for (int m = 0; m < 4; ++m) _Pragma("unroll") for (int n = 0; n < 2; ++n) \
            asm volatile("v_mfma_scale_f32_16x16x128_f8f6f4 %0, %1, %2, %0, %3, %3 op_sel_hi:[0,0,0]" : "+v"(acc[ai][bj][m][n]) : "v"(Bt[n]), "v"(At[m]), "v"(sc_one)); } \
        else { _Pragma("unroll") for (int m = 0; m < 4; ++m) _Pragma("unroll") for (int n = 0; n < 2; ++n) { \
            const i32x8 a_ = At[m], b_ = Bt[n]; \
            const h16x8 a0_ = __builtin_bit_cast(h16x8, __builtin_shufflevector(a_, a_, 0, 1, 2, 3)), a1_ = __builtin_bit_cast(h16x8, __builtin_shufflevector(a_, a_, 4, 5, 6, 7)); \
            const h16x8 b0_ = __builtin_bit_cast(h16x8, __builtin_shufflevector(b_, b_, 0, 1, 2, 3)), b1_ = __builtin_bit_cast(h16x8, __builtin_shufflevector(b_, b_, 4, 5, 6, 7)); \
            acc[ai][bj][m][n] = __builtin_amdgcn_mfma_f32_16x16x32_f16(b0_, a0_, acc[ai][bj][m][n], 0, 0, 0); \
            acc[ai][bj][m][n] = __builtin_amdgcn_mfma_f32_16x16x32_f16(b1_, a1_, acc[ai][bj][m][n], 0, 0, 0); } } \
        __builtin_amdgcn_s_setprio(0); } while (0)
#define G8_WAIT_V(n) asm volatile("s_waitcnt vmcnt(" #n ")" ::: "memory")
#define G8_WAIT_L(n) asm volatile("s_waitcnt lgkmcnt(" #n ")" ::: "memory")
#define G8_BAR __builtin_amdgcn_s_barrier()
#define G8_SCHED __builtin_amdgcn_sched_barrier(0)
    Unit cur, nxt; int ui = 0;
    if (!S.next(0, cur)) return;
    f32x4 acc[2][2][4][2];
#pragma unroll
    for (int a = 0; a < 2; ++a)
#pragma unroll
        for (int b = 0; b < 2; ++b)
#pragma unroll
            for (int m = 0; m < 4; ++m)
#pragma unroll
                for (int n = 0; n < 2; ++n) acc[a][b][m][n] = (f32x4){0.f, 0.f, 0.f, 0.f};
    i32x8 At[4], B0[2], B1[2];
    const int sc_one = 0x7f7f7f7f; (void)sc_one;
    unsigned va00, va01, va10, va11, vn00, vn01, vn10, vn11;
    va00 = (S.arow(cur, Rr[0]) * (unsigned)K + (unsigned)Cc[0]) * 2u; va01 = (S.arow(cur, Rr[1]) * (unsigned)K + (unsigned)Cc[1]) * 2u;
    va10 = (S.arow(cur, HALF + Rr[0]) * (unsigned)K + (unsigned)Cc[0]) * 2u; va11 = (S.arow(cur, HALF + Rr[1]) * (unsigned)K + (unsigned)Cc[1]) * 2u;
    vn00 = va00; vn01 = va01; vn10 = va10; vn11 = va11;
    const char* cB = cur.B;
    G8_STAGE(G8_SB(0, 0), cB, voffB[0], voffB[1]); G8_STAGE(G8_SA(0, 0), A, va00, va01); G8_STAGE(G8_SB(0, 1), cB + hstep, voffB[0], voffB[1]); G8_STAGE(G8_SA(0, 1), A, va10, va11);
    if (wr == 1) G8_BAR;
    G8_WAIT_V(4); G8_BAR;
    G8_STAGE(G8_SB(1, 0), cB + kstep, voffB[0], voffB[1]); G8_STAGE(G8_SA(1, 0), A + kstep, va00, va01); G8_STAGE(G8_SB(1, 1), cB + hstep + kstep, voffB[0], voffB[1]);
    G8_WAIT_V(6); G8_BAR;
    for (;;) {
        const bool has_next = S.next(ui + 1, nxt);
        const char* nB = has_next ? nxt.B : cB;
        if (has_next) {
            vn00 = (S.arow(nxt, Rr[0]) * (unsigned)K + (unsigned)Cc[0]) * 2u; vn01 = (S.arow(nxt, Rr[1]) * (unsigned)K + (unsigned)Cc[1]) * 2u;
            vn10 = (S.arow(nxt, HALF + Rr[0]) * (unsigned)K + (unsigned)Cc[0]) * 2u; vn11 = (S.arow(nxt, HALF + Rr[1]) * (unsigned)K + (unsigned)Cc[1]) * 2u;
        }
        for (int t = 0; t < nt; t += 2) {
            const bool last = (t == nt - 2);
            const char* a1 = A + (size_t)(t + 1) * kstep;
            const char* a2 = last ? A : A + (size_t)(t + 2) * kstep; const char* b2 = last ? nB : cB + (size_t)(t + 2) * kstep;
            const char* a3 = a2 + kstep; const char* b3 = b2 + kstep;
            const unsigned w00 = last ? vn00 : va00, w01 = last ? vn01 : va01, w10 = last ? vn10 : va10, w11 = last ? vn11 : va11;
            G8_LDB(B0, 0, 0); G8_SCHED; G8_LDA(At, 0, 0); G8_STAGE(G8_SA(1, 1), a1, va10, va11);
            G8_WAIT_L(8); G8_BAR; G8_WAIT_L(0); G8_MMA(0, 0, At, B0); G8_BAR; G8_SCHED;
            G8_LDB(B1, 0, 1); G8_STAGE(G8_SB(0, 0), b2, voffB[0], voffB[1]);
            G8_BAR; G8_WAIT_L(0); G8_MMA(0, 1, At, B1); G8_BAR;
            G8_LDA(At, 0, 1); G8_STAGE(G8_SA(0, 0), a2, w00, w01);
            G8_BAR; G8_WAIT_L(0); G8_MMA(1, 0, At, B0); G8_BAR; G8_SCHED;
            G8_STAGE(G8_SB(0, 1), b2 + hstep, voffB[0], voffB[1]);
            G8_WAIT_V(6); G8_BAR; G8_MMA(1, 1, At, B1); G8_BAR;
            G8_LDB(B0, 1, 0); G8_SCHED; G8_LDA(At, 1, 0); G8_STAGE(G8_SA(0, 1), a2, w10, w11);
            G8_WAIT_L(8); G8_BAR; G8_WAIT_L(0); G8_MMA(0, 0, At, B0); G8_BAR; G8_SCHED;
            G8_LDB(B1, 1, 1); G8_STAGE(G8_SB(1, 0), b3, voffB[0], voffB[1]);
            G8_BAR; G8_WAIT_L(0); G8_MMA(0, 1, At, B1); G8_BAR;
            G8_LDA(At, 1, 1); G8_STAGE(G8_SA(1, 0), a3, w00, w01);
            G8_BAR; G8_WAIT_L(0); G8_MMA(1, 0, At, B0); G8_BAR; G8_SCHED;
            G8_STAGE(G8_SB(1, 1), b3 + hstep, voffB[0], voffB[1]);
            G8_WAIT_V(6); G8_BAR; G8_MMA(1, 1, At, B1); G8_BAR;
        }
        if constexpr (FP8) asm volatile("s_nop 15\n\ts_nop 15" ::: "memory");
        E(acc, cur, wr, wc, fr, fq);
        if (!has_next) break;
#pragma unroll
        for (int a = 0; a < 2; ++a)
#pragma unroll
            for (int b = 0; b < 2; ++b)
#pragma unroll
                for (int m = 0; m < 4; ++m)
#pragma unroll
                    for (int n = 0; n < 2; ++n) acc[a][b][m][n] = (f32x4){0.f, 0.f, 0.f, 0.f};
        cur = nxt; cB = nB; va00 = vn00; va01 = vn01; va10 = vn10; va11 = vn11; ++ui;
    }
    G8_WAIT_V(0);
    if (wr == 0) G8_BAR;
    G8_BAR;
#undef G8_SA
#undef G8_SB
#undef G8_STAGE
#undef G8_LDA
#undef G8_LDB
#undef G8_MMA
#undef G8_WAIT_V
#undef G8_WAIT_L
#undef G8_BAR
#undef G8_SCHED
}

struct DenseSched {
    const char* Bt; int K, nM, nN, nwg, G, c;
    __device__ void init(const void* Bt_, int M, int N, int K_, int G_, int c_) { Bt = (const char*)Bt_; K = K_; nM = M / BM; nN = N / BM; nwg = nM * nN; G = G_; c = c_; }
    __device__ bool next(int i, Unit& u) const {
        const long L = (long)i * G + c; if (L >= nwg) return false;
        int wgid = (int)L; { const int q = nwg / 8, r = nwg % 8, xcd = wgid % 8, off = wgid / 8; wgid = (xcd < r ? xcd * (q + 1) : r * (q + 1) + (xcd - r) * q) + off; }
        const int nig = 8 * nN, gid = wgid / nig, fm = gid * 8, gsz = (nM - fm) < 8 ? (nM - fm) : 8;
        u.pm = fm + ((wgid % nig) % gsz); u.pn = (wgid % nig) / gsz; u.g = 0; u.rowbase = (unsigned)u.pm * BM; u.ord = 0;
        u.B = Bt + (size_t)u.pn * BM * K * 2; return true;
    }
    __device__ __forceinline__ unsigned arow(const Unit& u, int r) const { return u.rowbase + (unsigned)r; }
};
struct Moe1Sched {
    const char* W; const int* rowmap; int G, c; const LAS unsigned short* lrow;
    __device__ bool next(int i, Unit& u) const {
        const long L = (long)i * G + c; if (L >= NEXP * 512) return false;
        const int e = (int)(L / 512), w = (int)(L % 512), cc = w % 256, r = w / 256, xcd = cc % 8, j = cc / 8;
        const int mt = xcd * 4 + (j & 3), nt_ = r * 8 + (j >> 2), b = mt >> 1;
        u.pm = mt & 1; u.pn = nt_; u.g = b * NEXP + e; u.rowbase = (unsigned)u.g * CAP + (unsigned)u.pm * BM; u.ord = i;
        u.B = W + ((size_t)e * 2 * DFF + (size_t)nt_ * BM) * DM; return true;
    }
    __device__ __forceinline__ unsigned arow(const Unit& u, int r) const { return (unsigned)lrow[u.ord * BM + r]; }
    __device__ __forceinline__ void preload(LAS unsigned short* dst) const {
        Unit u;
        for (int i = 0; next(i, u); ++i) if (threadIdx.x < BM) dst[i * BM + threadIdx.x] = (unsigned short)rowmap[u.rowbase + threadIdx.x];
        __syncthreads();
    }
};
struct Moe2Sched {
    const char* W; int G, c;
    __device__ bool next(int i, Unit& u) const {
        const long L = (long)i * G + c; if (L >= NEXP * 128) return false;
        const int e = (int)(L / 128), w = (int)(L % 128), xcd = w % 8, j = w / 8;
        const int mt = xcd * 4 + (j & 3), nt_ = j >> 2, b = mt >> 1;
        u.pm = mt & 1; u.pn = nt_; u.g = b * NEXP + e; u.rowbase = (unsigned)u.g * CAP + (unsigned)u.pm * BM; u.ord = 0;
        u.B = W + ((size_t)e * DM + (size_t)nt_ * BM) * DFF; return true;
    }
    __device__ __forceinline__ unsigned arow(const Unit& u, int r) const { return u.rowbase + (unsigned)r; }
};

typedef const f32x4 (&AccRef)[2][2][4][2];
struct EpiQKVG {
    static constexpr bool PERM = true;
    h16* qkvg; float* codes;
    __device__ __forceinline__ void operator()(AccRef acc, const Unit& u, int wr, int wc, int fr, int fq) const {
        const int row0 = u.pm * BM + wr * 64 + fr;
        if (u.pn < 6) {
#pragma unroll
            for (int ai = 0; ai < 2; ++ai)
#pragma unroll
                for (int m = 0; m < 4; ++m) { h16* rowp = qkvg + (size_t)(row0 + ai * HALF + m * 16) * 1536 + u.pn * BM + wc * 32 + 8 * fq;
#pragma unroll
                    for (int bj = 0; bj < 2; ++bj) { const f32x4 v0 = acc[ai][bj][m][0], v1 = acc[ai][bj][m][1];
                        u32x4 w; w.x = pack_h2(v0[0], v0[1]); w.y = pack_h2(v0[2], v0[3]); w.z = pack_h2(v1[0], v1[1]); w.w = pack_h2(v1[2], v1[3]);
                        *(u32x4*)(rowp + bj * HALF) = w; } }
        } else if (wc == 0) {
#pragma unroll
            for (int ai = 0; ai < 2; ++ai)
#pragma unroll
                for (int m = 0; m < 4; ++m) { float* rowp = codes + (size_t)(row0 + ai * HALF + m * 16) * 32 + 8 * fq;
                    *(f32x4*)(rowp) = acc[ai][0][m][0]; *(f32x4*)(rowp + 4) = acc[ai][0][m][1]; }
        }
    }
};
struct EpiH16 {
    static constexpr bool PERM = true;
    h16* C; int ldc;
    __device__ __forceinline__ void operator()(AccRef acc, const Unit& u, int wr, int wc, int fr, int fq) const {
        const int row0 = u.pm * BM + wr * 64 + fr;
#pragma unroll
        for (int ai = 0; ai < 2; ++ai)
#pragma unroll
            for (int m = 0; m < 4; ++m) { h16* rowp = C + (size_t)(row0 + ai * HALF + m * 16) * ldc + u.pn * BM + wc * 32 + 8 * fq;
#pragma unroll
                for (int bj = 0; bj < 2; ++bj) { const f32x4 v0 = acc[ai][bj][m][0], v1 = acc[ai][bj][m][1];
                    u32x4 w; w.x = pack_h2(v0[0], v0[1]); w.y = pack_h2(v0[2], v0[3]); w.z = pack_h2(v1[0], v1[1]); w.w = pack_h2(v1[2], v1[3]);
                    *(u32x4*)(rowp + bj * HALF) = w; } }
    }
};
struct EpiResid {
    static constexpr bool PERM = true;
    const float* X; h16* R;
    __device__ __forceinline__ void operator()(AccRef acc, const Unit& u, int wr, int wc, int fr, int fq) const {
        const int row0 = u.pm * BM + wr * 64 + fr, col0 = u.pn * BM + wc * 32 + 8 * fq;
#pragma unroll
        for (int ai = 0; ai < 2; ++ai)
#pragma unroll
            for (int m = 0; m < 4; ++m) { const size_t off = (size_t)(row0 + ai * HALF + m * 16) * DM + col0;
#pragma unroll
                for (int bj = 0; bj < 2; ++bj) { const f32x4 x0 = *(const f32x4*)(X + off + bj * HALF), x1 = *(const f32x4*)(X + off + bj * HALF + 4);
                    const f32x4 v0 = x0 + acc[ai][bj][m][0], v1 = x1 + acc[ai][bj][m][1];
                    u32x4 w; w.x = pack_h2(v0[0], v0[1]); w.y = pack_h2(v0[2], v0[3]); w.z = pack_h2(v1[0], v1[1]); w.w = pack_h2(v1[2], v1[3]);
                    *(u32x4*)(R + off + bj * HALF) = w; } }
    }
};
struct EpiHid {
    static constexpr bool PERM = true;
    unsigned char* hid;
    __device__ __forceinline__ void operator()(AccRef acc, const Unit& u, int wr, int wc, int fr, int fq) const {
        const unsigned row0 = u.rowbase + wr * 64 + fr;
#pragma unroll
        for (int ai = 0; ai < 2; ++ai)
#pragma unroll
            for (int m = 0; m < 4; ++m) { unsigned char* rowp = hid + (size_t)(row0 + ai * HALF + m * 16) * DFF + u.pn * HALF + wc * 32 + 8 * fq;
                constexpr float ws_ = 1.0f / (float)(1 << FP8_WSHIFT);
                const f32x4 g0 = acc[ai][0][m][0] * ws_, g1 = acc[ai][0][m][1] * ws_, u0 = acc[ai][1][m][0] * ws_, u1 = acc[ai][1][m][1] * ws_;
                u32x2 w; w.x = pack_fp8x4(siluf_(g0[0]) * u0[0], siluf_(g0[1]) * u0[1], siluf_(g0[2]) * u0[2], siluf_(g0[3]) * u0[3]);
                w.y = pack_fp8x4(siluf_(g1[0]) * u1[0], siluf_(g1[1]) * u1[1], siluf_(g1[2]) * u1[2], siluf_(g1[3]) * u1[3]);
                *(u32x2*)rowp = w; }
    }
};
constexpr float Y_SCALE = 8.0f;
struct EpiDown {
    static constexpr bool PERM = true;
    unsigned char* Y; const float* selgate;
    __device__ __forceinline__ void operator()(AccRef acc, const Unit& u, int wr, int wc, int fr, int fq) const {
        const unsigned row0 = u.rowbase + wr * 64 + fr;
#pragma unroll
        for (int ai = 0; ai < 2; ++ai)
#pragma unroll
            for (int m = 0; m < 4; ++m) { const unsigned sr = row0 + ai * HALF + m * 16; const float gt = selgate[sr] * (Y_SCALE / (float)(1 << FP8_WSHIFT));
                unsigned char* rowp = Y + (size_t)sr * DM + u.pn * BM + wc * 32 + 8 * fq;
#pragma unroll
                for (int bj = 0; bj < 2; ++bj) { const f32x4 v0 = acc[ai][bj][m][0] * gt, v1 = acc[ai][bj][m][1] * gt;
                    u32x2 w; w.x = pack_fp8x4(v0[0], v0[1], v0[2], v0[3]); w.y = pack_fp8x4(v1[0], v1[1], v1[2], v1[3]);
                    *(u32x2*)(rowp + bj * HALF) = w; } }
    }
};
struct EpiPle {
    static constexpr bool PERM = true;
    const h16* H3; const float* rstd3; const float* lnw; const h16* PP; h16* R3H; float* rowsq;
    __device__ __forceinline__ void operator()(AccRef acc, const Unit& u, int wr, int wc, int fr, int fq) const {
        const int row0 = u.pm * BM + wr * 64 + fr, col0 = u.pn * BM + wc * 32 + 8 * fq;
        f32x4 winv[2][2];
#pragma unroll
        for (int bj = 0; bj < 2; ++bj)
#pragma unroll
            for (int n = 0; n < 2; ++n) { const f32x4 wv = *(const f32x4*)(lnw + col0 + bj * HALF + n * 4);
#pragma unroll
                for (int j = 0; j < 4; ++j) winv[bj][n][j] = __builtin_amdgcn_rcpf(wv[j]); }
#pragma unroll
        for (int ai = 0; ai < 2; ++ai)
#pragma unroll
            for (int m = 0; m < 4; ++m) { const int row = row0 + ai * HALF + m * 16; const size_t off = (size_t)row * DM + col0;
                const float inv = __builtin_amdgcn_rcpf(rstd3[row]); float sq = 0.f;
#pragma unroll
                for (int bj = 0; bj < 2; ++bj) { const size_t o2 = off + bj * HALF; const h16x8 hv = *(const h16x8*)(H3 + o2), pv = *(const h16x8*)(PP + o2);
                    float o[8];
#pragma unroll
                    for (int n = 0; n < 2; ++n)
#pragma unroll
                        for (int j = 0; j < 4; ++j) { const float v = (float)hv[4 * n + j] * inv * winv[bj][n][j] + sigmoidf_(acc[ai][bj][m][n][j]) * (float)pv[4 * n + j]; o[4 * n + j] = v; sq += v * v; }
                    u32x4 w; w.x = pack_h2(o[0], o[1]); w.y = pack_h2(o[2], o[3]); w.z = pack_h2(o[4], o[5]); w.w = pack_h2(o[6], o[7]); *(u32x4*)(R3H + o2) = w; }
                sq += __shfl_xor(sq, 16); sq += __shfl_xor(sq, 32);
                if (fq == 0) unsafeAtomicAdd(rowsq + row, sq); }
    }
};
}

template <class ColPtr>
__device__ __forceinline__ void cvt_transpose(LAS unsigned char* lds, h16* dst, int N, int K, int src_ld, ColPtr cp, int blk, int nblk) {
    const int tid = threadIdx.x, w = tid >> 6, l = tid & 63, nq = tid & 31, kp = tid >> 5;
    const int ktiles = K / 256, ntiles = (N / 128) * ktiles;
    f32x4 va[8], vb[8];
    auto fetch = [&](int t) {
        const int n0 = (t / ktiles) * 128, k0 = (t % ktiles) * 256;
        const float* sp = cp(n0 + (nq >> 3) * 32);
#pragma unroll
        for (int ps = 0; ps < 8; ++ps) {
            const int kk = 2 * (kp + 16 * ps);
            if (sp) { va[ps] = *(const f32x4*)(sp + (size_t)(k0 + kk) * src_ld + ((4 * nq) & 31)); vb[ps] = *(const f32x4*)(sp + (size_t)(k0 + kk + 1) * src_ld + ((4 * nq) & 31)); }
            else { va[ps] = (f32x4){0.f, 0.f, 0.f, 0.f}; vb[ps] = va[ps]; }
        }
    };
    if (blk < ntiles) fetch(blk);
    for (int t = blk; t < ntiles; t += nblk) {
        const int n0 = (t / ktiles) * 128, k0 = (t % ktiles) * 256;
        __syncthreads();
        const int sv = (nq & 15) << 1;
#pragma unroll
        for (int ps = 0; ps < 8; ++ps) { const int d = kp + 16 * ps;
#pragma unroll
            for (int j = 0; j < 4; ++j) *(LAS unsigned*)(lds + (4 * nq + j) * 512 + ((d ^ sv) << 2)) = pack_h2(va[ps][j], vb[ps][j]); }
        if (t + nblk < ntiles) fetch(t + nblk);
        __syncthreads();
#pragma unroll 4
        for (int r = 0; r < 16; ++r) { const int row = w * 16 + r, rv = ((row >> 2) & 15) << 1;
            const u32x2 x = *(const LAS u32x2*)(lds + row * 512 + (((2 * l) ^ rv) << 2));
            *(u32x2*)(dst + (size_t)(n0 + row) * K + k0 + 4 * l) = x; }
    }
}

template <class ColPtr>
__device__ __forceinline__ void cvt_transpose_fp8(LAS unsigned char* lds, unsigned char* dst, int N, int K, int src_ld, float scale, ColPtr cp, int blk, int nblk) {
    const int tid = threadIdx.x, w = tid >> 6, l = tid & 63, nq = tid & 31, kq = tid >> 5;
    const int ktiles = K / 256, ntiles = (N / 128) * ktiles;
    f32x4 v[4][4];
    auto fetch = [&](int t) {
        const int n0 = (t / ktiles) * 128, k0 = (t % ktiles) * 256;
        const float* sp = cp(n0 + (nq >> 3) * 32);
#pragma unroll
        for (int ps = 0; ps < 4; ++ps)
#pragma unroll
            for (int q = 0; q < 4; ++q) v[ps][q] = *(const f32x4*)(sp + (size_t)(k0 + 4 * (kq + 16 * ps) + q) * src_ld + ((4 * nq) & 31));
    };
    if (blk < ntiles) fetch(blk);
    for (int t = blk; t < ntiles; t += nblk) {
        const int n0 = (t / ktiles) * 128, k0 = (t % ktiles) * 256;
        __syncthreads();
        const int sv = (nq & 15) << 1;
#pragma unroll
        for (int ps = 0; ps < 4; ++ps) { const int d = kq + 16 * ps;
#pragma unroll
            for (int j = 0; j < 4; ++j) *(LAS unsigned*)(lds + (4 * nq + j) * 256 + ((d ^ sv) << 2)) = pack_fp8x4(v[ps][0][j] * scale, v[ps][1][j] * scale, v[ps][2][j] * scale, v[ps][3][j] * scale); }
        if (t + nblk < ntiles) fetch(t + nblk);
        __syncthreads();
#pragma unroll 4
        for (int r = 0; r < 16; ++r) { const int row = w * 16 + r, rv = ((row >> 2) & 15) << 1;
            const unsigned x = *(const LAS unsigned*)(lds + row * 256 + ((l ^ rv) << 2));
            *(unsigned*)(dst + (size_t)(n0 + row) * K + k0 + 4 * l) = x; }
    }
}

__device__ __forceinline__ void prep_fp8_weights(const Args& a, LAS unsigned char* lds, int blk, int nblk) {
    unsigned char* ws = a.ws;
    const int tid = threadIdx.x, w = tid >> 6, l = tid & 63, nq = tid & 31, kq = tid >> 5;
    constexpr int NT = 2048 + 1024;
    const float scale = (float)(1 << FP8_WSHIFT);
    struct Tile { const float* sp; int src_ld; unsigned char* dst; int K; };
    auto decode = [&](int gt) -> Tile {
        Tile t;
        if (gt < 2048) { const int e = gt >> 7, r = gt & 127, n0 = (r >> 2) * 128, k0 = (r & 3) * 256, nb = n0 + (nq >> 3) * 32;
            const int tile = nb >> 8, within = nb & 255, f = tile * 128 + (within & 127);
            t.sp = ((within >> 7) ? a.in[I_WUP] : a.in[I_WGATE]) + (size_t)e * DM * DFF + f + (size_t)k0 * DFF; t.src_ld = DFF; t.K = DM;
            t.dst = ws + OFF_WGU + (size_t)e * 2 * DFF * DM + (size_t)n0 * DM + k0; }
        else { const int g2 = gt - 2048, e = g2 >> 6, r = g2 & 63, n0 = (r >> 3) * 128, k0 = (r & 7) * 256, nb = n0 + (nq >> 3) * 32;
            t.sp = a.in[I_WDOWN] + (size_t)e * DFF * DM + nb + (size_t)k0 * DM; t.src_ld = DM; t.K = DFF;
            t.dst = ws + OFF_WD + (size_t)e * DM * DFF + (size_t)n0 * DFF + k0; }
        return t;
    };
    f32x4 v[4][4];
    auto fetch = [&](const Tile& t) {
#pragma unroll
        for (int ps = 0; ps < 4; ++ps)
#pragma unroll
            for (int q = 0; q < 4; ++q) v[ps][q] = *(const f32x4*)(t.sp + (size_t)(4 * (kq + 16 * ps) + q) * t.src_ld + ((4 * nq) & 31));
    };
    Tile cur;
    if (blk < NT) { cur = decode(blk); fetch(cur); }
    for (int gt = blk; gt < NT; gt += nblk) {
        __syncthreads();
        const int sv = (nq & 15) << 1;
#pragma unroll
        for (int ps = 0; ps < 4; ++ps) { const int d = kq + 16 * ps;
#pragma unroll
            for (int j = 0; j < 4; ++j) *(LAS unsigned*)(lds + (4 * nq + j) * 256 + ((d ^ sv) << 2)) = pack_fp8x4(v[ps][0][j] * scale, v[ps][1][j] * scale, v[ps][2][j] * scale, v[ps][3][j] * scale); }
        unsigned char* dst = cur.dst; const int K = cur.K;
        if (gt + nblk < NT) { cur = decode(gt + nblk); fetch(cur); }
        __syncthreads();
#pragma unroll 4
        for (int r = 0; r < 16; ++r) { const int row = w * 16 + r, rv = ((row >> 2) & 15) << 1;
            const unsigned x = *(const LAS unsigned*)(lds + row * 256 + ((l ^ rv) << 2));
            *(unsigned*)(dst + (size_t)row * K + 4 * l) = x; }
    }
}

__device__ __forceinline__ void phase_prep(const Args& a, LAS unsigned char* lds, int blk, int nblk) {
    unsigned char* ws = a.ws;
    const int tid = threadIdx.x;
    if (blk == 0) { if (tid < 64) ((unsigned*)(ws + OFF_CTR))[tid] = 0u;
        for (int i = tid; i < 3456; i += NTHREADS) ((unsigned*)(ws + OFF_XBAR))[i] = 0u; }
    auto rot = [&](int off) { return (blk - off + 4 * nblk) % nblk; };
    { const float* w = a.in[I_WIN]; cvt_transpose(lds, (h16*)(ws + OFF_WINA), NA1, DM, INCOLS, [=](int n0) { return n0 < 1568 ? w + n0 : (const float*)nullptr; }, rot(0), nblk); }
    { const float* w = a.in[I_WIN]; cvt_transpose(lds, (h16*)(ws + OFF_WINHY), HYC, DM, INCOLS, [=](int n0) { return w + 1568 + n0; }, rot(56), nblk); }
    { const float* w = a.in[I_WOUT]; cvt_transpose(lds, (h16*)(ws + OFF_WOUT), DM, DM, DM, [=](int n0) { return w + n0; }, rot(104), nblk); }
    { const float* w = a.in[I_WPG]; cvt_transpose(lds, (h16*)(ws + OFF_WG), DM, DM, DM, [=](int n0) { return w + n0; }, rot(136), nblk); }
    { const float* w = a.in[I_WPP]; cvt_transpose(lds, (h16*)(ws + OFF_WP), DM, 256, DM, [=](int n0) { return w + n0; }, rot(168), nblk); }
    prep_fp8_weights(a, lds, blk, nblk);
    { const f32x4* p = (const f32x4*)a.in[I_P]; u32x2* d = (u32x2*)(ws + OFF_P16); const size_t n4 = (size_t)NTOK * 256 / 4;
        for (size_t i = (size_t)blk * NTHREADS + tid; i < n4; i += (size_t)nblk * NTHREADS) { const f32x4 v = p[i]; u32x2 o; o.x = pack_h2(v[0], v[1]); o.y = pack_h2(v[2], v[3]); d[i] = o; } }
}

__device__ __forceinline__ void phase_rmsnorm_h16(const float* X, const float* w, h16* H, int blk, int nblk) {
    constexpr int RP = 4;
    const int lane = threadIdx.x & 63, gw = blk * 8 + (threadIdx.x >> 6), nw = nblk * 8;
    f32x4 wv[4];
#pragma unroll
    for (int j = 0; j < 4; ++j) wv[j] = *(const f32x4*)(w + j * 256 + lane * 4);
    for (int row0 = gw * RP; row0 < NTOK; row0 += nw * RP) {
        f32x4 v[RP][4];
#pragma unroll
        for (int r = 0; r < RP; ++r)
#pragma unroll
            for (int j = 0; j < 4; ++j) v[r][j] = *(const f32x4*)(X + (size_t)(row0 + r) * DM + j * 256 + lane * 4);
#pragma unroll
        for (int r = 0; r < RP; ++r) {
            float ss = 0.f;
#pragma unroll
            for (int j = 0; j < 4; ++j) ss += v[r][j][0] * v[r][j][0] + v[r][j][1] * v[r][j][1] + v[r][j][2] * v[r][j][2] + v[r][j][3] * v[r][j][3];
            ss = wave_sum(ss);
            const float rstd = rsqrtf(ss * (1.0f / DM) + EPS);
            h16* hp = H + (size_t)(row0 + r) * DM;
#pragma unroll
            for (int j = 0; j < 4; ++j) { u32x2 o; o.x = pack_h2(v[r][j][0] * rstd * wv[j][0], v[r][j][1] * rstd * wv[j][1]); o.y = pack_h2(v[r][j][2] * rstd * wv[j][2], v[r][j][3] * rstd * wv[j][3]);
                *(u32x2*)(hp + j * 256 + lane * 4) = o; }
        }
    }
}

__device__ __forceinline__ void phase_combine_norm(const h16* R, const unsigned char* Y, const int* slotmap, const float* w, h16* H, float* rstd3, float* rowsq, int blk, int nblk) {
    constexpr int RP = 2;
    const int lane = threadIdx.x & 63, gw = blk * 8 + (threadIdx.x >> 6), nw = nblk * 8;
    f32x4 wv[4];
#pragma unroll
    for (int j = 0; j < 4; ++j) wv[j] = *(const f32x4*)(w + j * 256 + lane * 4);
    for (int row0 = gw * RP; row0 < NTOK; row0 += nw * RP) {
        f32x4 v[RP][4]; int myslot[RP];
#pragma unroll
        for (int r = 0; r < RP; ++r) {
            myslot[r] = (lane < NEXP) ? slotmap[(size_t)(row0 + r) * NEXP + lane] : -1;
#pragma unroll
            for (int j = 0; j < 4; ++j) { const h16x4 hv = *(const h16x4*)(R + (size_t)(row0 + r) * DM + j * 256 + lane * 4); v[r][j] = (f32x4){(float)hv[0], (float)hv[1], (float)hv[2], (float)hv[3]}; }
        }
#pragma unroll
        for (int r = 0; r < RP; ++r) {
            unsigned long long mask = __ballot(myslot[r] >= 0);
            const int b = (row0 + r) / SEQ;
            while (mask) {
                const int e = __builtin_ctzll(mask); mask &= mask - 1;
                const int sl = __shfl(myslot[r], e);
                const unsigned char* yp = Y + ((size_t)(b * NEXP + e) * CAP + sl) * DM;
                unsigned y4[4];
#pragma unroll
                for (int j = 0; j < 4; ++j) y4[j] = *(const unsigned*)(yp + j * 256 + lane * 4);
#pragma unroll
                for (int j = 0; j < 4; ++j) { const f32x2 lo = __builtin_amdgcn_cvt_pk_f32_fp8((int)y4[j], false), hi = __builtin_amdgcn_cvt_pk_f32_fp8((int)y4[j], true);
                    v[r][j][0] += lo[0] * (1.0f / g8::Y_SCALE); v[r][j][1] += lo[1] * (1.0f / g8::Y_SCALE); v[r][j][2] += hi[0] * (1.0f / g8::Y_SCALE); v[r][j][3] += hi[1] * (1.0f / g8::Y_SCALE); }
            }
        }
#pragma unroll
        for (int r = 0; r < RP; ++r) {
            float ss = 0.f;
#pragma unroll
            for (int j = 0; j < 4; ++j) { ss += v[r][j][0] * v[r][j][0] + v[r][j][1] * v[r][j][1] + v[r][j][2] * v[r][j][2] + v[r][j][3] * v[r][j][3]; }
            ss = wave_sum(ss);
            const float rstd = rsqrtf(ss * (1.0f / DM) + EPS);
            if (lane == 0) { rstd3[row0 + r] = rstd; rowsq[row0 + r] = 0.f; }
            h16* hp = H + (size_t)(row0 + r) * DM;
#pragma unroll
            for (int j = 0; j < 4; ++j) { u32x2 o; o.x = pack_h2(v[r][j][0] * rstd * wv[j][0], v[r][j][1] * rstd * wv[j][1]); o.y = pack_h2(v[r][j][2] * rstd * wv[j][2], v[r][j][3] * rstd * wv[j][3]);
                *(u32x2*)(hp + j * 256 + lane * 4) = o; }
        }
    }
}

__device__ __forceinline__ void phase_final_norm(const h16* R3H, const float* rowsq, const float* w, float* out, int blk, int nblk) {
    constexpr int RP = 4;
    const int lane = threadIdx.x & 63, gw = blk * 8 + (threadIdx.x >> 6), nw = nblk * 8;
    f32x4 wv[4];
#pragma unroll
    for (int j = 0; j < 4; ++j) wv[j] = *(const f32x4*)(w + j * 256 + lane * 4);
    for (int row0 = gw * RP; row0 < NTOK; row0 += nw * RP) {
        h16x4 v[RP][4]; float sq[RP];
#pragma unroll
        for (int r = 0; r < RP; ++r) { sq[r] = rowsq[row0 + r];
#pragma unroll
            for (int j = 0; j < 4; ++j) v[r][j] = *(const h16x4*)(R3H + (size_t)(row0 + r) * DM + j * 256 + lane * 4); }
#pragma unroll
        for (int r = 0; r < RP; ++r) {
            const float rstd = rsqrtf(sq[r] * (1.0f / DM) + EPS);
#pragma unroll
            for (int j = 0; j < 4; ++j) { f32x4 o;
#pragma unroll
                for (int q = 0; q < 4; ++q) o[q] = (float)v[r][j][q] * rstd * wv[j][q];
                *(f32x4*)(out + (size_t)(row0 + r) * DM + j * 256 + lane * 4) = o; }
        }
    }
}

__device__ __forceinline__ void phase_router(const h16* R, const float* w, const float* wrouter, unsigned char* H8, float* probs, LAS unsigned char* lds, int blk, int nblk) {
    constexpr int WROW = 2064;
    LAS unsigned char* whi = lds; LAS unsigned char* wlo = lds + 16 * WROW; LAS float* lnw = (LAS float*)(lds + 32 * WROW);
    const int tid = threadIdx.x, lane = tid & 63, m16 = lane & 15, kg = lane >> 4, gw = blk * 8 + (tid >> 6), nw = nblk * 8;
    __syncthreads();
    { float tw[32], tn[32];
#pragma unroll
        for (int q = 0; q < 32; ++q) { const int i = tid + NTHREADS * q, k = i >> 4; tw[q] = wrouter[i]; tn[q] = w[k]; }
#pragma unroll
        for (int q = 0; q < 32; ++q) { const int i = tid + NTHREADS * q, k = i >> 4, e = i & 15; const float v = tw[q] * tn[q]; const h16 hi = (h16)v; const h16 lo = (h16)(v - (float)hi);
            *(LAS h16*)(whi + e * WROW + k * 2) = hi; *(LAS h16*)(wlo + e * WROW + k * 2) = lo; }
        for (int k = tid; k < DM; k += NTHREADS) lnw[k] = w[k]; }
    __syncthreads();
    for (int tile = gw; tile < NTOK / 16; tile += nw) {
        const int row = tile * 16 + m16;
        const h16* xp = R + (size_t)row * DM + 8 * kg;
        h16x8 A[32];
#pragma unroll
        for (int ks = 0; ks < 32; ++ks) A[ks] = *(const h16x8*)(xp + 32 * ks);
        float ss = 0.f;
#pragma unroll
        for (int ks = 0; ks < 32; ++ks)
#pragma unroll
            for (int q = 0; q < 4; ++q) { const h16x2 p2 = {A[ks][2 * q], A[ks][2 * q + 1]}; ss = __builtin_amdgcn_fdot2(p2, p2, ss, false); }
        ss += __shfl_xor(ss, 16); ss += __shfl_xor(ss, 32);
        const float rstd = rsqrtf(ss * (1.0f / DM) + EPS);
        f32x4 lg = (f32x4){0.f, 0.f, 0.f, 0.f};
#pragma unroll
        for (int ks = 0; ks < 32; ++ks) {
            const h16x8 bh = *(const LAS h16x8*)(whi + m16 * WROW + (32 * ks + 8 * kg) * 2), bl = *(const LAS h16x8*)(wlo + m16 * WROW + (32 * ks + 8 * kg) * 2);
            lg = __builtin_amdgcn_mfma_f32_16x16x32_f16(A[ks], bh, lg, 0, 0, 0);
            lg = __builtin_amdgcn_mfma_f32_16x16x32_f16(A[ks], bl, lg, 0, 0, 0);
            if ((ks & 3) == 3) asm volatile("" ::: "memory");
        }
#pragma unroll
        for (int r = 0; r < 4; ++r) {
            const float l1 = lg[r] * __shfl(rstd, 4 * kg + r);
            float mx = l1;
#pragma unroll
            for (int o = 1; o <= 8; o <<= 1) mx = fmaxf(mx, __shfl_xor(mx, o));
            const float ex = expf(l1 - mx); float den = ex;
#pragma unroll
            for (int o = 1; o <= 8; o <<= 1) den += __shfl_xor(den, o);
            const int rr = tile * 16 + 4 * kg + r, b = rr / SEQ, t = rr % SEQ;
            probs[((size_t)b * NEXP + m16) * SEQ + t] = ex * __builtin_amdgcn_rcpf(den);
        }
        unsigned char* hp = H8 + (size_t)row * DM + 8 * kg;
#pragma unroll
        for (int ks = 0; ks < 32; ++ks) {
            const f32x4 w0 = *(const LAS f32x4*)(lnw + 32 * ks + 8 * kg), w1 = *(const LAS f32x4*)(lnw + 32 * ks + 8 * kg + 4);
            u32x2 o;
            o.x = pack_fp8x4((float)A[ks][0] * rstd * w0[0], (float)A[ks][1] * rstd * w0[1], (float)A[ks][2] * rstd * w0[2], (float)A[ks][3] * rstd * w0[3]);
            o.y = pack_fp8x4((float)A[ks][4] * rstd * w1[0], (float)A[ks][5] * rstd * w1[1], (float)A[ks][6] * rstd * w1[2], (float)A[ks][7] * rstd * w1[3]);
            *(u32x2*)(hp + 32 * ks) = o;
            if ((ks & 3) == 3) asm volatile("" ::: "memory");
        }
    }
}

__device__ __forceinline__ void phase_topk(const float* probs, int* selidx, float* selgate, int* slotmap, LAS unsigned char* lds, int blk, int nblk) {
    LAS int* hist = (LAS int*)lds;
    LAS int* red = hist + 256;
    const int tid = threadIdx.x, lane = tid & 63, wid = tid >> 6;
    for (int g = blk; g < NB * NEXP; g += nblk) {
        const float* pp = probs + (size_t)g * SEQ;
        unsigned key[8]; float pv[8];
        { const f32x4 a = *(const f32x4*)(pp + tid * 8), b = *(const f32x4*)(pp + tid * 8 + 4);
#pragma unroll
          for (int j = 0; j < 4; ++j) { pv[j] = a[j]; pv[4 + j] = b[j]; }
#pragma unroll
          for (int j = 0; j < 8; ++j) key[j] = __float_as_uint(pv[j]); }
        unsigned prefix = 0; int krem = CAP;
#pragma unroll 1
        for (int ps = 0; ps < 4; ++ps) {
            const int shift = ps == 0 ? 23 : ps == 1 ? 15 : ps == 2 ? 7 : 0, bits = ps == 3 ? 7 : 8;
            const unsigned mhi = ~((1u << (shift + bits)) - 1u), dmask = (1u << bits) - 1u;
            __syncthreads();
            if (tid < 256) hist[tid] = 0;
            __syncthreads();
#pragma unroll
            for (int j = 0; j < 8; ++j) if ((key[j] & mhi) == (prefix & mhi)) __hip_atomic_fetch_add(hist + ((key[j] >> shift) & dmask), 1, __ATOMIC_RELAXED, __HIP_MEMORY_SCOPE_WORKGROUP);
            __syncthreads();
            if (wid == 0) {
                int c[4], tot = 0;
#pragma unroll
                for (int q = 0; q < 4; ++q) { c[q] = hist[4 * lane + q]; tot += c[q]; }
                int S = tot;
#pragma unroll
                for (int o = 1; o < 64; o <<= 1) { const int t = __shfl_down(S, o); if (lane + o < 64) S += t; }
                const int above = S - tot;
                if (above < krem && krem <= S) {
                    int acc = above, dsel = 4 * lane, kn = krem; bool done = false;
#pragma unroll
                    for (int q = 3; q >= 0; --q) { if (!done && acc + c[q] >= krem) { dsel = 4 * lane + q; kn = krem - acc; done = true; } if (!done) acc += c[q]; }
                    red[0] = dsel; red[1] = kn;
                }
            }
            __syncthreads();
            prefix |= (unsigned)red[0] << shift; krem = red[1];
        }
        int cgt = 0, ceq = 0;
#pragma unroll
        for (int j = 0; j < 8; ++j) { cgt += (key[j] > prefix) ? 1 : 0; ceq += (key[j] == prefix) ? 1 : 0; }
        int sg = cgt, se = ceq;
#pragma unroll
        for (int o = 1; o < 64; o <<= 1) { const int a = __shfl_up(sg, o), b = __shfl_up(se, o); if (lane >= o) { sg += a; se += b; } }
        __syncthreads();
        if (lane == 63) { red[32 + wid] = sg; red[48 + wid] = se; }
        __syncthreads();
        int bg = 0, be = 0;
#pragma unroll
        for (int w = 0; w < 8; ++w) { const int x = red[32 + w], y = red[48 + w]; if (w < wid) { bg += x; be += y; } }
        int pg = bg + sg - cgt, pe = be + se - ceq;
        const int need = krem;
#pragma unroll
        for (int j = 0; j < 8; ++j) {
            const bool gt = key[j] > prefix, eq = key[j] == prefix;
            const bool take = gt || (eq && pe < need);
            const int slot = pg + (pe < need ? pe : need);
            if (take) { selidx[(size_t)g * CAP + slot] = (g / NEXP) * SEQ + tid * 8 + j; selgate[(size_t)g * CAP + slot] = pv[j]; }
            slotmap[((size_t)(g / NEXP) * SEQ + tid * 8 + j) * NEXP + (g % NEXP)] = take ? slot : -1;
            pg += gt ? 1 : 0; pe += eq ? 1 : 0;
        }
    }
}

struct __attribute__((packed, aligned(2))) H8U { h16 v[8]; };
__device__ __forceinline__ void phase_filters(const Args& a, h16* GR, LAS unsigned char* lds, int blk, int nblk) {
    constexpr int NP = 16;
    LAS float* z = (LAS float*)lds;
    LAS float* h1 = z + NP * 32;
    LAS float* h2 = h1 + NP * 64;
    const int tid = threadIdx.x;
    const float* w1 = a.in[I_FW1]; const float* b1 = a.in[I_FB1]; const float* fr1 = a.in[I_FFR1];
    const float* w2 = a.in[I_FW2]; const float* b2 = a.in[I_FB2]; const float* fr2 = a.in[I_FFR2];
    const float* w3 = a.in[I_FW3]; const float* hb = a.in[I_HBIAS];
    const float MIND = logf(1e-2f) / 1.5f, MAXD = logf(1e-2f) / 0.3f;
    for (int it = blk; it < SEQ / NP; it += nblk) {
        const int t0 = it * NP;
        __syncthreads();
        if (tid < NP * 17) { const int pos = tid / 17, i = tid % 17, t = t0 + pos; float v;
            if (i == 0) v = (float)t / (float)(SEQ - 1);
            else { const int bi = (i - 1) & 7; const float f = 1e-4f + (float)bi * ((7.0f - 1e-4f) / 7.0f); const float wp = 6.283185307179586f * (float)t / (float)SEQ; const float ang = f * wp;
                float sn, cs; sincos_f(ang, sn, cs); v = (i <= 8) ? cs : -sn; }
            z[pos * 32 + i] = v; }
        __syncthreads();
#pragma unroll
        for (int hf = 0; hf < NP / 8; ++hf) { const int pos = hf * 8 + (tid >> 6), j = tid & 63; float s = b1[j];
#pragma unroll
            for (int i = 0; i < 17; ++i) s += z[pos * 32 + i] * w1[i * 64 + j];
            h1[pos * 64 + j] = sin_f(fr1[j] * s); }
        __syncthreads();
#pragma unroll
        for (int hf = 0; hf < NP / 8; ++hf) { const int pos = hf * 8 + (tid >> 6), j = tid & 63; float s = b2[j];
#pragma unroll 16
            for (int i = 0; i < 64; ++i) s += h1[pos * 64 + i] * w2[i * 64 + j];
            h2[j * NP + pos] = sin_f(fr2[j] * s); }
        __syncthreads();
        {
            const int w = tid >> 6, l = tid & 63, n16 = l & 15, kg = l >> 4;
            h16x8 Af[2];
#pragma unroll
            for (int ks = 0; ks < 2; ++ks)
#pragma unroll
                for (int jj = 0; jj < 8; ++jj) Af[ks][jj] = (h16)h2[(32 * ks + 8 * kg + jj) * NP + n16];
#pragma unroll 2
            for (int ti = 0; ti < 16; ++ti) {
                const int col = (w * 16 + ti) * 16 + n16;
                float wv[2][8];
#pragma unroll
                for (int ks = 0; ks < 2; ++ks)
#pragma unroll
                    for (int jj = 0; jj < 8; ++jj) wv[ks][jj] = w3[(32 * ks + 8 * kg + jj) * 2048 + col];
                f32x4 acc = (f32x4){0.f, 0.f, 0.f, 0.f};
#pragma unroll
                for (int ks = 0; ks < 2; ++ks) { h16x8 Bf;
#pragma unroll
                    for (int jj = 0; jj < 8; ++jj) Bf[jj] = (h16)wv[ks][jj];
                    acc = __builtin_amdgcn_mfma_f32_16x16x32_f16(Af[ks], Bf, acc, 0, 0, 0); }
                const int o = col >> 10, dir = (col >> 9) & 1, c = col & 511;
                const float delta = fabsf(MIND + (float)c * ((MAXD - MIND) / 511.0f));
                h16* gp = GR + ((size_t)o * HYW + c) * 8192;
                h16 hv[4];
#pragma unroll
                for (int r = 0; r < 4; ++r) { const int t = t0 + 4 * kg + r; const float tl = (float)t * (1.0f / (float)(SEQ - 1)); float v = acc[r] * __expf(-tl * delta);
                    if (dir == 0 && t == 0) v += hb[o * HYW + c];
                    hv[r] = (h16)(v * HY_SCALE); }
                if (dir == 0) { h16x4 st; st[0] = hv[3]; st[1] = hv[2]; st[2] = hv[1]; st[3] = hv[0]; *(h16x4*)(gp + 4092 - t0 - 4 * kg) = st; }
                else {
#pragma unroll
                    for (int r = 0; r < 4; ++r) { const int t = t0 + 4 * kg + r; if (t >= 1) gp[4095 + t] = hv[r]; else gp[8191] = (h16)0.f; }
                }
            }
        }
    }
}

constexpr int HY_ROW = 8192, HY_UIMG = 16 * HY_ROW, HY_RING = 24;
__device__ __forceinline__ int hy_uoff(int b, int s) { return b * HY_ROW + ((((s >> 3) ^ b) << 4) | ((s & 7) << 1)); }
#define HY_MFMA(acc_, a_, b_) asm volatile("v_mfma_f32_16x16x32_f16 %0, %1, %2, %0" : "+v"(acc_) : "v"(a_), "v"(b_))
__device__ __forceinline__ void phase_hyena(const h16* __restrict__ hy, h16* __restrict__ z2, const h16* __restrict__ gr, const float* __restrict__ cw, const float* __restrict__ cb, unsigned* __restrict__ queue0, LAS unsigned char* lds, int reps) {
    const int tid = threadIdx.x, w = __builtin_amdgcn_readfirstlane(tid >> 6), l = tid & 63, bcol = l & 15, kg = l >> 4;
    LAS unsigned char* uimg = lds; LAS unsigned char* ring = lds + HY_UIMG;
    LAS int* qslot = (LAS int*)(lds + HY_UIMG + HY_RING * 1024);
    const int lbase = 4095 - (l & 15) + 8 * (l >> 4);
#pragma unroll 1
    for (int rep = 0; rep < reps; ++rep) {
    unsigned* queue = queue0 + rep;
    for (;;) {
        __syncthreads();
        if (tid == 0) *qslot = (int)atomicAdd(queue, 1u);
        __syncthreads();
        const int c = *qslot;
        if (c >= HYW) break;
        { const float w0 = cw[c], w1 = cw[HYC + c], w2 = cw[2 * HYC + c], bb = cb[c]; const int t0 = tid * 8;
#pragma unroll 8
            for (int b = 0; b < NB; ++b) {
                const h16* src = hy + (size_t)c * NTOK + (size_t)b * SEQ;
                const h16x8 rv = *(const h16x8*)(src + t0);
                const float rm = (t0 > 0) ? (float)src[t0 - 1] : 0.f, rp = (t0 + 8 < SEQ) ? (float)src[t0 + 8] : 0.f;
                float r[10]; r[0] = rm; r[9] = rp;
#pragma unroll
                for (int j = 0; j < 8; ++j) r[1 + j] = (float)rv[j];
                h16x8 o;
#pragma unroll
                for (int j = 0; j < 8; ++j) o[j] = (h16)(bb + w0 * r[j] + w1 * r[j + 1] + w2 * r[j + 2]);
                *(LAS h16x8*)(uimg + b * HY_ROW + ((tid ^ b) << 4)) = o;
            } }
#pragma unroll 1
        for (int o = 0; o < 2; ++o) {
            const h16* grp = gr + ((size_t)o * HYW + c) * 8192;
            f32x4 acc[8][4];
#pragma unroll
            for (int i = 0; i < 8; ++i)
#pragma unroll
                for (int m = 0; m < 4; ++m) acc[i][m] = (f32x4){0.f, 0.f, 0.f, 0.f};
            { const int phi = -256 + w; if (phi >= -254) { const H8U v0 = *(const H8U*)(grp + lbase - 16 * phi); *(LAS h16x8*)(ring + ((phi + 264) % HY_RING) * 1024 + l * 16) = __builtin_bit_cast(h16x8, v0); } }
            h16x8 fragA = __builtin_bit_cast(h16x8, *(const H8U*)(grp + lbase - 16 * (-248 + w))), fragB = {};
            __syncthreads();
#define HY_STEP(st_, fcur_, fnext_) do { \
                const int d0 = -64 + 2 * (st_); \
                if ((st_) < 62) fnext_ = __builtin_bit_cast(h16x8, *(const H8U*)(grp + lbase - 16 * (4 * (d0 + 4) + w))); \
                const int sbase = (4 * d0 - 2 + 264) % HY_RING; \
                _Pragma("unroll") for (int dd = 0; dd < 2; ++dd) { \
                    const int delta = d0 + dd; \
                    if (delta >= -63) { \
                        h16x8 A6[6]; \
                        _Pragma("unroll") for (int q = 0; q < 6; ++q) { int sl = sbase + 4 * dd + q; sl = sl >= HY_RING ? sl - HY_RING : sl; A6[q] = *(const LAS h16x8*)(ring + sl * 1024 + l * 16); } \
                        _Pragma("unroll") for (int i = 0; i < 8; ++i) { \
                            const int s1 = w + 8 * i - delta; \
                            if ((unsigned)s1 < 64u) { \
                                const int ch = 8 * s1 + kg; \
                                const h16x8 B0 = *(const LAS h16x8*)(uimg + bcol * HY_ROW + ((ch ^ bcol) << 4)), B1 = *(const LAS h16x8*)(uimg + bcol * HY_ROW + (((ch + 4) ^ bcol) << 4)); \
                                __builtin_amdgcn_s_setprio(1); \
                                _Pragma("unroll") for (int m = 0; m < 4; ++m) { HY_MFMA(acc[i][m], A6[m + 2], B0); HY_MFMA(acc[i][m], A6[m], B1); } \
                                __builtin_amdgcn_s_setprio(0); \
                            } } } } \
                if ((st_) < 63) *(LAS h16x8*)(ring + ((4 * (d0 + 2) + w + 264) % HY_RING) * 1024 + l * 16) = fcur_; \
                asm volatile("s_waitcnt lgkmcnt(0)" ::: "memory"); __builtin_amdgcn_s_barrier(); asm volatile("" ::: "memory"); \
            } while (0)
#pragma unroll 1
            for (int st = 0; st < 64; st += 2) { HY_STEP(st, fragA, fragB); HY_STEP(st + 1, fragB, fragA); }
#undef HY_STEP
            asm volatile("s_nop 15\n\ts_nop 15" ::: "memory");
            const int ch = (o + 1) * HYW + c;
            const float w0 = cw[ch], w1 = cw[HYC + ch], w2 = cw[2 * HYC + ch], bb = cb[ch];
            int kg_e = kg, bcol_e = bcol; asm volatile("" : "+v"(kg_e), "+v"(bcol_e));
            const h16* xsrc = hy + (size_t)ch * NTOK + (size_t)bcol_e * SEQ;
#pragma unroll
            for (int ih = 0; ih < 4; ++ih) {
                h16x4 xv[2][4]; h16 xm[2][4], xp[2][4];
#pragma unroll
                for (int ii = 0; ii < 2; ++ii)
#pragma unroll
                    for (int m = 0; m < 4; ++m) {
                        const int t = 64 * (w + 8 * (2 * ih + ii)) + 16 * m + 4 * kg_e;
                        xv[ii][m] = *(const h16x4*)(xsrc + t);
                        xm[ii][m] = (t > 0) ? xsrc[t - 1] : (h16)0.f; xp[ii][m] = (t + 4 < SEQ) ? xsrc[t + 4] : (h16)0.f;
                    }
#pragma unroll
                for (int ii = 0; ii < 2; ++ii)
#pragma unroll
                    for (int m = 0; m < 4; ++m) {
                        const int i = 2 * ih + ii;
                        const int t = 64 * (w + 8 * i) + 16 * m + 4 * kg_e;
                        float r[6]; r[0] = (float)xm[ii][m]; r[5] = (float)xp[ii][m];
#pragma unroll
                        for (int jj = 0; jj < 4; ++jj) r[1 + jj] = (float)xv[ii][m][jj];
                        h16x4 zo;
#pragma unroll
                        for (int jj = 0; jj < 4; ++jj) zo[jj] = (h16)((bb + w0 * r[jj] + w1 * r[jj + 1] + w2 * r[jj + 2]) * acc[i][m][jj] * (1.0f / HY_SCALE));
                        if (o == 0) *(LAS h16x4*)(uimg + hy_uoff(bcol_e, t)) = zo;
                        else *(h16x4*)(z2 + (size_t)c * NTOK + (size_t)bcol_e * SEQ + t) = zo;
                    }
                asm volatile("" ::: "memory");
            }
        }
    }
}
}

__device__ __forceinline__ float wave_incl_scan(float x) {
#define DPP_ADD(ctrl, rmask, bctl) x += __builtin_bit_cast(float, __builtin_amdgcn_update_dpp(0, __builtin_bit_cast(int, x), ctrl, rmask, 0xf, bctl))
    DPP_ADD(0x111, 0xf, true);
    DPP_ADD(0x112, 0xf, true);
    DPP_ADD(0x114, 0xf, true);
    DPP_ADD(0x118, 0xf, true);
    DPP_ADD(0x142, 0xa, false);
    DPP_ADD(0x143, 0xc, false);
#undef DPP_ADD
    return x;
}

constexpr int GL_QD = 0, GL_KI = 8192, GL_KDT = 16384, GL_P = 24576, GL_VT = 32768, GL_EDL = 49152, GL_WA = 49408, GL_BA = 53504, GL_QS = 54272, GL_KS = 62464, GL_VS = 70656, GL_CS = 87040;
__device__ __forceinline__ int gsw(int row, int col) { return row * 128 + ((((col >> 3) ^ (row & 7)) << 4) | ((col & 7) << 1)); }
#define GLA_BAR() do { asm volatile("s_waitcnt lgkmcnt(0)" ::: "memory"); __builtin_amdgcn_s_barrier(); asm volatile("" ::: "memory"); } while (0)
__device__ __forceinline__ void phase_gla(const h16* __restrict__ qkvg, const float* __restrict__ codes, const float* __restrict__ waf, const float* __restrict__ baf,
                          const float* __restrict__ wab, const float* __restrict__ bab, h16* __restrict__ of, h16* __restrict__ ob, LAS unsigned char* lds, int first, int stride, int reps) {
    const int tid = threadIdx.x, w = __builtin_amdgcn_readfirstlane(tid >> 6), l = tid & 63, m16 = l & 15, kg = l >> 4;
    LAS float* EDL = (LAS float*)(lds + GL_EDL); LAS float* WA = (LAS float*)(lds + GL_WA); LAS float* BA = (LAS float*)(lds + GL_BA);
    for (int item = first; item < NB * 8 * reps; item += stride) {
        const int b = (item >> 3) % NB, h = (item >> 1) & 3, dir = item & 1;
        const float* wa = dir ? wab : waf; const float* ba = dir ? bab : baf; h16* O = dir ? ob : of;
        __syncthreads();
        for (int i = tid; i < 16 * 64; i += NTHREADS) WA[i] = wa[(i >> 6) * 256 + h * 64 + (i & 63)];
        if (tid < 64) BA[tid] = ba[h * 64 + tid];
        f32x4 S[4];
#pragma unroll
        for (int m = 0; m < 4; ++m) S[m] = (f32x4){0.f, 0.f, 0.f, 0.f};
        h16x8 pq, pk, pv0, pv1; f32x4 pc;
#define GLA_ROW(n_, c_) ((size_t)b * SEQ + (dir ? (SEQ - 1 - (64 * (n_) + (c_))) : (64 * (n_) + (c_))))
#define GLA_FETCH(n_) do { const size_t rq_ = GLA_ROW(n_, tid >> 3); pq = *(const h16x8*)(qkvg + rq_ * 1536 + h * 64 + (tid & 7) * 8); pk = *(const h16x8*)(qkvg + rq_ * 1536 + 256 + h * 64 + (tid & 7) * 8); \
            const size_t rv0_ = GLA_ROW(n_, tid >> 4), rv1_ = GLA_ROW(n_, 32 + (tid >> 4)); pv0 = *(const h16x8*)(qkvg + rv0_ * 1536 + 512 + h * 128 + (tid & 15) * 8); pv1 = *(const h16x8*)(qkvg + rv1_ * 1536 + 512 + h * 128 + (tid & 15) * 8); \
            if (tid < 256) pc = *(const f32x4*)(codes + GLA_ROW(n_, tid >> 2) * 32 + dir * 16 + (tid & 3) * 4); } while (0)
#define GLA_PARK() do { { const int t_ = tid >> 3, p_ = tid & 7; *(LAS h16x8*)(lds + GL_QS + t_ * 128 + ((p_ ^ (t_ & 7)) << 4)) = pq; *(LAS h16x8*)(lds + GL_KS + t_ * 128 + ((p_ ^ (t_ & 7)) << 4)) = pk; } \
            { const int t0_ = tid >> 4, t1_ = 32 + (tid >> 4), p_ = tid & 15; *(LAS h16x8*)(lds + GL_VS + t0_ * 256 + ((p_ ^ ((t0_ & 7) << 1)) << 4)) = pv0; *(LAS h16x8*)(lds + GL_VS + t1_ * 256 + ((p_ ^ ((t1_ & 7) << 1)) << 4)) = pv1; } \
            if (tid < 256) *(LAS f32x4*)(lds + GL_CS + (tid >> 2) * 80 + (tid & 3) * 16) = pc; } while (0)
        GLA_FETCH(0);
        GLA_PARK();
        GLA_FETCH(1);
#pragma unroll 1
        for (int n = 0; n < SEQ / 64; ++n) {
            GLA_BAR();
            {
                const h16x8 cq = *(const LAS h16x8*)(lds + GL_QS + l * 128 + ((w ^ (l & 7)) << 4)), ck = *(const LAS h16x8*)(lds + GL_KS + l * 128 + ((w ^ (l & 7)) << 4));
                const h16x8 cv0 = *(const LAS h16x8*)(lds + GL_VS + l * 256 + (((2 * w) ^ ((l & 7) << 1)) << 4)), cv1 = *(const LAS h16x8*)(lds + GL_VS + l * 256 + (((2 * w + 1) ^ ((l & 7) << 1)) << 4));
                f32x4 cc[4];
#pragma unroll
                for (int r = 0; r < 4; ++r) cc[r] = *(const LAS f32x4*)(lds + GL_CS + l * 80 + r * 16);
                float z[8];
                { const f32x4 b0 = *(const LAS f32x4*)(BA + 8 * w), b1 = *(const LAS f32x4*)(BA + 8 * w + 4);
#pragma unroll
                  for (int j = 0; j < 4; ++j) { z[j] = b0[j]; z[4 + j] = b1[j]; } }
#pragma unroll
                for (int r = 0; r < 16; ++r) { const float cr = cc[r >> 2][r & 3]; const f32x4 w0 = *(const LAS f32x4*)(WA + r * 64 + 8 * w), w1 = *(const LAS f32x4*)(WA + r * 64 + 8 * w + 4);
#pragma unroll
                    for (int j = 0; j < 4; ++j) { z[j] += cr * w0[j]; z[4 + j] += cr * w1[j]; } }
                h16x8 qd, ki, kd; float edl[8];
#pragma unroll
                for (int j = 0; j < 8; ++j) {
                    const float ls = fminf(z[j], 0.f) - __logf(1.0f + __expf(-fabsf(z[j])));
                    float bb = ls * (1.0f / 16.0f);
                    bb = wave_incl_scan(bb);
                    const float bl = __builtin_bit_cast(float, __builtin_amdgcn_readlane(__builtin_bit_cast(int, bb), 63));
                    const float E = __expf(bb), Ei = __builtin_amdgcn_rcpf(E), el = __expf(bl);
                    edl[j] = el;
                    qd[j] = (h16)((float)cq[j] * 0.125f * E); const float kiv = (float)ck[j] * Ei; ki[j] = (h16)kiv; kd[j] = (h16)(kiv * el);
                }
                *(LAS h16x8*)(lds + GL_QD + l * 128 + ((w ^ (l & 7)) << 4)) = qd;
                *(LAS h16x8*)(lds + GL_KI + l * 128 + ((w ^ (l & 7)) << 4)) = ki;
#pragma unroll
                for (int j = 0; j < 8; ++j) *(LAS h16*)(lds + GL_KDT + gsw(8 * w + j, l)) = kd[j];
#pragma unroll
                for (int j = 0; j < 8; ++j) { *(LAS h16*)(lds + GL_VT + gsw(16 * w + j, l)) = cv0[j]; *(LAS h16*)(lds + GL_VT + gsw(16 * w + 8 + j, l)) = cv1[j]; }
                if (l == 0) {
#pragma unroll
                    for (int j = 0; j < 8; ++j) EDL[8 * w + j] = edl[j]; }
            }
            GLA_BAR();
            {
                const int mi = w & 3;
                h16x8 Aq[2];
                Aq[0] = *(const LAS h16x8*)(lds + GL_QD + gsw(16 * mi + m16, 8 * kg)); Aq[1] = *(const LAS h16x8*)(lds + GL_QD + gsw(16 * mi + m16, 32 + 8 * kg));
#pragma unroll
                for (int q = 0; q < 2; ++q) {
                    const int nj = 2 * (w >> 2) + q;
                    if (nj <= mi) {
                        const h16x8 B0 = *(const LAS h16x8*)(lds + GL_KI + gsw(16 * nj + m16, 8 * kg)), B1 = *(const LAS h16x8*)(lds + GL_KI + gsw(16 * nj + m16, 32 + 8 * kg));
                        f32x4 p = (f32x4){0.f, 0.f, 0.f, 0.f};
                        p = __builtin_amdgcn_mfma_f32_16x16x32_f16(Aq[0], B0, p, 0, 0, 0);
                        p = __builtin_amdgcn_mfma_f32_16x16x32_f16(Aq[1], B1, p, 0, 0, 0);
#pragma unroll
                        for (int r = 0; r < 4; ++r) { const int c = 16 * mi + 4 * kg + r, cp = 16 * nj + m16; const bool keep = dir ? (cp < c) : (cp <= c);
                            *(LAS h16*)(lds + GL_P + gsw(c, cp)) = (h16)(keep ? p[r] : 0.f); }
                    } else if ((nj >> 1) == (mi >> 1)) {
#pragma unroll
                        for (int r = 0; r < 4; ++r) *(LAS h16*)(lds + GL_P + gsw(16 * mi + 4 * kg + r, 16 * nj + m16)) = (h16)0.f;
                    }
                }
            }
            GLA_BAR();
            {
                h16x8 Bv[2];
                Bv[0] = *(const LAS h16x8*)(lds + GL_VT + gsw(16 * w + m16, 8 * kg)); Bv[1] = *(const LAS h16x8*)(lds + GL_VT + gsw(16 * w + m16, 32 + 8 * kg));
                h16x8 Sf[2];
#pragma unroll
                for (int ks = 0; ks < 2; ++ks)
#pragma unroll
                    for (int j = 0; j < 4; ++j) { Sf[ks][j] = (h16)S[2 * ks][j]; Sf[ks][4 + j] = (h16)S[2 * ks + 1][j]; }
#pragma unroll
                for (int mi = 0; mi < 4; ++mi) {
                    f32x4 o = (f32x4){0.f, 0.f, 0.f, 0.f};
#pragma unroll
                    for (int ks = 0; ks < 2; ++ks) {
                        if (!(ks == 1 && mi < 2)) { const h16x8 Ap = *(const LAS h16x8*)(lds + GL_P + gsw(16 * mi + m16, 32 * ks + 8 * kg)); o = __builtin_amdgcn_mfma_f32_16x16x32_f16(Ap, Bv[ks], o, 0, 0, 0); }
                        const h16x4 a0 = *(const LAS h16x4*)(lds + GL_QD + gsw(16 * mi + m16, 32 * ks + 4 * kg)), a1 = *(const LAS h16x4*)(lds + GL_QD + gsw(16 * mi + m16, 32 * ks + 16 + 4 * kg));
                        h16x8 Aqs;
#pragma unroll
                        for (int j = 0; j < 4; ++j) { Aqs[j] = a0[j]; Aqs[4 + j] = a1[j]; }
                        o = __builtin_amdgcn_mfma_f32_16x16x32_f16(Aqs, Sf[ks], o, 0, 0, 0);
                    }
#pragma unroll
                    for (int r = 0; r < 4; ++r) { const int c = 16 * mi + 4 * kg + r; const int tok = dir ? (SEQ - 1 - (64 * n + c)) : (64 * n + c);
                        O[((size_t)b * SEQ + tok) * 512 + h * 128 + 16 * w + m16] = (h16)o[r]; }
                }
#pragma unroll
                for (int mt = 0; mt < 4; ++mt) {
                    const f32x4 e4 = *(const LAS f32x4*)(EDL + 16 * mt + 4 * kg);
                    S[mt] = S[mt] * e4;
#pragma unroll
                    for (int ks = 0; ks < 2; ++ks) { const h16x8 Ak = *(const LAS h16x8*)(lds + GL_KDT + gsw(16 * mt + m16, 32 * ks + 8 * kg)); S[mt] = __builtin_amdgcn_mfma_f32_16x16x32_f16(Ak, Bv[ks], S[mt], 0, 0, 0); }
                }
            }
            if (n + 1 < SEQ / 64) GLA_PARK();
            if (n + 2 < SEQ / 64) GLA_FETCH(n + 2);
        }
    }
}

__device__ __forceinline__ void phase_mixbuild(const h16* __restrict__ of, const h16* __restrict__ ob, const h16* __restrict__ qkvg, const float* __restrict__ nw, const h16* __restrict__ z2,
                               h16* __restrict__ mix, LAS unsigned char* lds, int blk, int nblk) {
    LAS h16* tileT = (LAS h16*)lds;
    const int tid = threadIdx.x;
    float nwv[8];
#pragma unroll
    for (int j = 0; j < 8; ++j) nwv[j] = nw[(tid & 15) * 8 + j];
    for (int sl = blk; sl < NTOK / 64; sl += nblk) {
        const int tok0 = sl * 64;
        h16x8 zv[8];
#pragma unroll
        for (int i = 0; i < 8; ++i) zv[i] = *(const h16x8*)(z2 + (size_t)tid * NTOK + tok0 + 8 * i);
#pragma unroll 2
        for (int i = 0; i < 8; ++i) {
            const int task = tid + NTHREADS * i, token = task >> 6, head = (task >> 4) & 3, part = task & 15;
            const size_t row = (size_t)tok0 + token;
            const h16x8 a = *(const h16x8*)(of + row * 512 + head * 128 + part * 8), b = *(const h16x8*)(ob + row * 512 + head * 128 + part * 8);
            const h16x8 g = *(const h16x8*)(qkvg + row * 1536 + 1024 + head * 128 + part * 8);
            float o[8], ss = 0.f;
#pragma unroll
            for (int j = 0; j < 8; ++j) { o[j] = (float)a[j] + (float)b[j]; ss += o[j] * o[j]; }
            ss += __shfl_xor(ss, 1); ss += __shfl_xor(ss, 2); ss += __shfl_xor(ss, 4); ss += __shfl_xor(ss, 8);
            const float rstd = rsqrtf(ss * (1.0f / 128.0f) + EPS);
            h16x8 r;
#pragma unroll
            for (int j = 0; j < 8; ++j) r[j] = (h16)(o[j] * rstd * nwv[j] * siluf_((float)g[j]));
            *(h16x8*)(mix + row * DM + head * 128 + part * 8) = r;
        }
        __syncthreads();
#pragma unroll
        for (int i = 0; i < 8; ++i)
#pragma unroll
            for (int j = 0; j < 8; ++j) tileT[(8 * i + j) * 520 + tid] = zv[i][j];
        __syncthreads();
#pragma unroll
        for (int i = 0; i < 8; ++i) { const int idx = tid + NTHREADS * i, token = idx >> 6, c8 = (idx & 63) * 8;
            *(h16x8*)(mix + (size_t)(tok0 + token) * DM + 512 + c8) = *(const LAS h16x8*)(tileT + token * 520 + c8); }
    }
}

#define XB_TMO      128
#define XB_XCNT(j)  (256  + 64 * (j))
#define XB_XSUB(j)  (1280 + 64 * (j))
#define XB_XGEN(j)  (2304 + 64 * (j))
#define XB_TOP      3328
#define XB_TOPGEN   3392
#define XCD_BAR_WORDS 3456
#define XB_SPIN_CAP (1u << 22)
__device__ __forceinline__ unsigned xb_ld(unsigned* p)              { return __hip_atomic_load(p, __ATOMIC_RELAXED, __HIP_MEMORY_SCOPE_AGENT); }
__device__ __forceinline__ unsigned xb_add(unsigned* p, unsigned v) { return __hip_atomic_fetch_add(p, v, __ATOMIC_RELAXED, __HIP_MEMORY_SCOPE_AGENT); }
__device__ __forceinline__ unsigned xb_xcc_id() { return (unsigned)__builtin_amdgcn_s_getreg((3 << 11) | 20) & 0xFu; }
#define XB_SPIN(cond, bar) do { unsigned _sp = 0; while (cond) { __builtin_amdgcn_s_sleep(1); \
    if ((++_sp & 255u) == 0u) { if (xb_ld(&(bar)[XB_TMO])) break; if (_sp > XB_SPIN_CAP) { atomicAdd(&(bar)[XB_TMO], 1u); break; } } } } while (0)
struct XcdBarrier { unsigned* bar; unsigned x; volatile LAS unsigned* st; };
__device__ __forceinline__ void xcd_barrier_post(unsigned* bar) {
    if (threadIdx.x == 0) (void)xb_add(&bar[XB_XCNT(xb_xcc_id())], 1u);
}
__device__ __forceinline__ void xcd_barrier_complete(unsigned* bar, unsigned x, unsigned& nloc, unsigned& nx) {
    const unsigned G = gridDim.x * gridDim.y * gridDim.z;
    unsigned sum, cnt, mine, sp = 0u;
    for (;;) {
        sum = 0u; cnt = 0u; mine = 0u;
#pragma unroll
        for (unsigned j = 0; j < 16; ++j) { const unsigned c = xb_ld(&bar[XB_XCNT(j)]); sum += c; cnt += (c > 0u) ? 1u : 0u; mine = (j == x) ? c : mine; }
        if (sum == G) break;
        __builtin_amdgcn_s_sleep(1);
        if ((++sp & 255u) == 0u) { if (xb_ld(&bar[XB_TMO])) break; if (sp > XB_SPIN_CAP) { atomicAdd(&bar[XB_TMO], 1u); break; } }
    }
    nloc = mine > 0u ? mine : 1u; nx = cnt > 0u ? cnt : 1u;
}
__device__ __forceinline__ void xcd_barrier(unsigned* bar_, volatile LAS unsigned* st_) {
    XcdBarrier b; b.bar = bar_; b.x = xb_xcc_id(); b.st = st_;
    asm volatile("s_waitcnt vmcnt(0)" ::: "memory");
    __syncthreads();
    if (threadIdx.x == 0) {
        unsigned* bar = b.bar;
        __builtin_amdgcn_s_waitcnt(0);
        unsigned nloc = b.st[0], nx = b.st[1];
        if (nloc == 0u) { xcd_barrier_complete(bar, b.x, nloc, nx); b.st[0] = nloc; b.st[1] = nx; }
        const unsigned old = xb_add(&bar[XB_XSUB(b.x)], 1u);
        const unsigned gen = old / nloc;
        if (old + 1u == (gen + 1u) * nloc) {
            __builtin_amdgcn_fence(__ATOMIC_RELEASE, "agent");
            asm volatile("s_waitcnt vmcnt(0)" ::: "memory");
            const unsigned og = xb_add(&bar[XB_TOP], 1u);
            const unsigned tg = og / nx;
            if (og + 1u == (tg + 1u) * nx) xb_add(&bar[XB_TOPGEN], 1u);
            else XB_SPIN(xb_ld(&bar[XB_TOPGEN]) == tg, bar);
            __builtin_amdgcn_fence(__ATOMIC_ACQUIRE, "agent");
            xb_add(&bar[XB_XGEN(b.x)], 1u);
            asm volatile("s_waitcnt vmcnt(0)" ::: "memory");
        } else {
            XB_SPIN(xb_ld(&bar[XB_XGEN(b.x)]) == gen, bar);
            __builtin_amdgcn_fence(__ATOMIC_ACQUIRE, "agent");
            asm volatile("s_waitcnt vmcnt(0)" ::: "memory");
        }
    }
    __syncthreads();
}

enum { PH_PREP = 0, PH_NORM1, PH_FILT, PH_G1A, PH_G1B, PH_GLA, PH_HYENA, PH_GLAMIX, PH_G2, PH_ROUTER, PH_TOPK, PH_MOE1, PH_MOE2, PH_NORM3, PH_G5, PH_G6, PH_FINAL, PH_COUNT };

template <bool COOP>
__global__ __launch_bounds__(NTHREADS, 2) void mega(Args a) {
    extern __shared__ __attribute__((aligned(16))) unsigned char shm[];
    LAS unsigned char* lds = (LAS unsigned char*)shm;
    const int blk = blockIdx.x, nblk = gridDim.x;
    unsigned char* ws = a.ws;
#ifndef PROBE_MASK
#define PROBE_MASK 0u
#endif
#define RUN(P, SYNC, ...) if (a.ph_lo <= (P) && (P) < a.ph_hi) { { __syncthreads(); const float pscale = 1.f; (void)pscale; __VA_ARGS__ } \
        if constexpr (((PROBE_MASK >> (P)) & 1u) != 0u && (P) != PH_GLA && (P) != PH_HYENA) { if (COOP) cg::this_grid().sync(); __syncthreads(); const float pscale = 0.f; (void)pscale; __VA_ARGS__ } \
        if (COOP && (SYNC) != 0 && (P) + 1 < a.ph_hi) { if ((SYNC) == 1) { cg::this_grid().sync(); xcd_barrier_post((unsigned*)(a.ws + OFF_XBAR)); } else xcd_barrier((unsigned*)(a.ws + OFF_XBAR), (volatile LAS unsigned*)(lds + LDS_BYTES - 16)); } }
    if (threadIdx.x < 4) ((volatile LAS unsigned*)(lds + LDS_BYTES - 16))[threadIdx.x] = 0u;
    __syncthreads();
    RUN(PH_PREP, 0, phase_prep(a, lds, blk, nblk);)
    RUN(PH_NORM1, 0, phase_rmsnorm_h16(a.in[I_X], a.in[I_LNMIX], (h16*)(ws + OFF_H), blk, nblk);)
    RUN(PH_FILT, 1, phase_filters(a, (h16*)(ws + OFF_GR), lds, blk, nblk);)
    RUN(PH_G1A, 0, { g8::DenseSched S; S.init(ws + OFF_WINA, NTOK, NA1, DM, nblk, blk); g8::EpiQKVG E{(h16*)(ws + OFF_QKVG), (float*)(ws + OFF_CODES)};
        g8::gemm_phase(lds, (const char*)(ws + OFF_H), DM, S, E); })
    RUN(PH_G1B, 2, { g8::DenseSched S; S.init(ws + OFF_H, HYC, NTOK, DM, nblk, blk); g8::EpiH16 E{(h16*)(ws + OFF_HY), NTOK};
        g8::gemm_phase(lds, (const char*)(ws + OFF_WINHY), DM, S, E); })
    RUN(PH_GLA, 0, { const int ng = nblk >= 2 * NB * 8 ? NB * 8 : nblk;
        if (blk >= nblk - ng) phase_gla((const h16*)(ws + OFF_QKVG), (const float*)(ws + OFF_CODES), a.in[I_WAF], a.in[I_BAF], a.in[I_WAB], a.in[I_BAB], (h16*)(ws + OFF_OF), (h16*)(ws + OFF_OB), lds, blk - (nblk - ng), ng, 1 + (int)((PROBE_MASK >> 5) & 1u)); })
    RUN(PH_HYENA, 2, phase_hyena((const h16*)(ws + OFF_HY), (h16*)(ws + OFF_Z2), (const h16*)(ws + OFF_GR), a.in[I_HCW], a.in[I_HCB], (unsigned*)(ws + OFF_CTR), lds, 1 + (int)((PROBE_MASK >> 6) & 1u));)
    RUN(PH_GLAMIX, 2, phase_mixbuild((const h16*)(ws + OFF_OF), (const h16*)(ws + OFF_OB), (const h16*)(ws + OFF_QKVG), a.in[I_GLANW], (const h16*)(ws + OFF_Z2), (h16*)(ws + OFF_H), lds, blk, nblk);)
    RUN(PH_G2, 2, { g8::DenseSched S; S.init(ws + OFF_WOUT, NTOK, DM, DM, nblk, blk); g8::EpiResid E{a.in[I_X], (h16*)a.out};
        g8::gemm_phase(lds, (const char*)(ws + OFF_H), DM, S, E); })
    RUN(PH_ROUTER, 2, phase_router((const h16*)a.out, a.in[I_LNFFN], a.in[I_WROUTER], ws + OFF_H, (float*)(ws + OFF_PROBS), lds, blk, nblk);)
    RUN(PH_TOPK, 2, phase_topk((const float*)(ws + OFF_PROBS), (int*)(ws + OFF_SELIDX), (float*)(ws + OFF_SELGATE), (int*)(ws + OFF_SLOTMAP), lds, blk, nblk);)
    RUN(PH_MOE1, 2, { LAS unsigned short* lrow = (LAS unsigned short*)(lds + g8::STAGE_BYTES); g8::Moe1Sched S{(const char*)(ws + OFF_WGU), (const int*)(ws + OFF_SELIDX), nblk, blk, lrow}; S.preload(lrow); g8::EpiHid E{ws + OFF_HID};
        g8::gemm_phase<g8::EpiHid, g8::Moe1Sched, true>(lds, (const char*)(ws + OFF_H), DM / 2, S, E); })
    RUN(PH_MOE2, 2, { g8::Moe2Sched S{(const char*)(ws + OFF_WD), nblk, blk}; g8::EpiDown E{ws + OFF_Y, (const float*)(ws + OFF_SELGATE)};
        g8::gemm_phase<g8::EpiDown, g8::Moe2Sched, true>(lds, (const char*)(ws + OFF_HID), DFF / 2, S, E); })
    RUN(PH_NORM3, 0, phase_combine_norm((const h16*)a.out, ws + OFF_Y, (const int*)(ws + OFF_SLOTMAP), a.in[I_LNPLE], (h16*)(ws + OFF_H3), (float*)(ws + OFF_RSTD3), (float*)(ws + OFF_ROWSQ), blk, nblk);)
    RUN(PH_G5, 2, { g8::DenseSched S; S.init(ws + OFF_WP, NTOK, DM, 256, nblk, blk); g8::EpiH16 E{(h16*)(ws + OFF_PP), DM};
        g8::gemm_phase(lds, (const char*)(ws + OFF_P16), 256, S, E); })
    RUN(PH_G6, 2, { g8::DenseSched S; S.init(ws + OFF_WG, NTOK, DM, DM, nblk, blk); g8::EpiPle E{(const h16*)(ws + OFF_H3), (const float*)(ws + OFF_RSTD3), a.in[I_LNPLE], (const h16*)(ws + OFF_PP), (h16*)(ws + OFF_R3H), (float*)(ws + OFF_ROWSQ)};
        g8::gemm_phase(lds, (const char*)(ws + OFF_H3), DM, S, E); })
    RUN(PH_FINAL, 0, phase_final_norm((const h16*)(ws + OFF_R3H), (const float*)(ws + OFF_ROWSQ), a.in[I_FNW], a.out, blk, nblk);)
}

extern "C" void kernel_launch(void* const* d_in, const int* in_sizes, int n_in, void* d_out, int out_size, void* d_ws, size_t ws_size, hipStream_t stream) {
    static int grid = 0;
    if (grid == 0) {
        if (n_in != N_IN || out_size != NTOK * DM || ws_size < WS_END) { fprintf(stderr, "kernel_launch: unexpected shapes (n_in %d, out %d, ws %zu, need %zu)\n", n_in, out_size, ws_size, (size_t)WS_END); grid = -1; return; }
        int dev = 0, cus = 0, per_cu = 0;
        (void)hipGetDevice(&dev); (void)hipDeviceGetAttribute(&cus, hipDeviceAttributeMultiprocessorCount, dev);
        (void)hipFuncSetAttribute((const void*)mega<true>, hipFuncAttributeMaxDynamicSharedMemorySize, LDS_BYTES);
        (void)hipOccupancyMaxActiveBlocksPerMultiprocessor(&per_cu, (const void*)mega<true>, NTHREADS, LDS_BYTES);
        if (per_cu < 1) { fprintf(stderr, "kernel_launch: occupancy query says %d blocks per CU\n", per_cu); per_cu = 1; }
        grid = cus * (per_cu > 1 ? 1 : per_cu);
        (void)hipGetLastError();
    }
    if (grid < 0) return;
    Args a{};
    for (int i = 0; i < N_IN; ++i) a.in[i] = (const float*)d_in[i];
    a.out = (float*)d_out; a.ws = (unsigned char*)d_ws;
    a.ph_lo = 0; a.ph_hi = PH_COUNT;
    void* args[] = {&a};
    hipError_t e = hipLaunchCooperativeKernel((const void*)mega<true>, dim3(grid), dim3(NTHREADS), args, LDS_BYTES, stream);
    if (e != hipSuccess) fprintf(stderr, "kernel_launch: cooperative launch failed: %s (grid %d)\n", hipGetErrorString(e), grid);
}
```
